# Optimizing an MI355X kernel written in HIP

```python
import math
import jax, jax.numpy as jnp
from jax import lax
import numpy as np

D_MODEL = 1024
BATCH = 32
SEQ = 2048
DEPTH = 2

RET_HEADS = 4
RET_QK_DIM = 64
RET_V_DIM = 128
RET_CHUNK = 128
DIFF_HEADS = 4
DIFF_HEAD_DIM = 64
DIFF_V_DIM = 2 * DIFF_HEAD_DIM
Q_BLOCK = 128
FFN_HIDDEN = ((int(math.ceil(8 * D_MODEL / 3)) + 255) // 256) * 256
NORM_EPS = 1e-6

RET_Q_W = RET_HEADS * RET_QK_DIM
RET_V_W = RET_HEADS * RET_V_DIM
DIFF_QK_W = DIFF_HEADS * 2 * DIFF_HEAD_DIM
DIFF_V_W = DIFF_HEADS * DIFF_V_DIM
IN_SPLITS = [RET_Q_W, RET_Q_W, RET_V_W, RET_V_W, DIFF_QK_W, DIFF_QK_W, DIFF_V_W]
IN_WIDTH = sum(IN_SPLITS)
MIX_WIDTH = RET_V_W + DIFF_V_W

kernel_name = "hybrid_retention_diffattn_alibi"


def rmsnorm(x, g):
    xf = x.astype(jnp.float32)
    y = xf * lax.rsqrt(jnp.mean(xf * xf, axis=-1, keepdims=True) + NORM_EPS)
    return (y * g.astype(jnp.float32)).astype(x.dtype)


def retention_gammas():
    return 1.0 - jnp.exp2(-5.0 - jnp.arange(RET_HEADS, dtype=jnp.float32))


def retention_chunkwise(q, k, v):
    B, S, H, dk = q.shape
    dv = v.shape[-1]
    C = RET_CHUNK
    N = S // C
    dt = q.dtype
    log_g = jnp.log(retention_gammas())
    k = k * jnp.asarray(dk ** -0.5, dt)
    q = q.reshape(B, N, C, H, dk)
    k = k.reshape(B, N, C, H, dk)
    v = v.reshape(B, N, C, H, dv)
    idx = jnp.arange(C, dtype=jnp.float32)
    rel = idx[:, None] - idx[None, :]
    decay = jnp.where(rel[None] >= 0,
                      jnp.exp(jnp.maximum(rel, 0.0)[None] * log_g[:, None, None]),
                      0.0).astype(dt)
    s = jnp.einsum('bnchd,bnshd->bnhcs', q, k) * decay
    inner = jnp.einsum('bnhcs,bnshe->bnche', s, v)
    k_decay = jnp.exp((C - 1 - idx)[:, None] * log_g[None, :]).astype(dt)
    kv = jnp.einsum('bnshd,bnshe->nbhde', k * k_decay[:, :, None], v)
    g_chunk = jnp.exp(C * log_g).astype(dt)[None, :, None, None]

    def step(state, kv_n):
        return g_chunk * state + kv_n, state

    _, states = lax.scan(step, jnp.zeros((B, H, dk, dv), dt), kv)
    q_decay = jnp.exp((idx + 1.0)[:, None] * log_g[None, :]).astype(dt)
    cross = jnp.einsum('bnchd,nbhde->bnche', q * q_decay[:, :, None], states)
    return (inner + cross).reshape(B, S, H, dv)


def alibi_slopes(n):
    return jnp.exp2(-8.0 * jnp.arange(1, n + 1, dtype=jnp.float32) / n)


def diff_attention(q, k, v, lam):
    S = q.shape[1]
    d = q.shape[-1]
    scale = d ** -0.5
    slopes = alibi_slopes(q.shape[2])
    outs = []
    for i in range(S // Q_BLOCK):
        q0 = i * Q_BLOCK
        kend = q0 + Q_BLOCK
        qb = q[:, q0:kend]
        kb = k[:, :kend]
        vb = v[:, :kend]
        s = jnp.einsum('bqhjd,bkhjd->bhjqk', qb, kb).astype(jnp.float32) * scale
        dist = (q0 + jnp.arange(Q_BLOCK, dtype=jnp.float32))[:, None] - jnp.arange(kend, dtype=jnp.float32)[None, :]
        s = s - slopes[None, :, None, None, None] * dist
        s = jnp.where(dist >= 0, s, -jnp.inf)
        p = jax.nn.softmax(s, axis=-1)
        a = p[:, :, 0] - lam * p[:, :, 1]
        outs.append(jnp.einsum('bhqk,bkhe->bqhe', a.astype(vb.dtype), vb))
    return jnp.concatenate(outs, axis=1)


def setup_inputs(seed: int = 0) -> dict:
    key = jax.random.key(seed)
    ks = jax.random.split(key, 16)
    f = jnp.float32

    def nrm(k, shape, scale):
        return jax.random.normal(k, shape, f) * scale

    def gain(k, shape):
        return 1.0 + 0.02 * jax.random.normal(k, shape, f)

    return {
        "x": jax.random.normal(ks[0], (BATCH, SEQ, D_MODEL), f),
        "attn_norm": gain(ks[1], (DEPTH, D_MODEL)),
        "w_in": nrm(ks[2], (DEPTH, D_MODEL, IN_WIDTH), D_MODEL ** -0.5),
        "ret_norm": gain(ks[3], (DEPTH, RET_V_DIM)),
        "lambda_q1": nrm(ks[4], (DEPTH, DIFF_HEAD_DIM), 0.1),
        "lambda_k1": nrm(ks[5], (DEPTH, DIFF_HEAD_DIM), 0.1),
        "lambda_q2": nrm(ks[6], (DEPTH, DIFF_HEAD_DIM), 0.1),
        "lambda_k2": nrm(ks[7], (DEPTH, DIFF_HEAD_DIM), 0.1),
        "diff_norm": gain(ks[8], (DEPTH, DIFF_V_DIM)),
        "w_out": nrm(ks[9], (DEPTH, MIX_WIDTH, D_MODEL), MIX_WIDTH ** -0.5),
        "ffn_norm": gain(ks[10], (DEPTH, D_MODEL)),
        "w_gate": nrm(ks[11], (DEPTH, D_MODEL, FFN_HIDDEN), D_MODEL ** -0.5),
        "w_up": nrm(ks[12], (DEPTH, D_MODEL, FFN_HIDDEN), D_MODEL ** -0.5),
        "w_down": nrm(ks[13], (DEPTH, FFN_HIDDEN, D_MODEL), FFN_HIDDEN ** -0.5),
        "final_norm": gain(ks[14], (D_MODEL,)),
    }


def reference(x, attn_norm, w_in, ret_norm, lambda_q1, lambda_k1, lambda_q2, lambda_k2,
              diff_norm, w_out, ffn_norm, w_gate, w_up, w_down, final_norm):
    B, S, _ = x.shape
    offsets = np.cumsum(IN_SPLITS)[:-1].tolist()
    h = x
    for l in range(DEPTH):
        u = rmsnorm(h, attn_norm[l])
        proj = u @ w_in[l]
        rq, rk, rv, rg, dq, dk, dv = jnp.split(proj, offsets, axis=-1)

        ret = retention_chunkwise(rq.reshape(B, S, RET_HEADS, RET_QK_DIM),
                                  rk.reshape(B, S, RET_HEADS, RET_QK_DIM),
                                  rv.reshape(B, S, RET_HEADS, RET_V_DIM))
        ret = rmsnorm(ret, ret_norm[l]).reshape(B, S, RET_V_W)
        ret = jax.nn.silu(rg) * ret

        lam_init = 0.8 - 0.6 * math.exp(-0.3 * l)
        lam = (jnp.exp(jnp.sum(lambda_q1[l].astype(jnp.float32) * lambda_k1[l].astype(jnp.float32)))
               - jnp.exp(jnp.sum(lambda_q2[l].astype(jnp.float32) * lambda_k2[l].astype(jnp.float32)))
               + lam_init)
        dif = diff_attention(dq.reshape(B, S, DIFF_HEADS, 2, DIFF_HEAD_DIM),
                             dk.reshape(B, S, DIFF_HEADS, 2, DIFF_HEAD_DIM),
                             dv.reshape(B, S, DIFF_HEADS, DIFF_V_DIM), lam)
        dif = (rmsnorm(dif, diff_norm[l]) * (1.0 - lam_init)).reshape(B, S, DIFF_V_W)

        mix = jnp.concatenate([ret, dif], axis=-1)
        h = h + mix @ w_out[l]

        u = rmsnorm(h, ffn_norm[l])
        h = h + (jax.nn.silu(u @ w_gate[l]) * (u @ w_up[l])) @ w_down[l]
    return rmsnorm(h, final_norm)
```

```cpp
#include <hip/hip_runtime.h>
#include <cstdio>
#include <cstdint>
namespace pg8 {
#define PG8_LAS __attribute__((address_space(3)))
typedef unsigned short bf16_t;
typedef short bf16x8 __attribute__((ext_vector_type(8)));
typedef float f32x4 __attribute__((ext_vector_type(4)));
typedef unsigned u32x4 __attribute__((ext_vector_type(4)));
constexpr int BM = 256, BK = 64, HALF = 128, HTB = HALF * BK * 2  , STAGE_BYTES = 8 * HTB, NXCD = 8, WGM = 8;

__host__ __device__ __forceinline__ int lds_byte(int r, int c) { const int st = (r >> 4) * 2 + (c >> 5), rr = r & 15, cc = c & 31, ob = rr * 64 + cc * 2; return st * 1024 + (ob ^ (((ob >> 9) & 1) << 5)); }
__host__ __device__ __forceinline__ void stage_rc(int b, int& R, int& C) { const int st = b / 1024, sb = b % 1024, swz = sb ^ (((sb >> 9) & 1) << 5); R = (st >> 1) * 16 + swz / 64; C = (st & 1) * 32 + (swz % 64) / 2; }
__host__ __device__ __forceinline__ int perm32(int rho) { const int n = rho >> 4, i = rho & 15; return 8 * (i >> 2) + 4 * n + (i & 3); }

struct Unit { int pm, pn; };
struct Gemm { const bf16_t* A; const bf16_t* Bt; int M, N, K; };

struct StaticOrder {
    int nM, nN, nwg, G, c;
    __host__ __device__ void init(int M, int N, int G_, int c_) { nM = M / BM; nN = N / BM; nwg = nM * nN; G = G_; c = c_; }
    __host__ __device__ bool next(int i, Unit& u) const {
        const long L = (long)i * G + c; if (L >= nwg) return false;
        int wgid = (int)L; { const int q = nwg / NXCD, r = nwg % NXCD, xcd = wgid % NXCD, off = wgid / NXCD; wgid = (xcd < r ? xcd * (q + 1) : r * (q + 1) + (xcd - r) * q) + off; }
        const int nig = WGM * nN, gid = wgid / nig, fm = gid * WGM, gsz = (nM - fm) < WGM ? (nM - fm) : WGM;
        u.pm = fm + ((wgid % nig) % gsz); u.pn = (wgid % nig) / gsz; return true;
    }
    __device__ __forceinline__ void a_ready(const Unit&) const {}
    __device__ __forceinline__ void done(const Unit&) const {}
};

__device__ __forceinline__ unsigned cvt_pk_bf16(float lo, float hi) { unsigned r; asm volatile("v_cvt_pk_bf16_f32 %0, %1, %2" : "=v"(r) : "v"(lo), "v"(hi)); return r; }
typedef float f32x2 __attribute__((ext_vector_type(2)));
typedef unsigned u32x2 __attribute__((ext_vector_type(2)));
constexpr float NORM_EPS = 1e-6f;
__device__ __forceinline__ float row_rstd(const float* ss, int row, int fq) {
    const f32x4 s4 = *(const f32x4*)(ss + (size_t)row * 16 + 4 * fq);
    float s = (s4[0] + s4[1]) + (s4[2] + s4[3]); s += __shfl_xor(s, 16); s += __shfl_xor(s, 32);
    return __builtin_amdgcn_rsqf(s * (1.0f / 1024.0f) + NORM_EPS);
}
struct EpiProj {
    static constexpr bool PERM = true, AFTER_DRAIN = false;
    bf16_t* O; int ldc; const float* ss;
    __device__ __forceinline__ void operator()(const f32x4 (&acc)[2][2][4][2], const Unit& u, int wr, int wc, int fr, int fq) const {
        const int row0 = u.pm * BM + wr * 64 + fr, col0 = u.pn * BM + wc * 32 + 8 * fq;
        float rsv[2][4];
#pragma unroll
        for (int ai = 0; ai < 2; ++ai)
#pragma unroll
            for (int m = 0; m < 4; ++m) rsv[ai][m] = row_rstd(ss, row0 + ai * HALF + m * 16, fq);
#pragma unroll
        for (int ai = 0; ai < 2; ++ai)
#pragma unroll
            for (int m = 0; m < 4; ++m) { const int row = row0 + ai * HALF + m * 16; const float rs = rsv[ai][m]; bf16_t* rowp = O + (size_t)row * ldc + col0;
#pragma unroll
                for (int bj = 0; bj < 2; ++bj) { const f32x4 v0 = acc[ai][bj][m][0] * rs, v1 = acc[ai][bj][m][1] * rs;
                    u32x4 w; w.x = cvt_pk_bf16(v0[0], v0[1]); w.y = cvt_pk_bf16(v0[2], v0[3]); w.z = cvt_pk_bf16(v1[0], v1[1]); w.w = cvt_pk_bf16(v1[2], v1[3]);
                    *(u32x4*)(rowp + bj * HALF) = w; } }
    }
};
struct EpiSwiglu {
    static constexpr bool PERM = true, AFTER_DRAIN = false;
    bf16_t* O; int ldc; const float* ss;
    __device__ __forceinline__ void operator()(const f32x4 (&acc)[2][2][4][2], const Unit& u, int wr, int wc, int fr, int fq) const {
        const int row0 = u.pm * BM + wr * 64 + fr, col0 = u.pn * HALF + wc * 32 + 8 * fq;
        float rsv[2][4];
#pragma unroll
        for (int ai = 0; ai < 2; ++ai)
#pragma unroll
            for (int m = 0; m < 4; ++m) rsv[ai][m] = row_rstd(ss, row0 + ai * HALF + m * 16, fq);
#pragma unroll
        for (int ai = 0; ai < 2; ++ai)
#pragma unroll
            for (int m = 0; m < 4; ++m) { const int row = row0 + ai * HALF + m * 16; const float rs = rsv[ai][m]; float h[8];
#pragma unroll
                for (int n = 0; n < 2; ++n)
#pragma unroll
                    for (int e = 0; e < 4; ++e) { const float g = acc[ai][0][m][n][e] * rs, up = acc[ai][1][m][n][e] * rs;
                        h[n * 4 + e] = g * up * __builtin_amdgcn_rcpf(1.0f + __builtin_amdgcn_exp2f(g * -1.4426950408889634f)); }
                u32x4 w; w.x = cvt_pk_bf16(h[0], h[1]); w.y = cvt_pk_bf16(h[2], h[3]); w.z = cvt_pk_bf16(h[4], h[5]); w.w = cvt_pk_bf16(h[6], h[7]);
                *(u32x4*)(O + (size_t)row * ldc + col0) = w; }
    }
};
struct EpiResid {
    static constexpr bool PERM = false, AFTER_DRAIN = false;
    const float* hin; float* hout; bf16_t* hb; float* ss;
    __device__ __forceinline__ void operator()(const f32x4 (&acc)[2][2][4][2], const Unit& u, int wr, int wc, int fr, int fq) const {
        const int row0 = u.pm * BM + wr * 64 + fr, col0 = u.pn * BM + wc * 32 + 4 * fq;
#pragma unroll
        for (int ai = 0; ai < 2; ++ai)
#pragma unroll
            for (int m = 0; m < 4; ++m) { const int row = row0 + ai * HALF + m * 16; const size_t off = (size_t)row * 1024 + col0; float q = 0.f; f32x4 res[2][2];
#pragma unroll
                for (int bj = 0; bj < 2; ++bj)
#pragma unroll
                    for (int n = 0; n < 2; ++n) res[bj][n] = *(const f32x4*)(hin + off + bj * HALF + n * 16);
#pragma unroll
                for (int bj = 0; bj < 2; ++bj)
#pragma unroll
                    for (int n = 0; n < 2; ++n) { const size_t o2 = off + bj * HALF + n * 16; const f32x4 v = res[bj][n] + acc[ai][bj][m][n];
                        *(f32x4*)(hout + o2) = v; q += (v[0] * v[0] + v[1] * v[1]) + (v[2] * v[2] + v[3] * v[3]);
                        u32x2 w; w.x = cvt_pk_bf16(v[0], v[1]); w.y = cvt_pk_bf16(v[2], v[3]); *(u32x2*)(hb + o2) = w; }
                q += __shfl_xor(q, 16); q += __shfl_xor(q, 32);
                if (fq == 0) ss[(size_t)row * 16 + u.pn * 4 + wc] = q;
                if (m & 1) asm volatile("" ::: "memory"); }
    }
};

template <class Epi, class Sched, bool ALIGN_EPI = false, bool SP2 = false>
__device__ __forceinline__ void gemm_phase(PG8_LAS unsigned char* lds, const Gemm g, const Sched& S, const Epi& E) {
    int tid_ = threadIdx.x; asm volatile("" : "+v"(tid_));
    const int tid = tid_, wid = __builtin_amdgcn_readfirstlane(tid >> 6), lane = tid & 63, wr = wid >> 2, wc = wid & 3, fr = lane & 15, fq = lane >> 4;
    const int K = g.K, nt = K / BK;
    unsigned voffA[2], voffB[2];
#pragma unroll
    for (int i = 0; i < 2; ++i) { int R, C; stage_rc(tid * 16 + i * 8192, R, C); const int Rb = Epi::PERM ? ((R & ~31) + perm32(R & 31)) : R;
        voffA[i] = (unsigned)(R * K + C) * 2u; voffB[i] = (unsigned)(Rb * K + C) * 2u; }
    const size_t kstep = (size_t)(BK * 2);
    const size_t hstep = (size_t)HALF * K * 2;
    const size_t tstep = 2 * hstep;
    const unsigned ldsw = (unsigned)wid * 1024u;
    const int aoff = lds_byte(wr * 64 + fr, fq * 8), boff = lds_byte(wc * 32 + fr, fq * 8);
#define PG8_SA(b, h) (((b) * 2 + (h)) * HTB)
#define PG8_SB(b, h) ((4 + (b) * 2 + (h)) * HTB)
#define PG8_STAGE(bufoff, gbase, voff) do { _Pragma("unroll") for (int _i = 0; _i < 2; ++_i) \
        __builtin_amdgcn_global_load_lds((const unsigned*)((const char*)(gbase) + (voff)[_i]), (PG8_LAS unsigned*)(lds + (bufoff) + ldsw + _i * 8192), 16, 0, 0); } while (0)
#define PG8_LDA(dst, b, h) do { _Pragma("unroll") for (int m = 0; m < 4; ++m) _Pragma("unroll") for (int k = 0; k < 2; ++k) dst[m][k] = *(const PG8_LAS bf16x8*)(lds + PG8_SA(b, h) + aoff + m * 2048 + k * 1024); } while (0)
#define PG8_LDB(dst, b, h) do { _Pragma("unroll") for (int n = 0; n < 2; ++n) _Pragma("unroll") for (int k = 0; k < 2; ++k) dst[n][k] = *(const PG8_LAS bf16x8*)(lds + PG8_SB(b, h) + boff + n * 2048 + k * 1024); } while (0)
#define PG8_MMA(ai, bj, At, Bt) do { __builtin_amdgcn_s_setprio(1); _Pragma("unroll") for (int m = 0; m < 4; ++m) _Pragma("unroll") for (int n = 0; n < 2; ++n) _Pragma("unroll") for (int k = 0; k < 2; ++k) \
        acc[ai][bj][m][n] = __builtin_amdgcn_mfma_f32_16x16x32_bf16(Bt[n][k], At[m][k], acc[ai][bj][m][n], 0, 0, 0); __builtin_amdgcn_s_setprio(0); } while (0)
#define PG8_WAIT_V(n) asm volatile("s_waitcnt vmcnt(" #n ")" ::: "memory")
#define PG8_WAIT_L(n) asm volatile("s_waitcnt lgkmcnt(" #n ")" ::: "memory")
#define PG8_BAR __builtin_amdgcn_s_barrier()
#define PG8_SCHED __builtin_amdgcn_sched_barrier(0)
    Unit cur, nxt; int ui = 0;
    if (!S.next(0, cur)) return;
    f32x4 acc[2][2][4][2];
#pragma unroll
    for (int a = 0; a < 2; ++a)
#pragma unroll
        for (int b = 0; b < 2; ++b)
#pragma unroll
            for (int m = 0; m < 4; ++m)
#pragma unroll
                for (int n = 0; n < 2; ++n) acc[a][b][m][n] = (f32x4){0.f, 0.f, 0.f, 0.f};
    bf16x8 At[4][2], B0[2][2], B1[2][2];
    const char* cA = (const char*)g.A + (size_t)cur.pm * tstep; const char* cB = (const char*)g.Bt + (size_t)cur.pn * tstep;
    S.a_ready(cur);
    if constexpr (SP2) {
        PG8_STAGE(PG8_SB(0, 0), cB, voffB); PG8_STAGE(PG8_SB(0, 1), cB + hstep, voffB); PG8_STAGE(PG8_SA(0, 0), cA, voffA); PG8_STAGE(PG8_SA(0, 1), cA + hstep, voffA);
        if (wr == 1) PG8_BAR;
        PG8_WAIT_V(2); PG8_BAR;
        PG8_STAGE(PG8_SB(1, 0), cB + kstep, voffB); PG8_STAGE(PG8_SA(1, 0), cA + kstep, voffA); PG8_STAGE(PG8_SB(1, 1), cB + hstep + kstep, voffB);
        PG8_WAIT_V(6); PG8_BAR;
    } else {
        PG8_STAGE(PG8_SB(0, 0), cB, voffB); PG8_STAGE(PG8_SA(0, 0), cA, voffA); PG8_STAGE(PG8_SB(0, 1), cB + hstep, voffB); PG8_STAGE(PG8_SA(0, 1), cA + hstep, voffA);
        if (wr == 1) PG8_BAR;
        PG8_WAIT_V(4); PG8_BAR;
        PG8_STAGE(PG8_SB(1, 0), cB + kstep, voffB); PG8_STAGE(PG8_SA(1, 0), cA + kstep, voffA); PG8_STAGE(PG8_SB(1, 1), cB + hstep + kstep, voffB);
        PG8_WAIT_V(6); PG8_BAR;
    }
    for (;;) {
        const bool has_next = S.next(ui + 1, nxt);
        const char* nA = has_next ? (const char*)g.A + (size_t)nxt.pm * tstep : cA; const char* nB = has_next ? (const char*)g.Bt + (size_t)nxt.pn * tstep : cB;
        for (int t = 0; t < nt; t += 2) {
            const bool last = (t == nt - 2);
            const char* a1 = cA + (size_t)(t + 1) * kstep;
            const char* a2 = last ? nA : cA + (size_t)(t + 2) * kstep; const char* b2 = last ? nB : cB + (size_t)(t + 2) * kstep;
            const char* a3 = a2 + kstep; const char* b3 = b2 + kstep;
            if (last && has_next) S.a_ready(nxt);
            if constexpr (SP2) {
            PG8_LDB(B0, 0, 0); PG8_LDB(B1, 0, 1); PG8_SCHED; PG8_LDA(At, 0, 0); PG8_STAGE(PG8_SA(1, 1), a1 + hstep, voffA);
            PG8_WAIT_V(8); PG8_WAIT_L(0); PG8_BAR; PG8_MMA(0, 0, At, B0); PG8_MMA(0, 1, At, B1); PG8_BAR; PG8_SCHED;
            PG8_LDA(At, 0, 1); PG8_STAGE(PG8_SB(0, 0), b2, voffB); PG8_STAGE(PG8_SB(0, 1), b2 + hstep, voffB); PG8_STAGE(PG8_SA(0, 0), a2, voffA);
            PG8_WAIT_V(8); PG8_WAIT_L(0); PG8_BAR; PG8_MMA(1, 0, At, B0); PG8_MMA(1, 1, At, B1); PG8_BAR; PG8_SCHED;
            PG8_LDB(B0, 1, 0); PG8_LDB(B1, 1, 1); PG8_SCHED; PG8_LDA(At, 1, 0); PG8_STAGE(PG8_SA(0, 1), a2 + hstep, voffA);
            PG8_WAIT_V(8); PG8_WAIT_L(0); PG8_BAR; PG8_MMA(0, 0, At, B0); PG8_MMA(0, 1, At, B1); PG8_BAR; PG8_SCHED;
            PG8_LDA(At, 1, 1); PG8_STAGE(PG8_SB(1, 0), b3, voffB); PG8_STAGE(PG8_SB(1, 1), b3 + hstep, voffB); PG8_STAGE(PG8_SA(1, 0), a3, voffA);
            PG8_WAIT_V(8); PG8_WAIT_L(0); PG8_BAR; PG8_MMA(1, 0, At, B0); PG8_MMA(1, 1, At, B1); PG8_BAR; PG8_SCHED;
            } else {
            PG8_LDB(B0, 0, 0); PG8_SCHED; PG8_LDA(At, 0, 0); PG8_STAGE(PG8_SA(1, 1), a1 + hstep, voffA);
            PG8_WAIT_L(8); PG8_BAR; PG8_WAIT_L(0); PG8_MMA(0, 0, At, B0); PG8_BAR; PG8_SCHED;
            PG8_LDB(B1, 0, 1); PG8_STAGE(PG8_SB(0, 0), b2, voffB);
            PG8_BAR; PG8_WAIT_L(0); PG8_MMA(0, 1, At, B1); PG8_BAR;
            PG8_LDA(At, 0, 1); PG8_STAGE(PG8_SA(0, 0), a2, voffA);
            PG8_BAR; PG8_WAIT_L(0); PG8_MMA(1, 0, At, B0); PG8_BAR; PG8_SCHED;
            PG8_STAGE(PG8_SB(0, 1), b2 + hstep, voffB);
            PG8_WAIT_V(6); PG8_BAR; PG8_MMA(1, 1, At, B1); PG8_BAR;
            PG8_LDB(B0, 1, 0); PG8_SCHED; PG8_LDA(At, 1, 0); PG8_STAGE(PG8_SA(0, 1), a2 + hstep, voffA);
            PG8_WAIT_L(8); PG8_BAR; PG8_WAIT_L(0); PG8_MMA(0, 0, At, B0); PG8_BAR; PG8_SCHED;
            PG8_LDB(B1, 1, 1); PG8_STAGE(PG8_SB(1, 0), b3, voffB);
            PG8_BAR; PG8_WAIT_L(0); PG8_MMA(0, 1, At, B1); PG8_BAR;
            PG8_LDA(At, 1, 1); PG8_STAGE(PG8_SA(1, 0), a3, voffA);
            PG8_BAR; PG8_WAIT_L(0); PG8_MMA(1, 0, At, B0); PG8_BAR; PG8_SCHED;
            PG8_STAGE(PG8_SB(1, 1), b3 + hstep, voffB);
            PG8_WAIT_V(6); PG8_BAR; PG8_MMA(1, 1, At, B1); PG8_BAR;
            }
        }
        if constexpr (ALIGN_EPI) { if (wr == 0) PG8_BAR; }
        if constexpr (!Epi::AFTER_DRAIN) { E(acc, cur, wr, wc, fr, fq); S.done(cur); }
        if (!has_next) break;
#pragma unroll
        for (int a = 0; a < 2; ++a)
#pragma unroll
            for (int b = 0; b < 2; ++b)
#pragma unroll
                for (int m = 0; m < 4; ++m)
#pragma unroll
                    for (int n = 0; n < 2; ++n) acc[a][b][m][n] = (f32x4){0.f, 0.f, 0.f, 0.f};
        cur = nxt; cA = nA; cB = nB; ++ui;
        if constexpr (ALIGN_EPI) { if (wr == 1) PG8_BAR; }
    }
    PG8_WAIT_V(0);
    if constexpr (!ALIGN_EPI) { if (wr == 0) PG8_BAR; }
    PG8_BAR;
    if constexpr (Epi::AFTER_DRAIN) { E.fused(acc, cur, wr, wc, fr, fq, lds, wid, lane); S.done(cur); }
#undef PG8_SA
#undef PG8_SB
#undef PG8_STAGE
#undef PG8_LDA
#undef PG8_LDB
#undef PG8_MMA
#undef PG8_WAIT_V
#undef PG8_WAIT_L
#undef PG8_BAR
#undef PG8_SCHED
}
}
#ifndef PG8_SP2
#define PG8_SP2 true
#endif
#ifndef PG8_ALIGN
#define PG8_ALIGN true
#endif
constexpr int NWAVES = 8;
using pg8::NORM_EPS;
#ifndef MK_PER_PHASE
#define MK_PER_PHASE 0
#endif
constexpr int BATCH = 32, SEQ = 2048, D = 1024, DEPTH = 2;
constexpr int M = BATCH * SEQ;
constexpr int NIN = 3072, FF = 2816, NGU = 2 * FF;
constexpr int C_RQ = 0, C_RK = 256, C_RV = 512, C_RG = 1024, C_DQ = 1536, C_DK = 2048, C_DV = 2560;
constexpr float LOG2E = 1.4426950408889634f;
constexpr float C2 = 0.125f * LOG2E;
constexpr int N_PHASES = 12;
constexpr size_t MiB = 1u << 20;
constexpr size_t WS_CTL = 0, CTL_ZERO_BYTES = 64 * 1024;
constexpr size_t WS_W = 2 * MiB, W_LAYER = 25 * MiB, W_IN = 0, W_OUT = 6 * MiB, W_GU = 8 * MiB, W_DN = 19 * MiB;
constexpr size_t WS_SSA = 52 * MiB, WS_SSB = 56 * MiB;
constexpr size_t WS_HB = 64 * MiB;
constexpr size_t WS_MIX = 192 * MiB;
constexpr size_t WS_PROJ = 320 * MiB;
constexpr size_t WS_END = 704 * MiB;
static_assert(W_DN + (size_t)D * FF * 2 <= W_LAYER && WS_W + 2 * W_LAYER <= WS_SSA && WS_SSB + (size_t)M * 64 <= WS_HB && WS_HB + (size_t)M * D * 2 <= WS_MIX && WS_MIX + (size_t)M * D * 2 <= WS_PROJ && WS_PROJ + (size_t)M * NIN * 2 <= WS_END, "d_ws map");
constexpr int CW_BAR = 1024;
constexpr int RING_OFF = 0, RING_BYTES = 131072;
constexpr int LDSCTL_OFF = RING_BYTES, MISC_OFF = LDSCTL_OFF + 320;
constexpr int LDS_BYTES = 147456;
static_assert(MISC_OFF + 128 <= LDS_BYTES, "LDS map");
#define GAS __attribute__((address_space(1)))
#define LAS __attribute__((address_space(3)))
typedef unsigned short bf16;
typedef unsigned v4u __attribute__((ext_vector_type(4)));
typedef float f32x4 __attribute__((ext_vector_type(4)));
typedef short bf16x8 __attribute__((ext_vector_type(8)));
typedef GAS unsigned gu32;
typedef GAS unsigned long long gu64;
#define RLX_AGENT __ATOMIC_RELAXED, __HIP_MEMORY_SCOPE_AGENT
#define LDS_WAIT() asm volatile("s_waitcnt lgkmcnt(0)" ::: "memory")
#define VM_WAIT() asm volatile("s_waitcnt vmcnt(0)" ::: "memory")
__device__ __forceinline__ unsigned long long rt() { return __builtin_amdgcn_s_memrealtime(); }
__device__ __forceinline__ unsigned f2bf(float f) { unsigned u = __builtin_bit_cast(unsigned, f); return (u + 0x7fffu + ((u >> 16) & 1u)) >> 16; }
__device__ __forceinline__ unsigned pk2(float lo, float hi) { return f2bf(lo) | (f2bf(hi) << 16); }

#define XB_TMO      128
#define XB_XCNT(j)  (256  + 64 * (j))
#define XB_XSUB(j)  (1280 + 64 * (j))
#define XB_XGEN(j)  (2304 + 64 * (j))
#define XB_TOP      3328
#define XB_TOPGEN   3392
#define XCD_BAR_WORDS 3456
#define XB_SPIN_CAP (1u << 22)

__device__ __forceinline__ unsigned xb_ld(unsigned* p)              { return __hip_atomic_load(p, __ATOMIC_RELAXED, __HIP_MEMORY_SCOPE_AGENT); }
__device__ __forceinline__ unsigned xb_add(unsigned* p, unsigned v) { return __hip_atomic_fetch_add(p, v, __ATOMIC_RELAXED, __HIP_MEMORY_SCOPE_AGENT); }
__device__ __forceinline__ unsigned xb_xcc_id() { return (unsigned)__builtin_amdgcn_s_getreg((3 << 11) | 20) & 0xFu; }
#define XB_SPIN(cond, bar) do { unsigned _sp = 0; while (cond) { __builtin_amdgcn_s_sleep(1); \
    if ((++_sp & 255u) == 0u) { if (xb_ld(&(bar)[XB_TMO])) break; if (_sp > XB_SPIN_CAP) { atomicAdd(&(bar)[XB_TMO], 1u); break; } } } } while (0)

struct XcdBarrier {
    unsigned* bar; unsigned x;
    volatile LAS unsigned* st;
};

__device__ __forceinline__ XcdBarrier xcd_barrier_post(unsigned* bar, volatile LAS unsigned* st) {
    XcdBarrier b; b.bar = bar; b.x = xb_xcc_id(); b.st = st;
    if (threadIdx.x == 0) (void)xb_add(&bar[XB_XCNT(b.x)], 1u);
    return b;
}
__device__ __forceinline__ void xcd_barrier_complete(unsigned* bar, unsigned x, unsigned& nloc, unsigned& nx) {
    const unsigned G = gridDim.x * gridDim.y * gridDim.z;
    unsigned sum, cnt, mine, sp = 0u;
    for (;;) {
        sum = 0u; cnt = 0u; mine = 0u;
#pragma unroll
        for (unsigned j = 0; j < 16; ++j) { const unsigned c = xb_ld(&bar[XB_XCNT(j)]); sum += c; cnt += (c > 0u) ? 1u : 0u; mine = (j == x) ? c : mine; }
        if (sum == G) break;
        __builtin_amdgcn_s_sleep(1);
        if ((++sp & 255u) == 0u) { if (xb_ld(&bar[XB_TMO])) break; if (sp > XB_SPIN_CAP) { atomicAdd(&bar[XB_TMO], 1u); break; } }
    }
    nloc = mine > 0u ? mine : 1u; nx = cnt > 0u ? cnt : 1u;
}

__device__ __forceinline__ void xcd_barrier(const XcdBarrier& b) {
    asm volatile("s_waitcnt vmcnt(0)" ::: "memory");
    __syncthreads();
    if (threadIdx.x == 0) {
        unsigned* bar = b.bar;
        __builtin_amdgcn_s_waitcnt(0);
        unsigned nloc = b.st[0], nx = b.st[1];
        if (nloc == 0u) { xcd_barrier_complete(bar, b.x, nloc, nx); b.st[0] = nloc; b.st[1] = nx; }
        const unsigned old = xb_add(&bar[XB_XSUB(b.x)], 1u);
        const unsigned gen = old / nloc;
        if (old + 1u == (gen + 1u) * nloc) {
            __builtin_amdgcn_fence(__ATOMIC_RELEASE, "agent");
            asm volatile("s_waitcnt vmcnt(0)" ::: "memory");
            const unsigned og = xb_add(&bar[XB_TOP], 1u);
            const unsigned tg = og / nx;
            if (og + 1u == (tg + 1u) * nx) xb_add(&bar[XB_TOPGEN], 1u);
            else XB_SPIN(xb_ld(&bar[XB_TOPGEN]) == tg, bar);
            __builtin_amdgcn_fence(__ATOMIC_ACQUIRE, "agent");
            xb_add(&bar[XB_XGEN(b.x)], 1u);
            asm volatile("s_waitcnt vmcnt(0)" ::: "memory");
        } else {
            XB_SPIN(xb_ld(&bar[XB_XGEN(b.x)]) == gen, bar);
            __builtin_amdgcn_fence(__ATOMIC_ACQUIRE, "agent");
            asm volatile("s_waitcnt vmcnt(0)" ::: "memory");
        }
    }
    __syncthreads();
}
struct Frame {
    LAS unsigned char* lds;
    volatile LAS unsigned* MISC;
    gu32* ctl;
    int tid, lane, wave;
    int vcu, G;
};
__device__ __forceinline__ float wave_sum(float v) {
#pragma unroll
    for (int o = 1; o < 64; o <<= 1) v += __shfl_xor(v, o);
    return v;
}
__device__ __forceinline__ float bf2f(bf16 b) { return __builtin_bit_cast(float, (unsigned)b << 16); }
__device__ __forceinline__ float bflo(unsigned w) { return __builtin_bit_cast(float, w << 16); }
__device__ __forceinline__ float bfhi(unsigned w) { return __builtin_bit_cast(float, w & 0xffff0000u); }
__device__ __forceinline__ float lam_init_of(int l) { return l == 0 ? 0.2f : 0.35550907f; }

template <int MODE, bool HAS_GAIN>
__device__ __forceinline__ void p0_transpose_item(const float* W, int K, int N, bf16* WT, const float* gain, LAS float* scr, int item, int lane) {
    const int nblk = N / 32, kb = item / nblk, nb = item % nblk, k0 = 64 * kb, n0 = 32 * nb;
    float cs = 1.f;
    if (MODE == 1) { if (n0 >= C_RK && n0 < C_RV) cs = 0.125f; else if (n0 >= C_DQ && n0 < C_DK) cs = C2; }
#pragma unroll 8
    for (int i = 0; i < 32; ++i) { const int kk = 2 * i + (lane >> 5); const float g = HAS_GAIN ? gain[k0 + kk] * cs : cs; scr[kk * 33 + (lane & 31)] = W[(size_t)(k0 + kk) * N + n0 + (lane & 31)] * g; }
    LDS_WAIT(); asm volatile("" ::: "memory");
    const int c = lane & 7;
#pragma unroll
    for (int j = 0; j < 4; ++j) { const int n = (lane >> 3) + 8 * j; const LAS float* s = scr + (8 * c) * 33 + n;
        v4u o; o.x = pk2(s[0 * 33], s[1 * 33]); o.y = pk2(s[2 * 33], s[3 * 33]); o.z = pk2(s[4 * 33], s[5 * 33]); o.w = pk2(s[6 * 33], s[7 * 33]);
        const int nn = n0 + n; int drow = nn;
        if (MODE == 2) drow = 256 * (nn >> 7) + (nn & 127);
        if (MODE == 3) drow = 256 * (nn >> 7) + 128 + (nn & 127);
        *(GAS v4u*)(WT + (size_t)drow * K + k0 + 8 * c) = o; }
    LDS_WAIT(); asm volatile("" ::: "memory");
}
struct Ptrs {
    const float *x, *attn_norm, *w_in, *ret_norm, *lq1, *lk1, *lq2, *lk2, *diff_norm, *w_out, *ffn_norm, *w_gate, *w_up, *w_down, *final_norm;
    float* out; unsigned char* ws;
};
__device__ __forceinline__ void p0_prologue(Frame& F, const Ptrs& P) {
    LAS float* scr = (LAS float*)(F.lds + RING_OFF + F.wave * 16384);
    const int gw = F.vcu * NWAVES + F.wave, NGW = F.G * NWAVES;
    constexpr int I_IN = (D / 64) * (NIN / 32), I_OUT = (D / 64) * (D / 32), I_G = (D / 64) * (FF / 32), I_DN = (FF / 64) * (D / 32);
    constexpr int I_LAYER = I_IN + I_OUT + 2 * I_G + I_DN;
    for (int it = gw; it < DEPTH * I_LAYER; it += NGW) {
        const int l = it / I_LAYER; int r = it % I_LAYER;
        bf16* wl = (bf16*)(P.ws + WS_W + (size_t)l * W_LAYER);
        if (r < I_IN) { p0_transpose_item<1, true>(P.w_in + (size_t)l * D * NIN, D, NIN, (bf16*)((unsigned char*)wl + W_IN), P.attn_norm + l * D, scr, r, F.lane); continue; } r -= I_IN;
        if (r < I_OUT) { p0_transpose_item<0, false>(P.w_out + (size_t)l * D * D, D, D, (bf16*)((unsigned char*)wl + W_OUT), nullptr, scr, r, F.lane); continue; } r -= I_OUT;
        if (r < I_G) { p0_transpose_item<2, true>(P.w_gate + (size_t)l * D * FF, D, FF, (bf16*)((unsigned char*)wl + W_GU), P.ffn_norm + l * D, scr, r, F.lane); continue; } r -= I_G;
        if (r < I_G) { p0_transpose_item<3, true>(P.w_up + (size_t)l * D * FF, D, FF, (bf16*)((unsigned char*)wl + W_GU), P.ffn_norm + l * D, scr, r, F.lane); continue; } r -= I_G;
        p0_transpose_item<0, false>(P.w_down + (size_t)l * FF * D, FF, D, (bf16*)((unsigned char*)wl + W_DN), nullptr, scr, r, F.lane);
    }
    bf16* hb = (bf16*)(P.ws + WS_HB); float* ssa = (float*)(P.ws + WS_SSA);
    for (int m = gw; m < M; m += NGW) {
        const GAS f32x4* xr = (const GAS f32x4*)(P.x + (size_t)m * D) + F.lane;
        f32x4 v[4]; float s = 0.f;
#pragma unroll
        for (int j = 0; j < 4; ++j) { v[j] = xr[64 * j]; s += (v[j].x * v[j].x + v[j].y * v[j].y) + (v[j].z * v[j].z + v[j].w * v[j].w); }
        s = wave_sum(s);
        GAS unsigned long long* o8 = (GAS unsigned long long*)(hb + (size_t)m * D) + F.lane;
#pragma unroll
        for (int j = 0; j < 4; ++j) o8[64 * j] = (unsigned long long)pk2(v[j].x, v[j].y) | ((unsigned long long)pk2(v[j].z, v[j].w) << 32);
        if (F.lane < 16) ssa[(size_t)m * 16 + F.lane] = F.lane == 0 ? s : 0.f;
    }
}
__device__ __forceinline__ void final_norm_phase(Frame& F, const Ptrs& P) {
    const int gw = F.vcu * NWAVES + F.wave, NGW = F.G * NWAVES;
    f32x4 g[4];
#pragma unroll
    for (int j = 0; j < 4; ++j) g[j] = ((const GAS f32x4*)P.final_norm)[64 * j + F.lane];
    for (int m = gw; m < M; m += NGW) {
        GAS f32x4* xr = (GAS f32x4*)(P.out + (size_t)m * D) + F.lane;
        f32x4 v[4]; float s = 0.f;
#pragma unroll
        for (int j = 0; j < 4; ++j) { v[j] = xr[64 * j]; s += (v[j].x * v[j].x + v[j].y * v[j].y) + (v[j].z * v[j].z + v[j].w * v[j].w); }
        const float rs = 1.0f / sqrtf(wave_sum(s) * (1.0f / D) + NORM_EPS);
#pragma unroll
        for (int j = 0; j < 4; ++j) xr[64 * j] = v[j] * rs * g[j];
    }
}
__device__ __forceinline__ void naive_mixer_phase(Frame& F, const Ptrs& P, int l) {
    const bf16* proj = (const bf16*)(P.ws + WS_PROJ); bf16* mix = (bf16*)(P.ws + WS_MIX);
    const int gw = F.vcu * NWAVES + F.wave, NGW = F.G * NWAVES, lane = F.lane;
    const float lam_init = lam_init_of(l);
    const float s1 = wave_sum(P.lq1[l * 64 + lane] * P.lk1[l * 64 + lane]), s2 = wave_sum(P.lq2[l * 64 + lane] * P.lk2[l * 64 + lane]);
    const float lam = __expf(s1) - __expf(s2) + lam_init;
    for (int it = gw; it < M * 8; it += NGW) {
        const int m = it >> 3, h = it & 3, kind = (it >> 2) & 1, t = m % SEQ;
        const bf16* rowp = proj + (size_t)m * NIN; const bf16* seq0 = proj + (size_t)(m - t) * NIN;
        if (kind == 0) {
            const float q = bf2f(rowp[C_RQ + h * 64 + lane]);
            const float lg = log2f(1.0f - exp2f(-5.0f - (float)h));
            float a0 = 0.f, a1 = 0.f;
            for (int s = 0; s <= t; ++s) { const bf16* pr = seq0 + (size_t)s * NIN;
                const float dot = wave_sum(q * bf2f(pr[C_RK + h * 64 + lane]));
                const float w = dot * exp2f((float)(t - s) * lg);
                const unsigned vv = *(const unsigned*)(pr + C_RV + h * 128 + 2 * lane);
                a0 += w * bflo(vv); a1 += w * bfhi(vv); }
            const float rs = 1.0f / sqrtf(wave_sum(a0 * a0 + a1 * a1) * (1.0f / 128.0f) + NORM_EPS);
            const unsigned gg = *(const unsigned*)(rowp + C_RG + h * 128 + 2 * lane);
            const float g0 = bflo(gg), g1 = bfhi(gg);
            const float y0 = a0 * rs * P.ret_norm[l * 128 + 2 * lane], y1 = a1 * rs * P.ret_norm[l * 128 + 2 * lane + 1];
            const float o0 = g0 / (1.0f + __expf(-g0)) * y0, o1 = g1 / (1.0f + __expf(-g1)) * y1;
            *(unsigned*)(mix + (size_t)m * D + h * 128 + 2 * lane) = pk2(o0, o1);
        } else {
            const float cs = exp2f(-8.0f * (float)(h + 1) / 4.0f) * LOG2E;
            float oj[2][2];
#pragma unroll
            for (int j = 0; j < 2; ++j) {
                const float q = bf2f(rowp[C_DQ + h * 128 + j * 64 + lane]);
                float mx = -INFINITY, lsum = 0.f, a0 = 0.f, a1 = 0.f;
                for (int s = 0; s <= t; ++s) { const bf16* pr = seq0 + (size_t)s * NIN;
                    const float sc = wave_sum(q * bf2f(pr[C_DK + h * 128 + j * 64 + lane])) - cs * (float)(t - s);
                    const unsigned vv = *(const unsigned*)(pr + C_DV + h * 128 + 2 * lane);
                    const float mn = fmaxf(mx, sc), f = exp2f(mx - mn), p = exp2f(sc - mn);
                    lsum = lsum * f + p; a0 = a0 * f + p * bflo(vv); a1 = a1 * f + p * bfhi(vv); mx = mn; }
                oj[j][0] = a0 / lsum; oj[j][1] = a1 / lsum;
            }
            const float d0 = oj[0][0] - lam * oj[1][0], d1 = oj[0][1] - lam * oj[1][1];
            const float rs = 1.0f / sqrtf(wave_sum(d0 * d0 + d1 * d1) * (1.0f / 128.0f) + NORM_EPS) * (1.0f - lam_init);
            *(unsigned*)(mix + (size_t)m * D + 512 + h * 128 + 2 * lane) = pk2(d0 * rs * P.diff_norm[l * 128 + 2 * lane], d1 * rs * P.diff_norm[l * 128 + 2 * lane + 1]);
        }
    }
}

struct Args { const float* in[15]; float* out; unsigned char* ws; int ph_lo, ph_hi; };
__global__ void __launch_bounds__(NWAVES * 64, 2) hybrid_fwd(Args args) {
    extern __shared__ __attribute__((aligned(16))) unsigned char lds[];
    Frame F;
    F.lds = (LAS unsigned char*)lds;
    F.MISC = (volatile LAS unsigned*)(F.lds + MISC_OFF);
    F.tid = threadIdx.x; F.lane = F.tid & 63; F.wave = __builtin_amdgcn_readfirstlane(F.tid >> 6);
    F.G = gridDim.x; { const int bx = blockIdx.x; F.vcu = (F.G % 8 == 0) ? (bx % 8) * (F.G / 8) + bx / 8 : bx; }
    Ptrs P;
    P.x = args.in[0]; P.attn_norm = args.in[1]; P.w_in = args.in[2]; P.ret_norm = args.in[3]; P.lq1 = args.in[4]; P.lk1 = args.in[5]; P.lq2 = args.in[6]; P.lk2 = args.in[7];
    P.diff_norm = args.in[8]; P.w_out = args.in[9]; P.ffn_norm = args.in[10]; P.w_gate = args.in[11]; P.w_up = args.in[12]; P.w_down = args.in[13]; P.final_norm = args.in[14];
    P.out = args.out; P.ws = args.ws;
    F.ctl = (gu32*)(P.ws + WS_CTL);
    for (int u = F.tid; u < (LDS_BYTES - LDSCTL_OFF) / 4; u += NWAVES * 64) ((LAS unsigned*)(F.lds + LDSCTL_OFF))[u] = 0u;
    __syncthreads();
    XcdBarrier bar; bar.bar = (unsigned*)(F.ctl + CW_BAR); bar.x = 0; bar.st = nullptr;
    if (!MK_PER_PHASE) bar = xcd_barrier_post((unsigned*)(F.ctl + CW_BAR), F.MISC + 8);
#define GRID_BAR() do { if (!MK_PER_PHASE) xcd_barrier(bar); } while (0)
    const int lo = args.ph_lo, hi = args.ph_hi;
#define IN(k) (lo <= (k) && (k) < hi)
#define BOTH(k) (IN(k) && IN((k) + 1))
    bf16* hb = (bf16*)(P.ws + WS_HB); bf16* mixb = (bf16*)(P.ws + WS_MIX); bf16* projb = (bf16*)(P.ws + WS_PROJ); bf16* hidb = (bf16*)(P.ws + WS_PROJ);
    float* ssa = (float*)(P.ws + WS_SSA); float* ssb = (float*)(P.ws + WS_SSB);

    if (IN(0)) { p0_prologue(F, P); if (BOTH(0)) GRID_BAR(); }
#pragma unroll
    for (int l = 0; l < DEPTH; ++l) {
        const int pb = 1 + 5 * l;
        const unsigned char* wl = P.ws + WS_W + (size_t)l * W_LAYER;
        if (IN(pb)) {
            pg8::Gemm g{hb, (const bf16*)(wl + W_IN), M, NIN, D}; pg8::StaticOrder S; S.init(M, NIN, F.G, (int)blockIdx.x);
            pg8::EpiProj E{projb, NIN, ssa};
            pg8::gemm_phase<pg8::EpiProj, pg8::StaticOrder, PG8_ALIGN, PG8_SP2>(F.lds + RING_OFF, g, S, E);
            if (BOTH(pb)) GRID_BAR();
        }
        if (IN(pb + 1)) {
            naive_mixer_phase(F, P, l);
            if (BOTH(pb + 1)) GRID_BAR();
        }
        if (IN(pb + 2)) {
            pg8::Gemm g{mixb, (const bf16*)(wl + W_OUT), M, D, D}; pg8::StaticOrder S; S.init(M, D, F.G, (int)blockIdx.x);
            pg8::EpiResid E{l == 0 ? P.x : (const float*)P.out, P.out, hb, ssb};
            pg8::gemm_phase<pg8::EpiResid, pg8::StaticOrder, PG8_ALIGN, PG8_SP2>(F.lds + RING_OFF, g, S, E);
            if (BOTH(pb + 2)) GRID_BAR();
        }
        if (IN(pb + 3)) {
            pg8::Gemm g{hb, (const bf16*)(wl + W_GU), M, NGU, D}; pg8::StaticOrder S; S.init(M, NGU, F.G, (int)blockIdx.x);
            pg8::EpiSwiglu E{hidb, FF, ssb};
            pg8::gemm_phase<pg8::EpiSwiglu, pg8::StaticOrder, PG8_ALIGN, PG8_SP2>(F.lds + RING_OFF, g, S, E);
            if (BOTH(pb + 3)) GRID_BAR();
        }
        if (IN(pb + 4)) {
            pg8::Gemm g{hidb, (const bf16*)(wl + W_DN), M, D, FF}; pg8::StaticOrder S; S.init(M, D, F.G, (int)blockIdx.x);
            pg8::EpiResid E{(const float*)P.out, P.out, hb, ssa};
            pg8::gemm_phase<pg8::EpiResid, pg8::StaticOrder, PG8_ALIGN, PG8_SP2>(F.lds + RING_OFF, g, S, E);
            if (BOTH(pb + 4)) GRID_BAR();
        }
    }
    if (IN(11)) final_norm_phase(F, P);
#undef IN
#undef BOTH
}

extern "C" void kernel_launch(void* const* d_in, const int* in_sizes, int n_in, void* d_out, int out_size, void* d_ws, size_t ws_size, hipStream_t stream) {
    static int grid = 0;
    if (grid == 0) {
        if (n_in != 15 || in_sizes[0] != M * D || out_size != M * D || ws_size < WS_END) { fprintf(stderr, "kernel_launch: unexpected shapes (n_in %d, in0 %d, out %d, ws %zu; need ws >= %zu); nothing launched\n", n_in, n_in > 0 ? in_sizes[0] : -1, out_size, ws_size, (size_t)WS_END); grid = -1; return; }
        int dev = 0, cus = 0, per_cu = 0;
        if (hipGetDevice(&dev) != hipSuccess || hipDeviceGetAttribute(&cus, hipDeviceAttributeMultiprocessorCount, dev) != hipSuccess) { grid = -1; return; }
        if (hipFuncSetAttribute((const void*)hybrid_fwd, hipFuncAttributeMaxDynamicSharedMemorySize, LDS_BYTES) != hipSuccess) { fprintf(stderr, "kernel_launch: hipFuncSetAttribute failed\n"); grid = -1; return; }
        if (hipOccupancyMaxActiveBlocksPerMultiprocessor(&per_cu, (const void*)hybrid_fwd, NWAVES * 64, LDS_BYTES) != hipSuccess || per_cu < 1) { fprintf(stderr, "kernel_launch: occupancy query reports %d workgroups per CU\n", per_cu); (void)hipGetLastError(); grid = -1; return; }
        grid = cus;
    }
    if (grid < 0) return;
    if (hipMemsetAsync((char*)d_ws + WS_CTL, 0, CTL_ZERO_BYTES, stream) != hipSuccess) return;
    Args a{};
    for (int i = 0; i < 15; ++i) a.in[i] = (const float*)d_in[i];
    a.out = (float*)d_out; a.ws = (unsigned char*)d_ws;
#if MK_PER_PHASE
    for (int p = 0; p < N_PHASES; ++p) { a.ph_lo = p; a.ph_hi = p + 1; hipLaunchKernelGGL(hybrid_fwd, dim3(grid), dim3(NWAVES * 64), LDS_BYTES, stream, a); }
#else
    a.ph_lo = 0; a.ph_hi = N_PHASES;
    hipLaunchKernelGGL(hybrid_fwd, dim3(grid), dim3(NWAVES * 64), LDS_BYTES, stream, a);
#endif
}
```

```cpp
#include <hip/hip_runtime.h>
#include <cstdio>
#include <cstdint>
namespace pg8 {
#define PG8_LAS __attribute__((address_space(3)))
typedef unsigned short bf16_t;
typedef short bf16x8 __attribute__((ext_vector_type(8)));
typedef float f32x4 __attribute__((ext_vector_type(4)));
typedef unsigned u32x4 __attribute__((ext_vector_type(4)));
constexpr int BM = 256, BK = 64, HALF = 128, HTB = HALF * BK * 2  , STAGE_BYTES = 8 * HTB, NXCD = 8, WGM = 8;

__host__ __device__ __forceinline__ int lds_byte(int r, int c) { const int st = (r >> 4) * 2 + (c >> 5), rr = r & 15, cc = c & 31, ob = rr * 64 + cc * 2; return st * 1024 + (ob ^ (((ob >> 9) & 1) << 5)); }
__host__ __device__ __forceinline__ void stage_rc(int b, int& R, int& C) { const int st = b / 1024, sb = b % 1024, swz = sb ^ (((sb >> 9) & 1) << 5); R = (st >> 1) * 16 + swz / 64; C = (st & 1) * 32 + (swz % 64) / 2; }
__host__ __device__ __forceinline__ int perm32(int rho) { const int n = rho >> 4, i = rho & 15; return 8 * (i >> 2) + 4 * n + (i & 3); }

struct Unit { int pm, pn; };
struct Gemm { const bf16_t* A; const bf16_t* Bt; int M, N, K; int a_gc = 0; long a_gs = 0; };

struct StaticOrder {
    int nM, nN, nwg, G, c;
    __host__ __device__ void init(int M, int N, int G_, int c_) { nM = M / BM; nN = N / BM; nwg = nM * nN; G = G_; c = c_; }
    __host__ __device__ bool next(int i, Unit& u) const {
        if (G == 256 && WGM == 8 && NXCD == 8 && (nM & 7) == 0) {
            if (i * 256 + c >= nwg) return false;
            const int w = i * 32 + (c >> 3), x = w >> 3, k = (x >= nN) + (x >= 2 * nN) + (x >= 3 * nN);
            u.pm = 8 * (4 * (c & 7) + k) + (w & 7); u.pn = x - k * nN; return true; }
        const long L = (long)i * G + c; if (L >= nwg) return false;
        int wgid = (int)L; { const int q = nwg / NXCD, r = nwg % NXCD, xcd = wgid % NXCD, off = wgid / NXCD; wgid = (xcd < r ? xcd * (q + 1) : r * (q + 1) + (xcd - r) * q) + off; }
        const int nig = WGM * nN, gid = wgid / nig, fm = gid * WGM, gsz = (nM - fm) < WGM ? (nM - fm) : WGM;
        u.pm = fm + ((wgid % nig) % gsz); u.pn = (wgid % nig) / gsz; return true;
    }
    __device__ __forceinline__ void a_ready(const Unit&) const {}
    __device__ __forceinline__ void done(const Unit&) const {}
    __device__ __forceinline__ bool emit(int) const { return true; }
};
struct DupOrder : StaticOrder {
    __host__ __device__ bool next(int i, Unit& u) const { return StaticOrder::next(i >> 1, u); }
    __device__ __forceinline__ bool emit(int ui) const { return (ui & 1) != 0; }
};

__device__ __forceinline__ unsigned cvt_pk_bf16(float lo, float hi) { unsigned r; asm volatile("v_cvt_pk_bf16_f32 %0, %1, %2" : "=v"(r) : "v"(lo), "v"(hi)); return r; }
typedef float f32x2 __attribute__((ext_vector_type(2)));
typedef __bf16 bf16x2v __attribute__((ext_vector_type(2)));
__device__ __forceinline__ unsigned cvt_pk2(f32x2 v) { return __builtin_bit_cast(unsigned, __builtin_convertvector(v, bf16x2v)); }
typedef unsigned u32x2 __attribute__((ext_vector_type(2)));
#ifndef RET_NAIVE
#define RET_NAIVE 0
#endif
#ifndef PROBE_DUP
#define PROBE_DUP 0
#endif
constexpr bool RET_NAIVE_EPI = RET_NAIVE;
constexpr float NORM_EPS = 1e-6f;
__device__ __forceinline__ float row_rstd(const float* ss, int row, int fq) {
    const f32x4 s4 = *(const f32x4*)(ss + (size_t)row * 16 + 4 * fq);
    float s = (s4[0] + s4[1]) + (s4[2] + s4[3]); s += __shfl_xor(s, 16); s += __shfl_xor(s, 32);
    return __builtin_amdgcn_rsqf(s * (1.0f / 1024.0f) + NORM_EPS);
}
constexpr int SS_LDS_OFF = STAGE_BYTES;
__device__ __forceinline__ float row_rstd_l(const PG8_LAS float* ssl, int rl, int fq) {
    const f32x4 s4 = *(const PG8_LAS f32x4*)(ssl + rl * 16 + 4 * fq);
    float s = (s4[0] + s4[1]) + (s4[2] + s4[3]); s += __shfl_xor(s, 16); s += __shfl_xor(s, 32);
    return __builtin_amdgcn_rsqf(s * (1.0f / 1024.0f) + NORM_EPS);
}
__device__ __forceinline__ unsigned dpp_ror8(unsigned v) { return (unsigned)__builtin_amdgcn_update_dpp((int)v, (int)v, 0x128, 0xf, 0xf, false); }
struct EpiProj {
    static constexpr bool PERM = true, AFTER_DRAIN = false, PROBE_TWICE = (PROBE_DUP == 8), LDS_SS = true, ACC_INIT = false;
    bf16_t* O; int ldc; const float* ss; float* qn; float* kn; long gstr; const PG8_LAS float* ssl;
    __device__ __forceinline__ void operator()(const f32x4 (&acc)[2][2][4][2], const Unit& u, int wr, int wc, int fr, int fq) const {
        const int row0 = u.pm * BM + wr * 64 + fr, col0 = u.pn * BM + wc * 64 + 8 * fq;
        const bool gate_tile = !RET_NAIVE_EPI && (u.pn == 4 || u.pn == 5);
        const bool nrm_tile = (u.pn >= 6 && u.pn < 10);
        float lgv = 0.f; int rmask = 0;
        if (!RET_NAIVE_EPI && u.pn < 2) { const int hh = wc; const float lg = hh == 0 ? -0.04580368961312479f : hh == 1 ? -0.02272007650008353f : hh == 2 ? -0.011315313227834146f : -0.005646563141142063f;
            lgv = u.pn == 0 ? lg : -lg; rmask = 63; }
        float nmx[2] = {0.f, 0.f};
        float rsv[2][4];
#pragma unroll
        for (int ai = 0; ai < 2; ++ai)
#pragma unroll
            for (int m = 0; m < 4; ++m) rsv[ai][m] = row_rstd_l(ssl, wr * 64 + fr + ai * HALF + m * 16, fq);
        const bool lo8 = fr < 8;
        const bool timg = (u.pn < 2) || nrm_tile;
        const bool vimg = (u.pn == 2 || u.pn == 3 || u.pn >= 10);
        bf16_t* obase = O + (size_t)(4 * u.pn + wc) * (size_t)gstr + (timg ? (size_t)(4 * u.pm + wr) * 4096 + ((lo8 ? 0 : 4) + fq) * 512 + (fr & 7) * 8
                                                                      : vimg ? (size_t)(4 * u.pm + wr) * 4096 + (lo8 ? 0 : 2048) + (fr & 7) * 32 + 8 * fq
                                                                      : (size_t)(u.pm * BM + wr * 64 + (fr & 7)) * ldc + 8 * fq + (lo8 ? 0 : 32));
        const int st_m = timg ? 128 : vimg ? 512 : 16 * ldc, st_y = timg ? 64 : vimg ? 256 : 8 * ldc;
#pragma unroll
        for (int ai = 0; ai < 2; ++ai)
#pragma unroll
            for (int m = 0; m < 4; ++m) { const int row = row0 + ai * HALF + m * 16;
                const float sc = rsv[ai][m] * __builtin_amdgcn_exp2f(lgv * (float)(row & rmask)); const f32x2 sc2 = {sc, sc};
                f32x2 V[2][4];
#pragma unroll
                for (int bj = 0; bj < 2; ++bj)
#pragma unroll
                    for (int n = 0; n < 2; ++n)
#pragma unroll
                        for (int p = 0; p < 2; ++p) V[bj][2 * n + p] = (f32x2){acc[ai][bj][m][n][2 * p], acc[ai][bj][m][n][2 * p + 1]} * sc2;
                if (gate_tile) {
                    const f32x2 nl2 = {-1.4426950408889634f, -1.4426950408889634f}, one = {1.0f, 1.0f};
#pragma unroll
                    for (int bj = 0; bj < 2; ++bj) { f32x2 X[4];
#pragma unroll
                        for (int k = 0; k < 4; ++k) X[k] = V[bj][k] * nl2;
#pragma unroll
                        for (int k = 0; k < 4; ++k) X[k] = (f32x2){__builtin_amdgcn_exp2f(X[k][0]), __builtin_amdgcn_exp2f(X[k][1])};
#pragma unroll
                        for (int k = 0; k < 4; ++k) X[k] = X[k] + one;
#pragma unroll
                        for (int k = 0; k < 4; ++k) X[k] = (f32x2){__builtin_amdgcn_rcpf(X[k][0]), __builtin_amdgcn_rcpf(X[k][1])};
#pragma unroll
                        for (int k = 0; k < 4; ++k) V[bj][k] = V[bj][k] * X[k]; } }
                if (nrm_tile) { f32x2 q2 = V[0][0] * V[0][0];
#pragma unroll
                    for (int k = 1; k < 8; ++k) { const f32x2 v = V[k >> 2][k & 3]; q2 = v * v + q2; }
                    float nq = q2[0] + q2[1]; nq += __shfl_xor(nq, 16); nq += __shfl_xor(nq, 32); nmx[ai] = fmaxf(nmx[ai], nq); }
                u32x4 w[2];
#pragma unroll
                for (int bj = 0; bj < 2; ++bj) { w[bj].x = cvt_pk2(V[bj][0]); w[bj].y = cvt_pk2(V[bj][1]); w[bj].z = cvt_pk2(V[bj][2]); w[bj].w = cvt_pk2(V[bj][3]); }
                u32x4 t, p; t.x = lo8 ? w[1].x : w[0].x; t.y = lo8 ? w[1].y : w[0].y; t.z = lo8 ? w[1].z : w[0].z; t.w = lo8 ? w[1].w : w[0].w;
                p.x = dpp_ror8(t.x); p.y = dpp_ror8(t.y); p.z = dpp_ror8(t.z); p.w = dpp_ror8(t.w);
                u32x4 x, y;
                x.x = lo8 ? w[0].x : p.x; x.y = lo8 ? w[0].y : p.y; x.z = lo8 ? w[0].z : p.z; x.w = lo8 ? w[0].w : p.w;
                y.x = lo8 ? p.x : w[1].x; y.y = lo8 ? p.y : w[1].y; y.z = lo8 ? p.z : w[1].z; y.w = lo8 ? p.w : w[1].w;
                bf16_t* gp = obase + ai * 8192 + m * st_m;
                *(u32x4*)gp = x; *(u32x4*)(gp + st_y) = y; }
        if (nrm_tile) {
#pragma unroll
            for (int ai = 0; ai < 2; ++ai) { float v = nmx[ai];
                v = fmaxf(v, __builtin_bit_cast(float, __builtin_amdgcn_update_dpp(0, __builtin_bit_cast(int, v), 0x128, 0xf, 0xf, false)));
                v = fmaxf(v, __builtin_bit_cast(float, __builtin_amdgcn_update_dpp(0, __builtin_bit_cast(int, v), 0x124, 0xf, 0xf, false)));
                v = fmaxf(v, __builtin_bit_cast(float, __builtin_amdgcn_update_dpp(0, __builtin_bit_cast(int, v), 0x122, 0xf, 0xf, false)));
                v = fmaxf(v, __builtin_bit_cast(float, __builtin_amdgcn_update_dpp(0, __builtin_bit_cast(int, v), 0x121, 0xf, 0xf, false)));
                if (fr == 0 && fq == 0) { const int b = u.pm >> 3, sub = (u.pm & 7) * 4 + 2 * ai + wr;
                    if (u.pn < 8) qn[(b * 8 + (u.pn - 6) * 4 + wc) * 32 + sub] = v; else kn[(b * 8 + (u.pn - 8) * 4 + wc) * 32 + sub] = v; } }
        }
    }
};
struct EpiSwiglu {
    static constexpr bool PERM = true, AFTER_DRAIN = false, PROBE_TWICE = (PROBE_DUP == 9), LDS_SS = true, ACC_INIT = false;
    bf16_t* O; long gstr; const float* ss; const PG8_LAS float* ssl;
    __device__ __forceinline__ void operator()(const f32x4 (&acc)[2][2][4][2], const Unit& u, int wr, int wc, int fr, int fq) const {
        const int row0 = u.pm * BM + wr * 64 + fr; bf16_t* ob = O + (size_t)(4 * u.pn + wc) * (size_t)gstr + 8 * fq;
        float rsv[2][4];
#pragma unroll
        for (int ai = 0; ai < 2; ++ai)
#pragma unroll
            for (int m = 0; m < 4; ++m) rsv[ai][m] = row_rstd_l(ssl, wr * 64 + fr + ai * HALF + m * 16, fq);
#pragma unroll
        for (int ai = 0; ai < 2; ++ai)
#pragma unroll
            for (int m = 0; m < 4; ++m) { const int row = row0 + ai * HALF + m * 16; const float rs = rsv[ai][m];
                const f32x2 rsn = {rs * -1.4426950408889634f, rs * -1.4426950408889634f}, rs2 = {rs * rs, rs * rs}, one = {1.0f, 1.0f};
                f32x2 G[4], U[4], X[4];
#pragma unroll
                for (int n = 0; n < 2; ++n)
#pragma unroll
                    for (int p = 0; p < 2; ++p) { G[n * 2 + p] = (f32x2){acc[ai][0][m][n][2 * p], acc[ai][0][m][n][2 * p + 1]}; U[n * 2 + p] = (f32x2){acc[ai][1][m][n][2 * p], acc[ai][1][m][n][2 * p + 1]}; }
#pragma unroll
                for (int k = 0; k < 4; ++k) X[k] = G[k] * rsn;
#pragma unroll
                for (int k = 0; k < 4; ++k) X[k] = (f32x2){__builtin_amdgcn_exp2f(X[k][0]), __builtin_amdgcn_exp2f(X[k][1])};
#pragma unroll
                for (int k = 0; k < 4; ++k) { X[k] = X[k] + one; G[k] = (G[k] * U[k]) * rs2; }
#pragma unroll
                for (int k = 0; k < 4; ++k) X[k] = (f32x2){__builtin_amdgcn_rcpf(X[k][0]), __builtin_amdgcn_rcpf(X[k][1])};
#pragma unroll
                for (int k = 0; k < 4; ++k) G[k] = G[k] * X[k];
                u32x4 w; w.x = cvt_pk2(G[0]); w.y = cvt_pk2(G[1]); w.z = cvt_pk2(G[2]); w.w = cvt_pk2(G[3]);
                *(u32x4*)(ob + (size_t)row * 32) = w; }
    }
};
__device__ __forceinline__ float bf_lo(unsigned w) { return __builtin_bit_cast(float, w << 16); }
__device__ __forceinline__ float bf_hi(unsigned w) { return __builtin_bit_cast(float, w & 0xffff0000u); }
struct EpiResid {
    static constexpr bool PERM = true, AFTER_DRAIN = false, PROBE_TWICE = false, LDS_SS = false, ACC_INIT = true;
    const bf16_t* hbin; bf16_t* hb; float* ss;
    __device__ __forceinline__ void load_c(u32x4 (&res)[4][2], const Unit& u, int wr, int wc, int fr, int fq, int ai) const {
        const int row0 = u.pm * BM + wr * 64 + fr + ai * HALF, col0 = u.pn * BM + wc * 64 + 8 * fq;
#pragma unroll
        for (int m = 0; m < 4; ++m)
#pragma unroll
            for (int bj = 0; bj < 2; ++bj) res[m][bj] = *(const u32x4*)(hbin + (size_t)(row0 + m * 16) * 1024 + col0 + bj * 32);
    }
    template <int ai> __device__ __forceinline__ void init_acc(f32x4 (&acc)[2][2][4][2], const u32x4 (&res)[4][2]) const {
#pragma unroll
        for (int m = 0; m < 4; ++m)
#pragma unroll
            for (int bj = 0; bj < 2; ++bj) { const u32x4 r = res[m][bj];
                acc[ai][bj][m][0] = (f32x4){bf_lo(r.x), bf_hi(r.x), bf_lo(r.y), bf_hi(r.y)}; acc[ai][bj][m][1] = (f32x4){bf_lo(r.z), bf_hi(r.z), bf_lo(r.w), bf_hi(r.w)}; }
    }
    template <int ai> __device__ __forceinline__ void half(const f32x4 (&acc)[2][2][4][2], const Unit& u, int wr, int wc, int fr, int fq) const {
        const int row0 = u.pm * BM + wr * 64 + fr, col0 = u.pn * BM + wc * 64 + 8 * fq;
#pragma unroll
        for (int m = 0; m < 4; ++m) { const int row = row0 + ai * HALF + m * 16; f32x2 q2 = {0.f, 0.f};
#pragma unroll
            for (int bj = 0; bj < 2; ++bj) { const f32x4 a0 = acc[ai][bj][m][0], a1 = acc[ai][bj][m][1];
                const f32x2 v01 = {a0[0], a0[1]}, v23 = {a0[2], a0[3]}, v45 = {a1[0], a1[1]}, v67 = {a1[2], a1[3]};
                q2 = v01 * v01 + q2; q2 = v23 * v23 + q2; q2 = v45 * v45 + q2; q2 = v67 * v67 + q2;
                u32x4 w; w.x = cvt_pk2(v01); w.y = cvt_pk2(v23); w.z = cvt_pk2(v45); w.w = cvt_pk2(v67);
                *(u32x4*)(hb + (size_t)row * 1024 + col0 + bj * 32) = w; }
            float q = q2[0] + q2[1]; q += __shfl_xor(q, 16); q += __shfl_xor(q, 32);
            if (fq == 0) ss[(size_t)row * 16 + u.pn * 4 + wc] = q; }
    }
    __device__ __forceinline__ void operator()(const f32x4 (&acc)[2][2][4][2], const Unit& u, int wr, int wc, int fr, int fq) const { half<0>(acc, u, wr, wc, fr, fq); half<1>(acc, u, wr, wc, fr, fq); }
};

template <class Epi, class Sched, bool ALIGN_EPI = false, bool SP2 = false>
__device__ __forceinline__ void gemm_phase(PG8_LAS unsigned char* lds, const Gemm g, const Sched& S, const Epi& E) {
    int tid_ = threadIdx.x; asm volatile("" : "+v"(tid_));
    const int tid = tid_, wid = __builtin_amdgcn_readfirstlane(tid >> 6), lane = tid & 63, wr = wid >> 2, wc = wid & 3, fr = lane & 15, fq = lane >> 4;
    const int K = g.K, nt = K / BK;
    unsigned voffA[2], voffB[2];
#pragma unroll
    for (int i = 0; i < 2; ++i) { int R, C; stage_rc(tid * 16 + i * 8192, R, C); const int Rb = 64 * (R >> 5) + (Epi::PERM ? perm32(R & 31) : (R & 31));
        voffA[i] = g.a_gc ? (unsigned)((size_t)(C / g.a_gc) * (size_t)g.a_gs + (size_t)(R * g.a_gc + C % g.a_gc)) * 2u : (unsigned)(R * K + C) * 2u; voffB[i] = (unsigned)(Rb * K + C) * 2u; }
    const size_t kstep = (size_t)(BK * 2);
    const size_t hstep = (size_t)HALF * K * 2;
    const size_t bhalf = (size_t)32 * K * 2;
    const size_t tstep = 2 * hstep;
    const size_t kstepA = g.a_gc ? (size_t)(BK / g.a_gc) * (size_t)g.a_gs * 2 : kstep, hstepA = g.a_gc ? (size_t)HALF * g.a_gc * 2 : hstep, tstepA = 2 * hstepA;
    const unsigned ldsw = (unsigned)wid * 1024u;
    const int aoff = lds_byte(wr * 64 + fr, fq * 8), boff = lds_byte(wc * 32 + fr, fq * 8);
#define PG8_SA(b, h) (((b) * 2 + (h)) * HTB)
#define PG8_SB(b, h) ((4 + (b) * 2 + (h)) * HTB)
#define PG8_STAGE_R(rs, bufoff, soff, voff) do { _Pragma("unroll") for (int _i = 0; _i < 2; ++_i) \
        __builtin_amdgcn_raw_ptr_buffer_load_lds(rs, (PG8_LAS unsigned*)(lds + (bufoff) + ldsw + _i * 8192), 16, (int)(voff)[_i], (int)(soff), 0, 0); } while (0)
#define PG8_STAGE_A(bufoff, soff, voff) PG8_STAGE_R(rA, bufoff, soff, voff)
#define PG8_STAGE_B(bufoff, soff, voff) PG8_STAGE_R(rB, bufoff, soff, voff)
#define PG8_LDA(dst, b, h) do { _Pragma("unroll") for (int m = 0; m < 4; ++m) _Pragma("unroll") for (int k = 0; k < 2; ++k) dst[m][k] = *(const PG8_LAS bf16x8*)(lds + PG8_SA(b, h) + aoff + m * 2048 + k * 1024); } while (0)
#define PG8_LDB(dst, b, h) do { _Pragma("unroll") for (int n = 0; n < 2; ++n) _Pragma("unroll") for (int k = 0; k < 2; ++k) dst[n][k] = *(const PG8_LAS bf16x8*)(lds + PG8_SB(b, h) + boff + n * 2048 + k * 1024); } while (0)
#define PG8_MMA(ai, bj, At, Bt) do { __builtin_amdgcn_s_setprio(1); _Pragma("unroll") for (int m = 0; m < 4; ++m) _Pragma("unroll") for (int n = 0; n < 2; ++n) _Pragma("unroll") for (int k = 0; k < 2; ++k) \
        acc[ai][bj][m][n] = __builtin_amdgcn_mfma_f32_16x16x32_bf16(Bt[n][k], At[m][k], acc[ai][bj][m][n], 0, 0, 0); __builtin_amdgcn_s_setprio(0); } while (0)
#define PG8_WAIT_V(n) asm volatile("s_waitcnt vmcnt(" #n ")" ::: "memory")
#define PG8_WAIT_L(n) asm volatile("s_waitcnt lgkmcnt(" #n ")" ::: "memory")
#define PG8_BAR __builtin_amdgcn_s_barrier()
#define PG8_SCHED __builtin_amdgcn_sched_barrier(0)
    Unit cur, nxt; int ui = 0;
    if (!S.next(0, cur)) return;
    f32x4 acc[2][2][4][2];
#pragma unroll
    for (int a = 0; a < 2; ++a)
#pragma unroll
        for (int b = 0; b < 2; ++b)
#pragma unroll
            for (int m = 0; m < 4; ++m)
#pragma unroll
                for (int n = 0; n < 2; ++n) acc[a][b][m][n] = (f32x4){0.f, 0.f, 0.f, 0.f};
    if constexpr (Epi::ACC_INIT) { u32x4 res0[4][2]; E.load_c(res0, cur, wr, wc, fr, fq, 0); E.template init_acc<0>(acc, res0); E.load_c(res0, cur, wr, wc, fr, fq, 1); E.template init_acc<1>(acc, res0); }
    bf16x8 At[4][2], B0[2][2], B1[2][2];
    const __amdgpu_buffer_rsrc_t rA = __builtin_amdgcn_make_buffer_rsrc((void*)g.A, (short)0, 0x7fffffff, 0x00020000), rB = __builtin_amdgcn_make_buffer_rsrc((void*)g.Bt, (short)0, 0x7fffffff, 0x00020000);
    unsigned cA = (unsigned)cur.pm * (unsigned)tstepA, cB = (unsigned)cur.pn * (unsigned)tstep;
    S.a_ready(cur);
    if constexpr (SP2) {
        PG8_STAGE_B(PG8_SB(0, 0), cB, voffB); PG8_STAGE_B(PG8_SB(0, 1), cB + bhalf, voffB); PG8_STAGE_A(PG8_SA(0, 0), cA, voffA); PG8_STAGE_A(PG8_SA(0, 1), cA + hstepA, voffA);
        if (wr == 1) PG8_BAR;
        PG8_WAIT_V(2); PG8_BAR;
        PG8_STAGE_B(PG8_SB(1, 0), cB + kstep, voffB); PG8_STAGE_A(PG8_SA(1, 0), cA + kstepA, voffA); PG8_STAGE_B(PG8_SB(1, 1), cB + bhalf + kstep, voffB);
        PG8_WAIT_V(6); PG8_BAR;
    } else {
        PG8_STAGE_B(PG8_SB(0, 0), cB, voffB); PG8_STAGE_A(PG8_SA(0, 0), cA, voffA); PG8_STAGE_B(PG8_SB(0, 1), cB + bhalf, voffB); PG8_STAGE_A(PG8_SA(0, 1), cA + hstepA, voffA);
        if (wr == 1) PG8_BAR;
        PG8_WAIT_V(4); PG8_BAR;
        PG8_STAGE_B(PG8_SB(1, 0), cB + kstep, voffB); PG8_STAGE_A(PG8_SA(1, 0), cA + kstepA, voffA); PG8_STAGE_B(PG8_SB(1, 1), cB + bhalf + kstep, voffB);
        PG8_WAIT_V(6); PG8_BAR;
    }
    for (;;) {
        const bool has_next = S.next(ui + 1, nxt);
        const unsigned nA = has_next ? (unsigned)nxt.pm * (unsigned)tstepA : cA, nB = has_next ? (unsigned)nxt.pn * (unsigned)tstep : cB;
        asm volatile(".p2align 6");
        for (int t = 0; t < nt; t += 2) {
            const bool last = (t == nt - 2);
            const unsigned a1 = cA + (unsigned)(t + 1) * (unsigned)kstepA;
            const unsigned a2 = last ? nA : cA + (unsigned)(t + 2) * (unsigned)kstepA, b2 = last ? nB : cB + (unsigned)(t + 2) * (unsigned)kstep;
            const unsigned a3 = a2 + (unsigned)kstepA, b3 = b2 + (unsigned)kstep;
            if (last && has_next) S.a_ready(nxt);
            if constexpr (SP2) {
            PG8_LDB(B0, 0, 0); PG8_LDB(B1, 0, 1); PG8_SCHED; PG8_LDA(At, 0, 0); PG8_STAGE_A(PG8_SA(1, 1), a1 + hstepA, voffA);
            PG8_WAIT_V(8); PG8_WAIT_L(0); PG8_BAR;
            if constexpr (Epi::LDS_SS) __builtin_amdgcn_global_load_lds((const unsigned*)((const char*)E.ss + (size_t)cur.pm * 16384 + (size_t)(((t >> 1) & 7) * 2048 + wid * 256 + lane * 4)), (PG8_LAS unsigned*)(lds + SS_LDS_OFF + ((t >> 1) & 7) * 2048 + wid * 256), 4, 0, 0);
            PG8_MMA(0, 0, At, B0); PG8_MMA(0, 1, At, B1); PG8_BAR; PG8_SCHED;
            PG8_LDA(At, 0, 1); PG8_STAGE_B(PG8_SB(0, 0), b2, voffB); PG8_STAGE_B(PG8_SB(0, 1), b2 + bhalf, voffB); PG8_STAGE_A(PG8_SA(0, 0), a2, voffA);
            PG8_WAIT_V(8); PG8_WAIT_L(0); PG8_BAR; PG8_MMA(1, 0, At, B0); PG8_MMA(1, 1, At, B1); PG8_BAR; PG8_SCHED;
            PG8_LDB(B0, 1, 0); PG8_LDB(B1, 1, 1); PG8_SCHED; PG8_LDA(At, 1, 0); PG8_STAGE_A(PG8_SA(0, 1), a2 + hstepA, voffA);
            PG8_WAIT_V(8); PG8_WAIT_L(0); PG8_BAR; PG8_MMA(0, 0, At, B0); PG8_MMA(0, 1, At, B1); PG8_BAR; PG8_SCHED;
            PG8_LDA(At, 1, 1); PG8_STAGE_B(PG8_SB(1, 0), b3, voffB); PG8_STAGE_B(PG8_SB(1, 1), b3 + bhalf, voffB); PG8_STAGE_A(PG8_SA(1, 0), a3, voffA);
            PG8_WAIT_V(8); PG8_WAIT_L(0); PG8_BAR; PG8_MMA(1, 0, At, B0); PG8_MMA(1, 1, At, B1); PG8_BAR; PG8_SCHED;
            } else {
            PG8_LDB(B0, 0, 0); PG8_SCHED; PG8_LDA(At, 0, 0); PG8_STAGE_A(PG8_SA(1, 1), a1 + hstepA, voffA);
            PG8_WAIT_L(8); PG8_BAR; PG8_WAIT_L(0); PG8_MMA(0, 0, At, B0); PG8_BAR; PG8_SCHED;
            PG8_LDB(B1, 0, 1); PG8_STAGE_B(PG8_SB(0, 0), b2, voffB);
            PG8_BAR; PG8_WAIT_L(0); PG8_MMA(0, 1, At, B1); PG8_BAR;
            PG8_LDA(At, 0, 1); PG8_STAGE_A(PG8_SA(0, 0), a2, voffA);
            PG8_BAR; PG8_WAIT_L(0); PG8_MMA(1, 0, At, B0); PG8_BAR; PG8_SCHED;
            PG8_STAGE_B(PG8_SB(0, 1), b2 + bhalf, voffB);
            PG8_WAIT_V(6); PG8_BAR; PG8_MMA(1, 1, At, B1); PG8_BAR;
            PG8_LDB(B0, 1, 0); PG8_SCHED; PG8_LDA(At, 1, 0); PG8_STAGE_A(PG8_SA(0, 1), a2 + hstepA, voffA);
            PG8_WAIT_L(8); PG8_BAR; PG8_WAIT_L(0); PG8_MMA(0, 0, At, B0); PG8_BAR; PG8_SCHED;
            PG8_LDB(B1, 1, 1); PG8_STAGE_B(PG8_SB(1, 0), b3, voffB);
            PG8_BAR; PG8_WAIT_L(0); PG8_MMA(0, 1, At, B1); PG8_BAR;
            PG8_LDA(At, 1, 1); PG8_STAGE_A(PG8_SA(1, 0), a3, voffA);
            PG8_BAR; PG8_WAIT_L(0); PG8_MMA(1, 0, At, B0); PG8_BAR; PG8_SCHED;
            PG8_STAGE_B(PG8_SB(1, 1), b3 + bhalf, voffB);
            PG8_WAIT_V(6); PG8_BAR; PG8_MMA(1, 1, At, B1); PG8_BAR;
            }
        }
        if constexpr (ALIGN_EPI) { if (wr == 0) PG8_BAR; }
        if constexpr (Epi::ACC_INIT) {
            u32x4 resn[4][2];
            Unit un = cur; if (has_next) un = nxt;
            E.load_c(resn, un, wr, wc, fr, fq, 0);
            E.template half<0>(acc, cur, wr, wc, fr, fq);
            E.template init_acc<0>(acc, resn); E.load_c(resn, un, wr, wc, fr, fq, 1);
            E.template half<1>(acc, cur, wr, wc, fr, fq);
            E.template init_acc<1>(acc, resn);
            S.done(cur);
        } else
        if constexpr (!Epi::AFTER_DRAIN) { if (S.emit(ui)) { E(acc, cur, wr, wc, fr, fq); if constexpr (Epi::PROBE_TWICE) { asm volatile("" ::: "memory"); E(acc, cur, wr, wc, fr, fq); } } S.done(cur); }
        if (!has_next) break;
        if constexpr (!Epi::ACC_INIT)
#pragma unroll
        for (int a = 0; a < 2; ++a)
#pragma unroll
            for (int b = 0; b < 2; ++b)
#pragma unroll
                for (int m = 0; m < 4; ++m)
#pragma unroll
                    for (int n = 0; n < 2; ++n) acc[a][b][m][n] = (f32x4){0.f, 0.f, 0.f, 0.f};
        cur = nxt; cA = nA; cB = nB; ++ui;
        if constexpr (ALIGN_EPI) { if (wr == 1) PG8_BAR; }
    }
    PG8_WAIT_V(0);
    if constexpr (!ALIGN_EPI) { if (wr == 0) PG8_BAR; }
    PG8_BAR;
    if constexpr (Epi::AFTER_DRAIN) { E.fused(acc, cur, wr, wc, fr, fq, lds, wid, lane); S.done(cur); }
#undef PG8_SA
#undef PG8_SB
#undef PG8_STAGE_R
#undef PG8_STAGE_A
#undef PG8_STAGE_B
#undef PG8_LDA
#undef PG8_LDB
#undef PG8_MMA
#undef PG8_WAIT_V
#undef PG8_WAIT_L
#undef PG8_BAR
#undef PG8_SCHED
}
}
#include <hip/hip_bf16.h>
#include <cmath>
namespace attn_body {
using bf16=__hip_bfloat16;
using bf16x8=__attribute__((ext_vector_type(8)))short;
using s16x4=__attribute__((ext_vector_type(4)))short;
using f32x16=__attribute__((ext_vector_type(16)))float;
using u32x4=__attribute__((ext_vector_type(4)))unsigned;
constexpr int SEQ=2048,D=64,DM=64;
constexpr long GSTR=65536L*64;
constexpr int NW=8,QBLK=32,QB=QBLK*NW,KVBLK=64;
__device__ __forceinline__ int crow(int r,int hi){return (r&3)+8*(r>>2)+4*hi;}
#define SBAR() __builtin_amdgcn_sched_barrier(0)
__device__ __forceinline__ void cmask(f32x16&p0,f32x16&p1,int jb,int qrel,int hi,const float NEG){
  int kb=64*jb+4*hi;
  #pragma unroll
  for(int r=0;r<16;++r){int kv=kb+(r&3)+8*(r>>2); if(kv>qrel)p0[r]=NEG; if(kv+32>qrel)p1[r]=NEG;}
}
constexpr int NSLOT=3, SLOTB=8192, VSLOTB=16384;
constexpr int LDS_K=0, LDS_V=NSLOT*SLOTB, LDS_WS=LDS_V+NSLOT*VSLOTB, LDS_OST=LDS_WS+NW*64*4, LDS_ST=LDS_OST+NW*8192, LDS_BYTES=LDS_ST+16384;
__device__ __forceinline__ void glds16(const void*gsrc,unsigned lds_dst){unsigned keep;
  asm volatile("s_mov_b32 %0, m0\n\ts_mov_b32 m0, %2\n\ts_nop 0\n\tglobal_load_lds_dwordx4 %1, off\n\ts_mov_b32 m0, %0":"=&s"(keep):"v"(gsrc),"s"(lds_dst):"memory");}
__device__ __forceinline__ float max3f(float a,float b,float c){float r;asm("v_max3_f32 %0, %1, %2, %3":"=v"(r):"v"(a),"v"(b),"v"(c));return r;}
__device__ __forceinline__ float max2f(float a,float b){float r;asm("v_max_f32_e32 %0, %1, %2":"=v"(r):"v"(a),"v"(b));return r;}
__device__ __forceinline__ float fadd_s(float a,float b){float r;asm("v_add_f32_e32 %0, %1, %2":"=v"(r):"v"(a),"v"(b));return r;}
__device__ __forceinline__ float fsub_s(float a,float b){float r;asm("v_sub_f32_e32 %0, %1, %2":"=v"(r):"v"(a),"v"(b));return r;}
typedef float f32x2_t __attribute__((ext_vector_type(2))); typedef __bf16 bf16x2_t __attribute__((ext_vector_type(2)));
__device__ __forceinline__ unsigned cvtpk_s(float lo,float hi){f32x2_t v={lo,hi};bf16x2_t b=__builtin_convertvector(v,bf16x2_t);return __builtin_bit_cast(unsigned,b);}
#define WAIT_BAR(N) asm volatile("s_waitcnt vmcnt(" #N ") lgkmcnt(0)\n\ts_barrier":::"memory")

__device__ __forceinline__ void qkt(f32x16&p0,f32x16&p1,const char*Kslot,const bf16x8*qr,int r32,int hi){
  const char*kb=Kslot+hi*1024+r32*16;
  #pragma unroll
  for(int d0=0;d0<4;++d0){
    const bf16x8 b0=*reinterpret_cast<const bf16x8*>(kb+d0*2048);
    const bf16x8 b1=*reinterpret_cast<const bf16x8*>(kb+d0*2048+512);
    p0=__builtin_amdgcn_mfma_f32_32x32x16_bf16(b0,qr[d0],p0,0,0,0);p1=__builtin_amdgcn_mfma_f32_32x32x16_bf16(b1,qr[d0],p1,0,0,0);}
}
typedef __attribute__((address_space(3))) const char* lds_cptr;
typedef short v4i16_t __attribute__((ext_vector_type(4)));
__device__ __forceinline__ void kload8(bf16x8*kf,lds_cptr kp){
  kf[0]=*(const __attribute__((address_space(3))) bf16x8*)(kp);      kf[1]=*(const __attribute__((address_space(3))) bf16x8*)(kp+512);
  kf[2]=*(const __attribute__((address_space(3))) bf16x8*)(kp+2048); kf[3]=*(const __attribute__((address_space(3))) bf16x8*)(kp+2560);
  kf[4]=*(const __attribute__((address_space(3))) bf16x8*)(kp+4096); kf[5]=*(const __attribute__((address_space(3))) bf16x8*)(kp+4608);
  kf[6]=*(const __attribute__((address_space(3))) bf16x8*)(kp+6144); kf[7]=*(const __attribute__((address_space(3))) bf16x8*)(kp+6656);
}
__device__ __forceinline__ void kload2(bf16x8*kf,lds_cptr kp,int j){ kf[2*j]=*(const __attribute__((address_space(3))) bf16x8*)(kp+j*2048); kf[2*j+1]=*(const __attribute__((address_space(3))) bf16x8*)(kp+j*2048+512); }
__device__ __forceinline__ s16x4 vtr(lds_cptr p){ return __builtin_bit_cast(s16x4,__builtin_amdgcn_ds_read_tr16_b64_v4i16((__attribute__((address_space(3))) v4i16_t*)p)); }
__device__ __forceinline__ float rowmax(const f32x16&p0,const f32x16&p1){
  float a=max3f(p0[0],p0[1],p1[0]),b=max3f(p0[2],p0[3],p1[1]);a=max3f(a,p1[2],p1[3]);
  #pragma unroll
  for(int r=4;r<16;r+=4){a=max3f(a,p0[r],p0[r+1]);b=max3f(b,p0[r+2],p0[r+3]);a=max3f(a,p1[r],p1[r+1]);b=max3f(b,p1[r+2],p1[r+3]);}
  const float m=max2f(a,b);
  auto rr=__builtin_amdgcn_permlane32_swap(__float_as_uint(m),__float_as_uint(m),false,false);
  return max2f(__uint_as_float(rr[0]),__uint_as_float(rr[1]));
}
__device__ __forceinline__ void pv(f32x16*o,int vb,bf16x8 pa0,bf16x8 pa1,bf16x8 pa2,bf16x8 pa3){
  #pragma unroll
  for(int d0=0;d0<4;++d0){s16x4 lo[4],hi[4];
    #pragma unroll
    for(int ks=0;ks<4;++ks){
      asm volatile("ds_read_b64_tr_b16 %0,%1 offset:%c2":"=&v"(lo[ks]):"v"(vb),"i"(d0*4096+ks*1024):"memory");
      asm volatile("ds_read_b64_tr_b16 %0,%1 offset:%c2":"=&v"(hi[ks]):"v"(vb),"i"(d0*4096+ks*1024+512):"memory");}
    asm volatile("s_waitcnt lgkmcnt(0)":::"memory");SBAR();
    #define PK(k) (bf16x8){lo[k][0],lo[k][1],lo[k][2],lo[k][3],hi[k][0],hi[k][1],hi[k][2],hi[k][3]}
    o[d0]=__builtin_amdgcn_mfma_f32_32x32x16_bf16(pa0,PK(0),o[d0],0,0,0);
    o[d0]=__builtin_amdgcn_mfma_f32_32x32x16_bf16(pa1,PK(1),o[d0],0,0,0);
    o[d0]=__builtin_amdgcn_mfma_f32_32x32x16_bf16(pa2,PK(2),o[d0],0,0,0);
    o[d0]=__builtin_amdgcn_mfma_f32_32x32x16_bf16(pa3,PK(3),o[d0],0,0,0);
    #undef PK
  }
}

struct PassArgs { int qb, cq, ck, cv, tsk; };
template<int THRL,int MODE> __device__ __forceinline__ void attn_unit(const bf16*__restrict__ proj,long rowbase,const PassArgs A_,float cs,float lam,char*shm,int&slot0,bool pre,bf16x8(&qr)[4],bool has_next,const PassArgs N_,f32x16&Sreg){
  const int qb=A_.qb; const bf16*Qh=proj+A_.cq; const bf16*__restrict__ Kh_=proj+A_.ck; const bf16*__restrict__ Vh_=proj+A_.cv;
  int tid_=threadIdx.x; asm volatile("":"+v"(tid_));
  const int tid=tid_,lane=tid&63,r32=lane&31,hi=lane>>5; const int wid=__builtin_amdgcn_readfirstlane(tid>>6);
  constexpr bool LIN=(MODE==2); const float lgam=LIN?cs:0.f; if(LIN)cs=0.f; float ftv=1.f;
  const int q0=qb*QB;
  const bf16*Qw=Qh+(rowbase+q0+(wid>>1)*KVBLK)*DM+(wid&1)*(QBLK*8);
  const int tsk=A_.tsk;
  const bf16*Kh=Kh_+(rowbase+(long)tsk*KVBLK)*DM,*Vh=Vh_+(rowbase+(long)tsk*KVBLK)*DM;
  const unsigned lds0=(unsigned)(uintptr_t)shm;
  float*wsf=(float*)(shm+LDS_WS)+wid*64;
  const float g64=LIN?__builtin_amdgcn_exp2f(64.f*lgam):1.f;
  const __attribute__((address_space(3))) char* ktp0=(const __attribute__((address_space(3))) char*)shm+LDS_K+(4*(wid>>2)+2*((lane>>4)&1)+((lane&3)>>1))*1024+(4*hi+((lane&15)>>2))*16+(lane&1)*8;
  const bf16*ksrc=Kh+(long)lane*8+wid*512;
  const bf16*vsrc=Vh+(wid>>2)*2048+(wid&3)*512+(long)lane*8;
  const unsigned kdst=lds0+LDS_K+wid*1024, vdst=lds0+LDS_V+wid*1024;
  #define DMA_K(t,slot) glds16(ksrc+(long)(t)*KVBLK*DM,(unsigned)__builtin_amdgcn_readfirstlane(kdst+(slot)))
  #define DMA_V(t,slot) do{ glds16(vsrc+(long)(t)*KVBLK*DM,(unsigned)__builtin_amdgcn_readfirstlane(vdst+2*(slot))); glds16(vsrc+(long)(t)*KVBLK*DM+GSTR,(unsigned)__builtin_amdgcn_readfirstlane(vdst+2*(slot)+8192)); }while(0)
  const int vb0=(int)(lds0+LDS_V)+((lane>>4)&1)*32+(lane&3)*8+(4*hi+((lane&15)>>2))*64;
  const char*Kbase=shm+LDS_K; bf16x8 kf[8];
  const lds_cptr shm3=(lds_cptr)shm; const lds_cptr kp0=shm3+LDS_K+hi*1024+r32*16; const lds_cptr vp0=shm3+LDS_V+((lane>>4)&1)*32+(lane&3)*8+(4*hi+((lane&15)>>2))*64;
  const int NT=(q0+QB)/KVBLK-tsk;
  #define NXS(s) (((s)==(NSLOT-1)*SLOTB)?0:(s)+SLOTB)
  const int sA=slot0,sB=NXS(sA),sC=NXS(sB);
  if(!pre){ DMA_K(0,sA);DMA_V(0,sA);DMA_K(1,sB);
    #pragma unroll
    for(int d0=0;d0<4;++d0)qr[d0]=*reinterpret_cast<const bf16x8*>(&Qw[(2*d0+hi)*512+r32*8]);
    DMA_K(2,sC); }
  float l_reg=0.f;f32x16 o[4];
  { _Pragma("unroll") for(int d_=0;d_<4;++d_) _Pragma("unroll") for(int r=0;r<16;++r){float z_;asm volatile("v_mov_b32 %0, 0":"=v"(z_));o[d_][r]=z_;} }
  const int qrel=wid*QBLK+r32;
  float csv=cs; asm volatile("":"+v"(csv)); const float cs64=64.f*cs, cs59=59.f*cs; float nb=0.f;
  #define ALIBI_IN(P0,P1) do{ _Pragma("unroll") for(int r=0;r<16;++r){ P0[r]=__builtin_fmaf(csv,(float)((r&3)+8*(r>>2)),P0[r]); P1[r]=__builtin_fmaf(csv,(float)((r&3)+8*(r>>2)+32),P1[r]); } }while(0)
  #define CMASK(P0,P1,t) do{int jb_=(t)-(NT-4); if(jb_>=0)cmask(P0,P1,jb_,qrel,hi,LIN?0.f:-INFINITY);}while(0)
  bool resc=false;
  #define START(P0,P1) do{ resc=false; if constexpr(LIN){ _Pragma("unroll") for(int r=0;r<16;++r)P0[r]*=ftv; break; } const float rm=rowmax(P0,P1); \
    { const float dl=rm; \
      _Pragma("unroll") for(int r=0;r<16;++r){P0[r]=fsub_s(P0[r],dl);P1[r]=fsub_s(P1[r],dl);} \
      nb=bt0+cs64-dl; } \
    _Pragma("unroll") for(int r=0;r<16;++r)P0[r]=__builtin_amdgcn_exp2f(P0[r]); }while(0)
  #define RESC() do{ if(resc){ asm volatile("s_waitcnt lgkmcnt(0)":::"memory"); \
      _Pragma("unroll") for(int d_=0;d_<4;++d_) _Pragma("unroll") for(int r=0;r<16;++r)o[d_][r]*=wsf[crow(r,hi)]; } }while(0)
  f32x16 pA0,pA1,pB0,pB1;
  int sl_prev=sA,sl_cur=sA,sl_next=sB;
  #define ROT() do{sl_prev=sl_cur;sl_cur=sl_next;sl_next=(sl_next==(NSLOT-1)*SLOTB)?0:sl_next+SLOTB;}while(0)
  #define MF32(a,b,c) __builtin_amdgcn_mfma_f32_32x32x16_bf16(a,b,c,0,0,0)
  if constexpr(LIN){
    char*st_=shm+LDS_ST+((wid&3)*32+r32)*128+((wid>>2)*32+4*hi)*2;
    #pragma unroll
    for(int g4=0;g4<4;++g4){ uint2 w_; w_.x=cvtpk_s(Sreg[4*g4]*g64,Sreg[4*g4+1]*g64); w_.y=cvtpk_s(Sreg[4*g4+2]*g64,Sreg[4*g4+3]*g64); *reinterpret_cast<uint2*>(st_+g4*16)=w_; } }
  WAIT_BAR(4);
  if constexpr(LIN){
    const char*sr_=shm+LDS_ST+r32*128+hi*16;
    #pragma unroll
    for(int cq=0;cq<4;++cq){
      #pragma unroll
      for(int d0=0;d0<4;++d0){ const bf16x8 sf_=*reinterpret_cast<const bf16x8*>(sr_+cq*4096+d0*32); o[cq]=MF32(qr[d0],sf_,o[cq]); } } }
  #define KVUPD(slot) do{ _Pragma("unroll") for(int r=0;r<16;++r)Sreg[r]*=g64; \
    const __attribute__((address_space(3))) char*kt_=ktp0+(slot); const lds_cptr vt_=vp0+2*(slot)+(wid&3)*4096; \
    _Pragma("unroll") for(int ks=0;ks<4;++ks){ const s16x4 a0_=vtr((lds_cptr)(kt_+ks*256)),a1_=vtr((lds_cptr)(kt_+ks*256+128)),b0_=vtr(vt_+ks*1024),b1_=vtr(vt_+ks*1024+512); \
      Sreg=MF32(((bf16x8){a0_[0],a0_[1],a0_[2],a0_[3],a1_[0],a1_[1],a1_[2],a1_[3]}),((bf16x8){b0_[0],b0_[1],b0_[2],b0_[3],b1_[0],b1_[1],b1_[2],b1_[3]}),Sreg); } }while(0)
  const float bt0=cs*(float)(4*hi-(q0+QB-1)+64*tsk);
  { _Pragma("unroll") for(int r=0;r<16;++r){float z_,y_;asm volatile("v_mov_b32 %0, 0\n\tv_mov_b32 %1, 0":"=v"(z_),"=v"(y_));pA0[r]=z_;pA1[r]=y_;} asm volatile("s_nop 1":"+v"(pA0),"+v"(pA1)); }
  qkt(pA0,pA1,Kbase+sA,qr,r32,hi);asm volatile("s_nop 15\n\ts_nop 7":"+v"(pA0),"+v"(pA1));
  if constexpr(LIN) ftv=__builtin_amdgcn_exp2f(lgam*(float)(q0-64*tsk));
  if constexpr(!LIN){ _Pragma("unroll") for(int r=0;r<16;++r){pA0[r]+=bt0;pA1[r]+=bt0;} ALIBI_IN(pA0,pA1); } CMASK(pA0,pA1,0);
  START(pA0,pA1);
  _Pragma("unroll") for(int r=0;r<16;++r)pA1[r]=LIN?pA1[r]*ftv:__builtin_amdgcn_exp2f(pA1[r]);
  WAIT_BAR(0);
  if constexpr(LIN){ KVUPD(sA); asm volatile("s_waitcnt lgkmcnt(0)\n\ts_barrier":::"memory"); }
  DMA_K(3,sA);DMA_V(1,sB);
  ROT();
  kload8(kf,kp0+sl_cur);
  WAIT_BAR(3);
  s16x4 fl[16],fh[16]; u32x4 pw0,pw1,pw2,pw3;
  #define PKW(P,B) cvtpk_s(P[B],P[B+1])
  #define PAF(k) __builtin_bit_cast(bf16x8,pw##k)
  #define FFR(i) (bf16x8){fl[i][0],fl[i][1],fl[i][2],fl[i][3],fh[i][0],fh[i][1],fh[i][2],fh[i][3]}
  #define PIN(x) asm volatile("":"+v"(x))
  #define MX3(a,b,c) __builtin_fmaxf(__builtin_fmaxf((a),(b)),(c))
  #define GAPA(MF,A0,A1,A2,A3,W0,W1,PW) do{ MF; if constexpr(!LIN){ sacc+=A0; sacc+=A1; sacc+=A2; sacc+=A3; PIN(sacc); } W0; W1; PIN(PW); SBAR(); }while(0)
  #define KR(B) ((float)(((B)&3)+8*((B)>>2)))
  #define FMAK(a,K,c) ({ float r_; asm("v_fmamk_f32 %0, %1, %2, %3":"=v"(r_):"v"(a),"n"(__builtin_bit_cast(unsigned,(float)(K))),"v"(c)); r_; })
  #define EXB(v,k) (LIN?(v)*ftv:__builtin_amdgcn_exp2f(v))
  #define GAPB(MF,X,B,OFF,Y) do{ MF; X[B]=EXB(X[B],KR(B)+(OFF)); X[B+1]=EXB(X[B+1],KR((B)+1)+(OFF)); PIN(X); if constexpr(!LIN){ Y[B]=FMAK(csv,KR(B)+(OFF),nbn_); Y[B+1]=FMAK(csv,KR((B)+1)+(OFF),nbn_); PIN(Y); } SBAR(); }while(0)
  #define FRD(i) do{ fl[i]=vtr(vp_+(((i)>>2)*4096+((i)&3)*1024)); fh[i]=vtr(vp_+(((i)>>2)*4096+((i)&3)*1024+512)); SBAR(); }while(0)
  #define KRD(G,j) do{ if(G){ kload2(kf,kp0+sl_next,j); SBAR(); } }while(0)
  #define CST(Cx) (LIN?f32x16{}:Cx)
  #define STEP(C0,C1,P0,P1,t,GK,GV,GL) do{ SBAR(); \
    if constexpr(LIN){ ftv=__builtin_amdgcn_exp2f(lgam*(float)(q0-64*((t)+tsk))); if((t)>=2){ KVUPD(sl_prev); } } SBAR(); \
    const lds_cptr vp_=vp0+2*sl_prev; \
    FRD(0); float sacc=(P0[0]+P0[1]); \
    GAPA(C0=MF32(kf[0],qr[0],CST(C0)), P0[2],P0[3],P0[4],P0[5],     pw0[0]=PKW(P0,0), pw0[1]=PKW(P0,2), pw0); \
    GAPA(C1=MF32(kf[1],qr[0],CST(C1)), P0[6],P0[7],P0[8],P0[9],     pw0[2]=PKW(P0,4), pw0[3]=PKW(P0,6), pw0); \
    FRD(4); GAPA(C0=MF32(kf[2],qr[1],C0),   P0[10],P0[11],P0[12],P0[13], pw1[0]=PKW(P0,8), pw1[1]=PKW(P0,10), pw1); \
    GAPA(C1=MF32(kf[3],qr[1],C1),   P0[14],P0[15],P1[0],P1[1],   pw1[2]=PKW(P0,12),pw1[3]=PKW(P0,14), pw1); \
    FRD(1); GAPA(C0=MF32(kf[4],qr[2],C0),   P1[2],P1[3],P1[4],P1[5],     pw2[0]=PKW(P1,0), pw2[1]=PKW(P1,2), pw2); \
    GAPA(C1=MF32(kf[5],qr[2],C1),   P1[6],P1[7],P1[8],P1[9],     pw2[2]=PKW(P1,4), pw2[3]=PKW(P1,6), pw2); \
    FRD(5); GAPA(C0=MF32(kf[6],qr[3],C0),   P1[10],P1[11],P1[12],P1[13], pw3[0]=PKW(P1,8), pw3[1]=PKW(P1,10), pw3); \
    GAPA(C1=MF32(kf[7],qr[3],C1),   P1[14],P1[15],0.f,0.f,       pw3[2]=PKW(P1,12),pw3[3]=PKW(P1,14), pw3); \
    l_reg+=sacc; \
    if(GK){DMA_K((t)+3,sl_cur);} if(GV){DMA_V((t)+1,sl_next);} \
    CMASK(C0,C1,t); \
    if constexpr(!LIN){ float a=MX3(C0[0],C0[1],C1[0]),b=MX3(C0[2],C0[3],C1[1]); a=MX3(a,C1[2],C1[3]); \
      _Pragma("unroll") for(int r=4;r<16;r+=4){a=MX3(a,C0[r],C0[r+1]);b=MX3(b,C0[r+2],C0[r+3]);a=MX3(a,C1[r],C1[r+1]);b=MX3(b,C1[r+2],C1[r+3]);} \
      float rm=__builtin_fmaxf(a,b); { auto rr=__builtin_amdgcn_permlane32_swap(__float_as_uint(rm),__float_as_uint(rm),false,false); rm=__builtin_fmaxf(__uint_as_float(rr[0]),__uint_as_float(rr[1])); } \
      resc=false; \
      if(__builtin_expect(__any(rm>(float)THRL),0)){ const float dl=__builtin_fmaxf(rm,0.f); \
        _Pragma("unroll") for(int r=0;r<16;++r){C0[r]-=dl;C1[r]-=dl;} \
        nb-=dl; \
        const float f=__builtin_amdgcn_exp2f(-dl); l_reg*=f; if(hi==0)wsf[r32]=f; resc=true; } } \
    float nbn_=nb+cs64; asm volatile("":"+v"(nbn_)); \
    SBAR(); \
    FRD(2);  GAPB(o[0]=MF32(PAF(0),FFR(0),o[0]), C0,0,0.f,P0); \
    FRD(6);  GAPB(o[1]=MF32(PAF(0),FFR(4),o[1]), C0,2,0.f,P0); \
    FRD(3);  GAPB(o[0]=MF32(PAF(1),FFR(1),o[0]), C0,4,0.f,P0); \
    FRD(7);  GAPB(o[1]=MF32(PAF(1),FFR(5),o[1]), C0,6,0.f,P0); \
    FRD(8);  GAPB(o[0]=MF32(PAF(2),FFR(2),o[0]), C0,8,0.f,P0); \
    FRD(12); GAPB(o[1]=MF32(PAF(2),FFR(6),o[1]), C0,10,0.f,P0); \
    FRD(9);  GAPB(o[0]=MF32(PAF(3),FFR(3),o[0]), C0,12,0.f,P0); \
    FRD(13); GAPB(o[1]=MF32(PAF(3),FFR(7),o[1]), C0,14,0.f,P0); \
    FRD(10); GAPB(o[2]=MF32(PAF(0),FFR(8),o[2]), C1,0,32.f,P1); \
    FRD(14); GAPB(o[3]=MF32(PAF(0),FFR(12),o[3]), C1,2,32.f,P1); \
    FRD(11); GAPB(o[2]=MF32(PAF(1),FFR(9),o[2]), C1,4,32.f,P1); \
    FRD(15); GAPB(o[3]=MF32(PAF(1),FFR(13),o[3]), C1,6,32.f,P1); \
    KRD(GL,0); KRD(GL,1); GAPB(o[2]=MF32(PAF(2),FFR(10),o[2]), C1,8,32.f,P1); \
    KRD(GL,2); GAPB(o[3]=MF32(PAF(2),FFR(14),o[3]), C1,10,32.f,P1); \
    KRD(GL,3); GAPB(o[2]=MF32(PAF(3),FFR(11),o[2]), C1,12,32.f,P1); \
    GAPB(o[3]=MF32(PAF(3),FFR(15),o[3]), C1,14,32.f,P1); \
    nb=nbn_; \
    }while(0)
  if constexpr(!LIN){ float nbv_=nb; asm volatile("":"+v"(nbv_)); _Pragma("unroll") for(int r=0;r<16;++r){pB0[r]=__builtin_fmaf(csv,(float)((r&3)+8*(r>>2)),nbv_);pB1[r]=__builtin_fmaf(csv,(float)((r&3)+8*(r>>2)+32),nbv_);} asm volatile("":"+v"(pB0),"+v"(pB1)); }
  int t=1;
  #undef CMASK
  #define CMASK(P0,P1,t) do{}while(0)
  asm volatile(".p2align 6");
  for(;t+5<NT;t+=2){
    STEP(pB0,pB1,pA0,pA1,t,true,true,true);     WAIT_BAR(3); RESC(); ROT();
    STEP(pA0,pA1,pB0,pB1,t+1,true,true,true);   WAIT_BAR(3); RESC(); ROT();
  }
  #undef CMASK
  #define CMASK(P0,P1,t) do{int jb_=(t)-(NT-4); if(jb_>=0)cmask(P0,P1,jb_,qrel,hi,LIN?0.f:-INFINITY);}while(0)
  #define ENDW(tt) do{ if((tt)+3<NT){WAIT_BAR(3);} else if((tt)+2<NT){WAIT_BAR(2);} else {WAIT_BAR(0);} }while(0)
  for(;t+1<NT;t+=2){
    STEP(pB0,pB1,pA0,pA1,t,(t+3<NT),(t+1<NT),(t+1<NT));       ENDW(t);   RESC(); ROT();
    STEP(pA0,pA1,pB0,pB1,t+1,(t+4<NT),(t+2<NT),(t+2<NT));     ENDW(t+1); RESC(); ROT();
  }
  STEP(pB0,pB1,pA0,pA1,NT-1,false,false,false); RESC();
  if constexpr(LIN){ KVUPD(sl_cur); asm volatile("s_waitcnt lgkmcnt(0)\n\ts_barrier":::"memory"); }
  if(has_next){ const int sN=sl_next,sN1=NXS(sN),sN2=NXS(sN1);
    int ln2=lane; asm volatile("":"+v"(ln2)); const int r32n=ln2&31,hin=ln2>>5;
    const long nrb=rowbase+(long)N_.tsk*KVBLK;
    const bf16*nK=proj+N_.ck+nrb*DM+(long)ln2*8+wid*512; const bf16*nV=proj+N_.cv+nrb*DM+(wid>>2)*2048+(wid&3)*512+(long)ln2*8; const bf16*nQ=proj+N_.cq+(rowbase+N_.qb*QB+(wid>>1)*KVBLK)*DM+(wid&1)*(QBLK*8);
    glds16(nK,(unsigned)__builtin_amdgcn_readfirstlane(kdst+sN)); glds16(nV,(unsigned)__builtin_amdgcn_readfirstlane(vdst+2*sN)); glds16(nV+GSTR,(unsigned)__builtin_amdgcn_readfirstlane(vdst+2*sN+8192));
    glds16(nK+(long)KVBLK*DM,(unsigned)__builtin_amdgcn_readfirstlane(kdst+sN1));
    #pragma unroll
    for(int d0=0;d0<4;++d0)qr[d0]=*reinterpret_cast<const bf16x8*>(&nQ[(2*d0+hin)*512+r32n*8]);
    glds16(nK+(long)2*KVBLK*DM,(unsigned)__builtin_amdgcn_readfirstlane(kdst+sN2));
    slot0=sN; }
  { float sacc=pB0[0]+pB0[1]; _Pragma("unroll") for(int r=2;r<16;++r)sacc+=pB0[r]; _Pragma("unroll") for(int r=0;r<16;++r)sacc+=pB1[r]; l_reg+=sacc;
    pw0=(u32x4){PKW(pB0,0),PKW(pB0,2),PKW(pB0,4),PKW(pB0,6)};pw1=(u32x4){PKW(pB0,8),PKW(pB0,10),PKW(pB0,12),PKW(pB0,14)};pw2=(u32x4){PKW(pB1,0),PKW(pB1,2),PKW(pB1,4),PKW(pB1,6)};pw3=(u32x4){PKW(pB1,8),PKW(pB1,10),PKW(pB1,12),PKW(pB1,14)};
    SBAR(); pv(o,vb0+2*sl_cur,PAF(0),PAF(1),PAF(2),PAF(3)); }
  #undef PKW
  #undef PAF
  #undef FFR
  #undef PIN
  #undef MX3
  #undef GAPA
  #undef GAPB
  #undef EXB
  #undef KR
  #undef FMAK
  #undef FRD
  #undef KRD
  #undef MF32
  #undef CST
  #undef KVUPD
  #undef STEP
  #undef ENDW
  {auto rr=__builtin_amdgcn_permlane32_swap(__float_as_uint(l_reg),__float_as_uint(l_reg),false,false);l_reg=__uint_as_float(rr[0])+__uint_as_float(rr[1]);}
  if(hi==0)wsf[32+r32]=l_reg;asm volatile("s_waitcnt lgkmcnt(0)":::"memory");
  float rli[16];
  #pragma unroll
  for(int r=0;r<16;++r)rli[r]=__builtin_amdgcn_rcpf(wsf[32+crow(r,hi)]);
  { int ln_=lane; asm volatile("":"+v"(ln_));
    const int r32e=ln_&31, hie=ln_>>5;
    bf16*stg=(bf16*)(shm+LDS_OST)+wid*4096+hie*512+r32e;
    #pragma unroll
    for(int r=0;r<16;++r){const int orow=(r&3)+8*(r>>2);
      #pragma unroll
      for(int d0=0;d0<4;++d0){ float val=LIN?o[d0][r]:o[d0][r]*rli[r];
        if(MODE==1) val=__bfloat162float(stg[orow*128+d0*32])-lam*val;
        stg[orow*128+d0*32]=__float2bfloat16(val);} }
    asm volatile("s_waitcnt lgkmcnt(0)":::"memory"); }
  asm volatile("s_waitcnt lgkmcnt(0)\n\ts_barrier":::"memory");
  #undef DMA_K
  #undef DMA_V
  #undef CMASK
  #undef START
  #undef RESC
  #undef ROT
  #undef ALIBI_IN
  #undef NXS
}

typedef unsigned u32x2r __attribute__((ext_vector_type(2)));
typedef float f32x4r __attribute__((ext_vector_type(4)));
constexpr int R2_Q=LDS_OST, R2_SIMG=R2_Q+NSLOT*SLOTB, R2_SROW=144, R2_SBUF=128*R2_SROW, R2_STG=R2_SIMG+R2_SBUF, R2_STROW=264, R2_GATE=R2_STG+64*R2_STROW, R2_END=R2_GATE+16384;
static_assert(R2_END<=LDS_BYTES,"ret_chain LDS map");
__device__ __forceinline__ u32x4 gld16_async(const void*p){u32x4 r;asm volatile("global_load_dwordx4 %0, %1, off":"=v"(r):"v"(p):"memory");return r;}
__device__ __forceinline__ void ret_chain(const bf16*__restrict__ proj,long rowbase,int cq,int ck,int cv,int cg,float lgam,char*shm,int slot0,bool pre,const __attribute__((address_space(1))) float*gain,unsigned short*mixh,int DMX){
  #define NXS(s) (((s)==(NSLOT-1)*SLOTB)?0:(s)+SLOTB)
  int tid_=threadIdx.x; asm volatile("":"+v"(tid_));
  const int tid=tid_,lane=tid&63,r32=lane&31,hi=lane>>5; const int wid=__builtin_amdgcn_readfirstlane(tid>>6);
  const int rb=wid>>2,cb=wid&3;
  const unsigned lds0=(unsigned)(uintptr_t)shm; const lds_cptr shm3=(lds_cptr)shm;
  const bf16*ksrc=proj+ck+rowbase*DM+lane*8+wid*512; const bf16*qsrc=proj+cq+rowbase*DM+lane*8+wid*512;
  const bf16*vsrc=proj+cv+rowbase*DM+(wid>>2)*2048+(wid&3)*512+lane*8;
  const unsigned kdst=lds0+LDS_K+wid*1024, qdst=lds0+R2_Q+wid*1024, vdst=lds0+LDS_V+wid*1024;
  #define R2_DMA(t,slot) do{ glds16(ksrc+(long)(t)*KVBLK*DM,(unsigned)__builtin_amdgcn_readfirstlane(kdst+(slot))); glds16(qsrc+(long)(t)*KVBLK*DM,(unsigned)__builtin_amdgcn_readfirstlane(qdst+(slot))); \
    glds16(vsrc+(long)(t)*KVBLK*DM,(unsigned)__builtin_amdgcn_readfirstlane(vdst+2*(slot))); glds16(vsrc+(long)(t)*KVBLK*DM+GSTR,(unsigned)__builtin_amdgcn_readfirstlane(vdst+2*(slot)+8192)); }while(0)
  const lds_cptr kp0=shm3+LDS_K+hi*1024+r32*16;
  const lds_cptr qp0=shm3+R2_Q+hi*1024+(32*rb+r32)*16;
  const lds_cptr ktp0=shm3+LDS_K+(4*rb+2*((lane>>4)&1)+((lane&3)>>1))*1024+(4*hi+((lane&15)>>2))*16+(lane&1)*8;
  const lds_cptr vp0=shm3+LDS_V+((lane>>4)&1)*32+(lane&3)*8+(4*hi+((lane&15)>>2))*64+cb*4096;
  const lds_cptr sr0=shm3+R2_SIMG+(32*cb+r32)*R2_SROW+hi*16;
  char*const sw0=shm+R2_SIMG+(32*cb+r32)*R2_SROW+(32*rb+4*hi)*2;
  const int qrow=32*rb+r32;
  char*const stw=shm+R2_STG+qrow*R2_STROW+(32*cb+4*hi)*2;
  const int ch=lane&15, frow=8*wid+(lane>>4);
  const char*const str=shm+R2_STG+frow*R2_STROW+ch*16;
  const bf16*gsrc=proj+cg+(long)(ch>>3)*GSTR+(rowbase+frow)*DM+(ch&7)*8;
  unsigned short*msrc=mixh+(rowbase+frow)*(long)DMX+ch*8;
  float gd[8];
  #pragma unroll
  for(int r=0;r<8;++r)gd[r]=gain[ch*8+r];
  const float g64=__builtin_amdgcn_exp2f(64.f*lgam);
  f32x16 T,O;
  { _Pragma("unroll") for(int r=0;r<16;++r){float z_,y_;asm volatile("v_mov_b32 %0, 0\n\tv_mov_b32 %1, 0":"=v"(z_),"=v"(y_));T[r]=z_;O[r]=y_;} }
  #define MF32(a,b,c) __builtin_amdgcn_mfma_f32_32x32x16_bf16(a,b,c,0,0,0)
  asm volatile("s_waitcnt vmcnt(0) lgkmcnt(0)\n\ts_barrier":::"memory");
  { _Pragma("unroll") for(int r=0;r<8;++r)asm volatile("":"+v"(gd[r])); }
  const int sA=slot0,sB=NXS(sA),sC=NXS(sB);
  const unsigned gdst=lds0+R2_GATE+wid*2048; const char*const grd=shm+R2_GATE+wid*2048+lane*16;
  const bf16*const pfsrc=proj+cg+(long)(lane&1)*GSTR+(rowbase+8*wid+((lane&15)>>1))*DM; const unsigned pfdst=lds0+LDS_WS+wid*256;
  #define R2_PF(tt) do{ unsigned keep_; asm volatile("s_mov_b32 %0, m0\n\ts_mov_b32 m0, %2\n\ts_nop 0\n\tglobal_load_lds_dword %1, off\n\ts_mov_b32 m0, %0":"=&s"(keep_):"v"(pfsrc+(long)(tt)*KVBLK*DM),"s"((unsigned)__builtin_amdgcn_readfirstlane(pfdst)):"memory"); }while(0)
  #define R2_GDMA(tt) do{ const bf16*gp_=gsrc+(long)(tt)*KVBLK*DM; asm volatile("s_waitcnt lgkmcnt(0)":::"memory"); glds16(gp_,(unsigned)__builtin_amdgcn_readfirstlane(gdst)); glds16(gp_+(long)4*DM,(unsigned)__builtin_amdgcn_readfirstlane(gdst+1024)); }while(0)
  if(!pre){ glds16(ksrc,(unsigned)__builtin_amdgcn_readfirstlane(kdst+sA)); glds16(vsrc,(unsigned)__builtin_amdgcn_readfirstlane(vdst+2*sA)); glds16(vsrc+GSTR,(unsigned)__builtin_amdgcn_readfirstlane(vdst+2*sA+8192)); }
  glds16(qsrc,(unsigned)__builtin_amdgcn_readfirstlane(qdst+sA));
  R2_DMA(1,sB);
  { u32x2r z_; z_.x=0u; z_.y=0u;
    #pragma unroll
    for(int g4=0;g4<4;++g4)*reinterpret_cast<u32x2r*>(sw0+g4*16)=z_; }
  int s_cur=sA,s_n1=sB,s_n2=sC;
  u32x4 ow[2];
  #define R2_FINAL() do{ u32x4 av_[2],gv_[2]; float qv_[2]; \
      _Pragma("unroll") for(int k=0;k<2;++k){ av_[k]=*reinterpret_cast<const u32x4*>(str+k*4*R2_STROW); gv_[k]=*reinterpret_cast<const u32x4*>(grd+k*1024); } \
      _Pragma("unroll") for(int k=0;k<2;++k){ const u32x4 a_=av_[k]; float s_=0.f; \
        _Pragma("unroll") for(int e=0;e<4;++e){ const float lo_=__uint_as_float(a_[e]<<16),hi_=__uint_as_float(a_[e]&0xffff0000u); s_=__builtin_fmaf(lo_,lo_,s_); s_=__builtin_fmaf(hi_,hi_,s_); } qv_[k]=s_; } \
      _Pragma("unroll") for(int o_=1;o_<16;o_<<=1){ _Pragma("unroll") for(int k=0;k<2;++k)qv_[k]+=__shfl_xor(qv_[k],o_); } \
      _Pragma("unroll") for(int k=0;k<2;++k){ const u32x4 a_=av_[k]; const float rs_=__builtin_amdgcn_rsqf(qv_[k]*(1.0f/128.0f)+1e-6f); \
        _Pragma("unroll") for(int e=0;e<4;++e){ const float lo_=__uint_as_float(a_[e]<<16),hi_=__uint_as_float(a_[e]&0xffff0000u); const unsigned gw_=gv_[k][e]; \
          ow[k][e]=cvtpk_s(lo_*rs_*gd[2*e]*__uint_as_float(gw_<<16),hi_*rs_*gd[2*e+1]*__uint_as_float(gw_&0xffff0000u)); } } }while(0)
  #define R2_STORE(tt) do{ unsigned short*mp_=msrc+(long)(tt)*KVBLK*DMX; _Pragma("unroll") for(int k=0;k<2;++k)*(__attribute__((address_space(1))) u32x4*)(mp_+(long)k*4*DMX)=ow[k]; }while(0)
  #define R2_BODY(t,GV) do{ \
    if(t==0){ WAIT_BAR(4); } else if(t==1){ WAIT_BAR(5); } else if(t==31){ WAIT_BAR(2); } else { WAIT_BAR(7); } \
    const lds_cptr vt_=vp0+2*s_cur; const lds_cptr kt_=ktp0+s_cur; const lds_cptr kf_=kp0+s_cur; const lds_cptr qf_=qp0+s_cur; const lds_cptr sr_=sr0; \
    bf16x8 vf[4],ka[4],sf[4],qf[4],kb0[4],kb1[4]; \
    _Pragma("unroll") \
    for(int ks=0;ks<4;++ks){ const s16x4 b0_=vtr(vt_+ks*1024),b1_=vtr(vt_+ks*1024+512); vf[ks]=(bf16x8){b0_[0],b0_[1],b0_[2],b0_[3],b1_[0],b1_[1],b1_[2],b1_[3]}; \
      const s16x4 a0_=vtr(kt_+ks*256),a1_=vtr(kt_+ks*256+128); ka[ks]=(bf16x8){a0_[0],a0_[1],a0_[2],a0_[3],a1_[0],a1_[1],a1_[2],a1_[3]}; } \
    _Pragma("unroll") \
    for(int d0=0;d0<4;++d0){ sf[d0]=*(const __attribute__((address_space(3))) bf16x8*)(sr_+d0*32); qf[d0]=*(const __attribute__((address_space(3))) bf16x8*)(qf_+d0*2048); \
      kb0[d0]=*(const __attribute__((address_space(3))) bf16x8*)(kf_+d0*2048); kb1[d0]=*(const __attribute__((address_space(3))) bf16x8*)(kf_+d0*2048+512); } \
    SBAR(); \
    if(t>0){ R2_FINAL(); } \
    R2_GDMA(t); if(t+2<32){ R2_PF(t+2); } \
    if(t+2<32){ R2_DMA(t+2,s_n2); } \
    asm volatile("s_waitcnt lgkmcnt(0)":::"memory"); SBAR(); \
    f32x16 p0,p1; \
 \
    _Pragma("unroll") \
    for(int d0=0;d0<4;++d0){ O=MF32(sf[d0],qf[d0],d0==0?f32x16{}:O); T=MF32(ka[d0],vf[d0],T); p0=MF32(kb0[d0],qf[d0],d0==0?f32x16{}:p0); p1=MF32(kb1[d0],qf[d0],d0==0?f32x16{}:p1); SBAR(); } \
    { _Pragma("unroll") for(int r=0;r<16;++r){ const int kv=4*hi+(r&3)+8*(r>>2); p0[r]=(kv>qrow)?0.f:p0[r]; p1[r]=(kv+32>qrow)?0.f:p1[r]; } } \
    { u32x4 pw0,pw1,pw2,pw3; \
      pw0=(u32x4){cvtpk_s(p0[0],p0[1]),cvtpk_s(p0[2],p0[3]),cvtpk_s(p0[4],p0[5]),cvtpk_s(p0[6],p0[7])}; pw1=(u32x4){cvtpk_s(p0[8],p0[9]),cvtpk_s(p0[10],p0[11]),cvtpk_s(p0[12],p0[13]),cvtpk_s(p0[14],p0[15])}; \
      pw2=(u32x4){cvtpk_s(p1[0],p1[1]),cvtpk_s(p1[2],p1[3]),cvtpk_s(p1[4],p1[5]),cvtpk_s(p1[6],p1[7])}; pw3=(u32x4){cvtpk_s(p1[8],p1[9]),cvtpk_s(p1[10],p1[11]),cvtpk_s(p1[12],p1[13]),cvtpk_s(p1[14],p1[15])}; \
      O=MF32(vf[0],__builtin_bit_cast(bf16x8,pw0),O); O=MF32(vf[1],__builtin_bit_cast(bf16x8,pw1),O); O=MF32(vf[2],__builtin_bit_cast(bf16x8,pw2),O); O=MF32(vf[3],__builtin_bit_cast(bf16x8,pw3),O); } \
    asm volatile("s_waitcnt lgkmcnt(0)\n\ts_barrier":::"memory"); \
    { _Pragma("unroll") for(int r=0;r<16;++r)T[r]*=g64; } \
    if(t<31){ char*sw_=sw0; \
      _Pragma("unroll") for(int g4=0;g4<4;++g4){ u32x2r w_; w_.x=cvtpk_s(T[4*g4],T[4*g4+1]); w_.y=cvtpk_s(T[4*g4+2],T[4*g4+3]); *reinterpret_cast<u32x2r*>(sw_+g4*16)=w_; } } \
    { _Pragma("unroll") for(int g=0;g<4;++g){ u32x2r w_; w_.x=cvtpk_s(O[4*g],O[4*g+1]); w_.y=cvtpk_s(O[4*g+2],O[4*g+3]); *reinterpret_cast<u32x2r*>(stw+g*16)=w_; } } \
    if(t>0){ R2_STORE(t-1); } \
    { const int s_=s_cur; s_cur=s_n1; s_n1=s_n2; s_n2=s_; } \
  }while(0)
  asm volatile(".p2align 6");
  for(int t=0;t<32;++t){ R2_BODY(t,0); }
  WAIT_BAR(0);
  { R2_FINAL(); R2_STORE(31); }
  #undef R2_DMA
  #undef R2_FINAL
  #undef R2_STORE
  #undef R2_BODY
  #undef R2_GDMA
  #undef R2_PF
  #undef MF32
  #undef NXS
}
constexpr int ATTN_LDS_BYTES=LDS_BYTES;
#undef SBAR
#undef WAIT_BAR
}
#ifndef PG8_SP2
#define PG8_SP2 true
#endif
#ifndef PG8_ALIGN
#define PG8_ALIGN true
#endif
#ifndef RET_NAIVE
#define RET_NAIVE 0
#endif
#ifndef PROBE_DUP
#define PROBE_DUP 0
#endif
constexpr int ATT_THR = 40;
#ifndef NO_TSKIP
#define NO_TSKIP 0
#endif
#ifndef STAGGER_US
#define STAGGER_US 0
#endif
constexpr int NWAVES = 8;
using pg8::NORM_EPS;
#ifndef MK_PER_PHASE
#define MK_PER_PHASE 0
#endif
constexpr int BATCH = 32, SEQ = 2048, D = 1024, DEPTH = 2;
constexpr int M = BATCH * SEQ;
constexpr int NIN = 3072, FF = 2816, NGU = 2 * FF;
constexpr int C_RQ = 0, C_RK = 256, C_RV = 512, C_RG = 1024, C_DQ = 1536, C_DK = 2048, C_DV = 2560;
constexpr float LOG2E = 1.4426950408889634f;
constexpr float C2 = 0.125f * LOG2E;
constexpr int N_PHASES = 12;
constexpr size_t MiB = 1u << 20;
constexpr size_t WS_CTL = 0, CTL_ZERO_BYTES = 64 * 1024;
constexpr size_t WS_W = 2 * MiB, W_LAYER = 25 * MiB, W_IN = 0, W_OUT = 6 * MiB, W_GU = 8 * MiB, W_DN = 19 * MiB;
constexpr size_t WS_SSA = 52 * MiB, WS_SSB = 56 * MiB;
constexpr size_t WS_HB = 64 * MiB;
constexpr size_t WS_MIX = 192 * MiB;
constexpr size_t WS_PROJ = 320 * MiB;
constexpr size_t WS_END = 704 * MiB;
static_assert(W_DN + (size_t)D * FF * 2 <= W_LAYER && WS_W + 2 * W_LAYER <= WS_SSA && WS_SSB + (size_t)M * 64 <= WS_HB && WS_HB + (size_t)M * D * 2 <= WS_MIX && WS_MIX + (size_t)M * D * 2 <= WS_PROJ && WS_PROJ + (size_t)M * NIN * 2 <= WS_END, "d_ws map");
constexpr size_t WS_LAM = 60 * MiB;
constexpr size_t WS_QN = 61 * MiB, WS_KN = 61 * MiB + 65536;
constexpr int CW_BAR = 1024;
constexpr int RING_OFF = 0, RING_BYTES = 157696;
constexpr int LDSCTL_OFF = RING_BYTES, MISC_OFF = LDSCTL_OFF + 320;
constexpr int LDS_BYTES = 158720;
static_assert(MISC_OFF + 128 <= LDS_BYTES && attn_body::ATTN_LDS_BYTES <= RING_BYTES && pg8::STAGE_BYTES <= RING_BYTES, "LDS map");
#define GAS __attribute__((address_space(1)))
#define LAS __attribute__((address_space(3)))
typedef unsigned short bf16;
typedef unsigned v4u __attribute__((ext_vector_type(4)));
typedef float f32x4 __attribute__((ext_vector_type(4)));
typedef short bf16x8 __attribute__((ext_vector_type(8)));
typedef GAS unsigned gu32;
typedef GAS unsigned long long gu64;
#define RLX_AGENT __ATOMIC_RELAXED, __HIP_MEMORY_SCOPE_AGENT
#define LDS_WAIT() asm volatile("s_waitcnt lgkmcnt(0)" ::: "memory")
#define VM_WAIT() asm volatile("s_waitcnt vmcnt(0)" ::: "memory")
__device__ __forceinline__ unsigned long long rt() { return __builtin_amdgcn_s_memrealtime(); }
__device__ __forceinline__ unsigned f2bf(float f) { unsigned u = __builtin_bit_cast(unsigned, f); return (u + 0x7fffu + ((u >> 16) & 1u)) >> 16; }
__device__ __forceinline__ unsigned pk2(float lo, float hi) { return f2bf(lo) | (f2bf(hi) << 16); }

#define XB_TMO      128
#define XB_XCNT(j)  (256  + 64 * (j))
#define XB_XSUB(j)  (1280 + 64 * (j))
#define XB_XGEN(j)  (2304 + 64 * (j))
#define XB_TOP      3328
#define XB_TOPGEN   3392
#define XCD_BAR_WORDS 3456
#define XB_TAGMAX(j) (3520 + 64 * (j))
#define XB_TAGNEG(j) (4544 + 64 * (j))
#define XB_SPIN_CAP (1u << 22)

__device__ __forceinline__ unsigned xb_ld(unsigned* p)              { return __hip_atomic_load(p, __ATOMIC_RELAXED, __HIP_MEMORY_SCOPE_AGENT); }
__device__ __forceinline__ unsigned xb_add(unsigned* p, unsigned v) { return __hip_atomic_fetch_add(p, v, __ATOMIC_RELAXED, __HIP_MEMORY_SCOPE_AGENT); }
__device__ __forceinline__ unsigned xb_xcc_id() { return (unsigned)__builtin_amdgcn_s_getreg((3 << 11) | 20) & 0xFu; }
#define XB_SPIN(cond, bar) do { unsigned _sp = 0; while (cond) { __builtin_amdgcn_s_sleep(1); \
    if ((++_sp & 255u) == 0u) { if (xb_ld(&(bar)[XB_TMO])) break; if (_sp > XB_SPIN_CAP) { atomicAdd(&(bar)[XB_TMO], 1u); break; } } } } while (0)

struct XcdBarrier {
    unsigned* bar; unsigned x;
    volatile LAS unsigned* st;
};

__device__ __forceinline__ XcdBarrier xcd_barrier_post(unsigned* bar, volatile LAS unsigned* st) {
    XcdBarrier b; b.bar = bar; b.x = xb_xcc_id(); b.st = st;
    if (threadIdx.x == 0) { (void)xb_add(&bar[XB_XCNT(b.x)], 1u);
}
    return b;
}
__device__ __forceinline__ void xcd_barrier_complete(unsigned* bar, unsigned x, unsigned& nloc, unsigned& nx) {
    const unsigned G = gridDim.x * gridDim.y * gridDim.z;
    unsigned sum, cnt, mine, sp = 0u;
    for (;;) {
        sum = 0u; cnt = 0u; mine = 0u;
#pragma unroll
        for (unsigned j = 0; j < 16; ++j) { const unsigned c = xb_ld(&bar[XB_XCNT(j)]); sum += c; cnt += (c > 0u) ? 1u : 0u; mine = (j == x) ? c : mine; }
        if (sum == G) break;
        __builtin_amdgcn_s_sleep(1);
        if ((++sp & 255u) == 0u) { if (xb_ld(&bar[XB_TMO])) break; if (sp > XB_SPIN_CAP) { atomicAdd(&bar[XB_TMO], 1u); break; } }
    }
    nloc = mine > 0u ? mine : 1u; nx = cnt > 0u ? cnt : 1u;
}

__device__ __forceinline__ void xcd_barrier(const XcdBarrier& b, bool may_local = false) {
    asm volatile("s_waitcnt vmcnt(0)" ::: "memory");
    __syncthreads();
    if (threadIdx.x == 0) {
        unsigned* bar = b.bar; unsigned bx_ = b.x; asm volatile("" : "+s"(bx_));
        __builtin_amdgcn_s_waitcnt(0);
        unsigned nloc = b.st[0], nx = b.st[1];
        if (nloc == 0u) { xcd_barrier_complete(bar, bx_, nloc, nx); b.st[0] = nloc; b.st[1] = nx; }
        const unsigned old = xb_add(&bar[XB_XSUB(bx_)], 1u);
        const unsigned gen = old / nloc;
        if (old + 1u == (gen + 1u) * nloc && may_local && b.st[2] != 0u) {
            __builtin_amdgcn_fence(__ATOMIC_ACQUIRE, "agent");
            xb_add(&bar[XB_XGEN(bx_)], 1u);
            asm volatile("s_waitcnt vmcnt(0)" ::: "memory");
        } else
        if (old + 1u == (gen + 1u) * nloc) {
            __builtin_amdgcn_fence(__ATOMIC_RELEASE, "agent");
            asm volatile("s_waitcnt vmcnt(0)" ::: "memory");
            const unsigned og = xb_add(&bar[XB_TOP], 1u);
            const unsigned tg = og / nx;
            if (og + 1u == (tg + 1u) * nx) xb_add(&bar[XB_TOPGEN], 1u);
            else XB_SPIN(xb_ld(&bar[XB_TOPGEN]) == tg, bar);
            __builtin_amdgcn_fence(__ATOMIC_ACQUIRE, "agent");
            xb_add(&bar[XB_XGEN(bx_)], 1u);
            asm volatile("s_waitcnt vmcnt(0)" ::: "memory");
        } else {
            XB_SPIN(xb_ld(&bar[XB_XGEN(bx_)]) == gen, bar);
            __builtin_amdgcn_fence(__ATOMIC_ACQUIRE, "agent");
            asm volatile("s_waitcnt vmcnt(0)" ::: "memory");
        }
    }
    __syncthreads();
}

__device__ __forceinline__ void xcd_tag_post(const XcdBarrier& b) {
    if (threadIdx.x == 0) { unsigned x = b.x; asm volatile("" : "+s"(x)); const unsigned tag = blockIdx.x & 7u;
        (void)__hip_atomic_fetch_max(&b.bar[XB_TAGMAX(x)], tag + 1u, __ATOMIC_RELAXED, __HIP_MEMORY_SCOPE_AGENT);
        (void)__hip_atomic_fetch_max(&b.bar[XB_TAGNEG(x)], 8u - tag, __ATOMIC_RELAXED, __HIP_MEMORY_SCOPE_AGENT); }
}
__device__ __forceinline__ void xcd_local_check(const XcdBarrier& b) {
    if (threadIdx.x == 0) {
        unsigned ok = (gridDim.x * gridDim.y * gridDim.z == 256u) ? 1u : 0u, npop = 0u;
#pragma nounroll
        for (unsigned j_ = 0; j_ < 16; ++j_) { unsigned j = j_; asm volatile("" : "+s"(j));
            const unsigned c = xb_ld(&b.bar[XB_XCNT(j)]);
            if (c) { ++npop; const unsigned tmax = xb_ld(&b.bar[XB_TAGMAX(j)]), tneg = xb_ld(&b.bar[XB_TAGNEG(j)]); if (c != 32u || tmax - 1u != 8u - tneg) ok = 0u; } }
        if (npop != 8u) ok = 0u;
        b.st[2] = ok;
    }
    __syncthreads();
}
struct Frame {
    LAS unsigned char* lds;
    volatile LAS unsigned* MISC;
    gu32* ctl;
    int tid, lane, wave;
    int vcu, G;
};
__device__ __forceinline__ float wave_sum(float v) {
#pragma unroll
    for (int o = 1; o < 64; o <<= 1) v += __shfl_xor(v, o);
    return v;
}
__device__ __forceinline__ float bf2f(bf16 b) { return __builtin_bit_cast(float, (unsigned)b << 16); }
__device__ __forceinline__ float bflo(unsigned w) { return __builtin_bit_cast(float, w << 16); }
__device__ __forceinline__ float bfhi(unsigned w) { return __builtin_bit_cast(float, w & 0xffff0000u); }
__device__ __forceinline__ float lam_init_of(int l) { return l == 0 ? 0.2f : 0.35550907f; }

template <int MODE, bool HAS_GAIN>
__device__ __forceinline__ void p0_transpose_item(const float* W, int K, int N, bf16* WT, const float* gain, LAS float* scr, int item, int lane) {
    const int nblk = N / 32, kb = item / nblk, nb = item % nblk, k0 = 64 * kb, n0 = 32 * nb;
    float cs = 1.f;
    if (MODE == 1) { if (n0 >= C_RK && n0 < C_RV) cs = 0.125f; else if (n0 >= C_DQ && n0 < C_DK) cs = C2; }
#pragma unroll 8
    for (int i = 0; i < 32; ++i) { const int kk = 2 * i + (lane >> 5); const float g = HAS_GAIN ? gain[k0 + kk] * cs : cs; scr[kk * 33 + (lane & 31)] = W[(size_t)(k0 + kk) * N + n0 + (lane & 31)] * g; }
    LDS_WAIT(); asm volatile("" ::: "memory");
    const int c = lane & 7;
#pragma unroll
    for (int j = 0; j < 4; ++j) { const int n = (lane >> 3) + 8 * j; const LAS float* s = scr + (8 * c) * 33 + n;
        v4u o; o.x = pk2(s[0 * 33], s[1 * 33]); o.y = pk2(s[2 * 33], s[3 * 33]); o.z = pk2(s[4 * 33], s[5 * 33]); o.w = pk2(s[6 * 33], s[7 * 33]);
        const int nn = n0 + n; int drow = nn;
        if (MODE == 2) drow = 256 * (nn >> 7) + 64 * ((nn >> 5) & 3) + (nn & 31);
        if (MODE == 3) drow = 256 * (nn >> 7) + 64 * ((nn >> 5) & 3) + 32 + (nn & 31);
        *(GAS v4u*)(WT + (size_t)drow * K + k0 + 8 * c) = o; }
    LDS_WAIT(); asm volatile("" ::: "memory");
}
struct Ptrs {
    const float *x, *attn_norm, *w_in, *ret_norm, *lq1, *lk1, *lq2, *lk2, *diff_norm, *w_out, *ffn_norm, *w_gate, *w_up, *w_down, *final_norm;
    float* out; unsigned char* ws;
};

struct Args { const float* in[15]; float* out; unsigned char* ws; int ph_lo, ph_hi; };
typedef const __attribute__((address_space(4))) Args* KArgsPtr;
__device__ __forceinline__ KArgsPtr kargs() { KArgsPtr p = (KArgsPtr)__builtin_amdgcn_kernarg_segment_ptr(); asm volatile("" : "+s"(p)); return p; }
__device__ __forceinline__ void load_ptrs(Ptrs& P) {
    KArgsPtr a = kargs();
#define GP(T, e) ((T*)(GAS T*)(e))
    P.x = GP(const float, a->in[0]); P.attn_norm = GP(const float, a->in[1]); P.w_in = GP(const float, a->in[2]); P.ret_norm = GP(const float, a->in[3]);
    P.lq1 = GP(const float, a->in[4]); P.lk1 = GP(const float, a->in[5]); P.lq2 = GP(const float, a->in[6]); P.lk2 = GP(const float, a->in[7]);
    P.diff_norm = GP(const float, a->in[8]); P.w_out = GP(const float, a->in[9]); P.ffn_norm = GP(const float, a->in[10]); P.w_gate = GP(const float, a->in[11]);
    P.w_up = GP(const float, a->in[12]); P.w_down = GP(const float, a->in[13]); P.final_norm = GP(const float, a->in[14]);
    P.out = GP(float, a->out); P.ws = GP(unsigned char, a->ws);
#undef GP
}
__device__ __forceinline__ void make_frame(Frame& F, unsigned char* lds) {
    int t = threadIdx.x; asm volatile("" : "+v"(t));
    F.lds = (LAS unsigned char*)lds; F.MISC = (volatile LAS unsigned*)(F.lds + MISC_OFF);
    F.tid = t; F.lane = t & 63; F.wave = __builtin_amdgcn_readfirstlane(t >> 6);
    F.G = gridDim.x; { const int bx = blockIdx.x; F.vcu = (F.G % 8 == 0) ? (bx % 8) * (F.G / 8) + bx / 8 : bx; }
}
__device__ __forceinline__ void p0_prologue(unsigned char* lds_) {
    Frame F; make_frame(F, lds_); Ptrs P; load_ptrs(P);
    LAS float* scr = (LAS float*)(F.lds + RING_OFF + F.wave * 16384);
    const int gw = F.vcu * NWAVES + F.wave, NGW = F.G * NWAVES;
    constexpr int I_IN = (D / 64) * (NIN / 32), I_OUT = (D / 64) * (D / 32), I_G = (D / 64) * (FF / 32), I_DN = (FF / 64) * (D / 32);
    constexpr int I_LAYER = I_IN + I_OUT + 2 * I_G + I_DN;
    for (int it = gw; it < DEPTH * I_LAYER; it += NGW) {
        const int l = it / I_LAYER; int r = it % I_LAYER;
        bf16* wl = (bf16*)(P.ws + WS_W + (size_t)l * W_LAYER);
        if (r < I_IN) { p0_transpose_item<1, true>(P.w_in + (size_t)l * D * NIN, D, NIN, (bf16*)((unsigned char*)wl + W_IN), P.attn_norm + l * D, scr, r, F.lane); continue; } r -= I_IN;
        if (r < I_OUT) { p0_transpose_item<0, false>(P.w_out + (size_t)l * D * D, D, D, (bf16*)((unsigned char*)wl + W_OUT), nullptr, scr, r, F.lane); continue; } r -= I_OUT;
        if (r < I_G) { p0_transpose_item<2, true>(P.w_gate + (size_t)l * D * FF, D, FF, (bf16*)((unsigned char*)wl + W_GU), P.ffn_norm + l * D, scr, r, F.lane); continue; } r -= I_G;
        if (r < I_G) { p0_transpose_item<3, true>(P.w_up + (size_t)l * D * FF, D, FF, (bf16*)((unsigned char*)wl + W_GU), P.ffn_norm + l * D, scr, r, F.lane); continue; } r -= I_G;
        p0_transpose_item<0, false>(P.w_down + (size_t)l * FF * D, FF, D, (bf16*)((unsigned char*)wl + W_DN), nullptr, scr, r, F.lane);
    }
    if (gw == 0) {
        for (int l = 0; l < DEPTH; ++l) { const float s1 = wave_sum(P.lq1[l * 64 + F.lane] * P.lk1[l * 64 + F.lane]), s2 = wave_sum(P.lq2[l * 64 + F.lane] * P.lk2[l * 64 + F.lane]);
            if (F.lane == 0) ((GAS float*)(P.ws + WS_LAM))[l] = __expf(s1) - __expf(s2) + lam_init_of(l); } }
    bf16* hb = (bf16*)(P.ws + WS_HB); float* ssa = (float*)(P.ws + WS_SSA);
    for (int m0 = gw; m0 < M; m0 += 2 * NGW) {
        f32x4 v[2][4]; float s[2] = {0.f, 0.f};
#pragma unroll
        for (int r = 0; r < 2; ++r) { const int m = m0 + r * NGW; const GAS f32x4* xr = (const GAS f32x4*)(P.x + (size_t)(m < M ? m : m0) * D) + F.lane;
#pragma unroll
            for (int j = 0; j < 4; ++j) v[r][j] = xr[64 * j]; }
#pragma unroll
        for (int r = 0; r < 2; ++r) { const int m = m0 + r * NGW; if (m >= M) break;
#pragma unroll
            for (int j = 0; j < 4; ++j) s[r] += (v[r][j].x * v[r][j].x + v[r][j].y * v[r][j].y) + (v[r][j].z * v[r][j].z + v[r][j].w * v[r][j].w);
            s[r] = wave_sum(s[r]);
            GAS unsigned long long* o8 = (GAS unsigned long long*)(hb + (size_t)m * D) + F.lane;
#pragma unroll
            for (int j = 0; j < 4; ++j) o8[64 * j] = (unsigned long long)pk2(v[r][j].x, v[r][j].y) | ((unsigned long long)pk2(v[r][j].z, v[r][j].w) << 32);
            if (F.lane < 16) ssa[(size_t)m * 16 + F.lane] = F.lane == 0 ? s[r] : 0.f; }
    }
}
__device__ __forceinline__ void final_norm_phase(unsigned char* lds_) {
    Frame F; make_frame(F, lds_); Ptrs P; load_ptrs(P);
    const int gw = F.vcu * NWAVES + F.wave, NGW = F.G * NWAVES;
    const bf16* hb = (const bf16*)(P.ws + WS_HB);
    f32x4 g[4];
#pragma unroll
    for (int j = 0; j < 2; ++j) { g[2 * j] = ((const GAS f32x4*)P.final_norm)[128 * j + 2 * F.lane]; g[2 * j + 1] = ((const GAS f32x4*)P.final_norm)[128 * j + 2 * F.lane + 1]; }
    for (int m = gw; m < M; m += NGW) {
        const GAS v4u* hr = (const GAS v4u*)(hb + (size_t)m * D) + F.lane;
        f32x4 v[4]; float s = 0.f;
#pragma unroll
        for (int j = 0; j < 2; ++j) { const v4u w = hr[64 * j];
            v[2 * j] = (f32x4){bflo(w.x), bfhi(w.x), bflo(w.y), bfhi(w.y)}; v[2 * j + 1] = (f32x4){bflo(w.z), bfhi(w.z), bflo(w.w), bfhi(w.w)}; }
#pragma unroll
        for (int j = 0; j < 4; ++j) s += (v[j].x * v[j].x + v[j].y * v[j].y) + (v[j].z * v[j].z + v[j].w * v[j].w);
        const float rs = 1.0f / sqrtf(wave_sum(s) * (1.0f / D) + NORM_EPS);
        GAS f32x4* o = (GAS f32x4*)(P.out + (size_t)m * D);
#pragma unroll
        for (int j = 0; j < 2; ++j) { o[128 * j + 2 * F.lane] = v[2 * j] * rs * g[2 * j]; o[128 * j + 2 * F.lane + 1] = v[2 * j + 1] * rs * g[2 * j + 1]; }
    }
}
template <int KINDS  >
__device__ __forceinline__ void naive_mixer_phase(unsigned char* lds_, int l) {
    Frame F; make_frame(F, lds_); Ptrs P; load_ptrs(P);
    const bf16* proj = (const bf16*)(P.ws + WS_PROJ); bf16* mix = (bf16*)(P.ws + WS_MIX);
    const int gw = F.vcu * NWAVES + F.wave, NGW = F.G * NWAVES, lane = F.lane;
    const float lam_init = lam_init_of(l);
    const float s1 = wave_sum(P.lq1[l * 64 + lane] * P.lk1[l * 64 + lane]), s2 = wave_sum(P.lq2[l * 64 + lane] * P.lk2[l * 64 + lane]);
    const float lam = __expf(s1) - __expf(s2) + lam_init;
    for (int it = gw; it < M * 8; it += NGW) {
        const int m = it >> 3, h = it & 3, kind = (it >> 2) & 1, t = m % SEQ;
        if (!((KINDS >> kind) & 1)) continue;
        const bf16* rowp = proj + (size_t)m * NIN; const bf16* seq0 = proj + (size_t)(m - t) * NIN;
        if (kind == 0) {
            const float q = bf2f(rowp[C_RQ + h * 64 + lane]);
            const float lg = log2f(1.0f - exp2f(-5.0f - (float)h));
            float a0 = 0.f, a1 = 0.f;
            for (int s = 0; s <= t; ++s) { const bf16* pr = seq0 + (size_t)s * NIN;
                const float dot = wave_sum(q * bf2f(pr[C_RK + h * 64 + lane]));
                const float w = dot * exp2f((float)(t - s) * lg);
                const unsigned vv = *(const unsigned*)(pr + C_RV + h * 128 + 2 * lane);
                a0 += w * bflo(vv); a1 += w * bfhi(vv); }
            const float rs = 1.0f / sqrtf(wave_sum(a0 * a0 + a1 * a1) * (1.0f / 128.0f) + NORM_EPS);
            const unsigned gg = *(const unsigned*)(rowp + C_RG + h * 128 + 2 * lane);
            const float g0 = bflo(gg), g1 = bfhi(gg);
            const float y0 = a0 * rs * P.ret_norm[l * 128 + 2 * lane], y1 = a1 * rs * P.ret_norm[l * 128 + 2 * lane + 1];
            const float o0 = g0 / (1.0f + __expf(-g0)) * y0, o1 = g1 / (1.0f + __expf(-g1)) * y1;
            *(unsigned*)(mix + (size_t)m * D + h * 128 + 2 * lane) = pk2(o0, o1);
        } else {
            const float cs = exp2f(-8.0f * (float)(h + 1) / 4.0f) * LOG2E;
            float oj[2][2];
#pragma unroll
            for (int j = 0; j < 2; ++j) {
                const float q = bf2f(rowp[C_DQ + h * 128 + j * 64 + lane]);
                float mx = -INFINITY, lsum = 0.f, a0 = 0.f, a1 = 0.f;
                for (int s = 0; s <= t; ++s) { const bf16* pr = seq0 + (size_t)s * NIN;
                    const float sc = wave_sum(q * bf2f(pr[C_DK + h * 128 + j * 64 + lane])) - cs * (float)(t - s);
                    const unsigned vv = *(const unsigned*)(pr + C_DV + h * 128 + 2 * lane);
                    const float mn = fmaxf(mx, sc), f = exp2f(mx - mn), p = exp2f(sc - mn);
                    lsum = lsum * f + p; a0 = a0 * f + p * bflo(vv); a1 = a1 * f + p * bfhi(vv); mx = mn; }
                oj[j][0] = a0 / lsum; oj[j][1] = a1 / lsum;
            }
            const float d0 = oj[0][0] - lam * oj[1][0], d1 = oj[0][1] - lam * oj[1][1];
            const float rs = 1.0f / sqrtf(wave_sum(d0 * d0 + d1 * d1) * (1.0f / 128.0f) + NORM_EPS) * (1.0f - lam_init);
            *(unsigned*)(mix + (size_t)m * D + 512 + h * 128 + 2 * lane) = pk2(d0 * rs * P.diff_norm[l * 128 + 2 * lane], d1 * rs * P.diff_norm[l * 128 + 2 * lane + 1]);
        }
    }
}


template <int KIND  >
__device__ __forceinline__ void mixer_finalize(const Ptrs& P, int l, char* lds, long row0  , int h, float lam_init) {
    int ln = threadIdx.x & 63; asm volatile("" : "+v"(ln));
    const int wv = __builtin_amdgcn_readfirstlane((int)threadIdx.x >> 6);
    const GAS float* dn = (const GAS float*)((KIND == 0 ? P.diff_norm : P.ret_norm) + l * 128); asm volatile("" : "+s"(dn));
    const attn_body::bf16* stg = (const attn_body::bf16*)(lds + attn_body::LDS_OST) + wv * 4096;
    const int ch = ln & 15;
    float gd[8];
#pragma unroll
    for (int e = 0; e < 8; ++e) gd[e] = dn[ch * 8 + e];
    const int colo = (KIND == 0 ? 512 : 0) + h * 128 + ch * 8;
    unsigned short* mixrow = (unsigned short*)(P.ws + WS_MIX) + (size_t)row0 * D + colo;
    const unsigned short* gaterow = (const unsigned short*)(P.ws + WS_PROJ) + (size_t)row0 * NIN + C_RG + h * 128 + ch * 8;
    v4u av[8]; float qv[8]; v4u gv[8];
#pragma unroll
    for (int k = 0; k < 8; ++k) { const int row = k * 4 + (ln >> 4);
        av[k] = *(const v4u*)(stg + row * 128 + ch * 8);
        if (KIND == 1) gv[k] = *(const GAS v4u*)(gaterow + (size_t)row * NIN); }
#pragma unroll
    for (int k = 0; k < 8; ++k) { const v4u a = av[k];
        const float v0 = bflo(a.x), v1 = bfhi(a.x), v2 = bflo(a.y), v3 = bfhi(a.y), v4 = bflo(a.z), v5 = bfhi(a.z), v6 = bflo(a.w), v7 = bfhi(a.w);
        qv[k] = ((v0 * v0 + v1 * v1) + (v2 * v2 + v3 * v3)) + ((v4 * v4 + v5 * v5) + (v6 * v6 + v7 * v7)); }
#pragma unroll
    for (int o = 1; o < 16; o <<= 1) {
#pragma unroll
        for (int k = 0; k < 8; ++k) qv[k] += __shfl_xor(qv[k], o); }
#pragma unroll
    for (int k = 0; k < 8; ++k) { const int row = k * 4 + (ln >> 4); const v4u a = av[k];
        float v[8];
        v[0] = bflo(a.x); v[1] = bfhi(a.x); v[2] = bflo(a.y); v[3] = bfhi(a.y); v[4] = bflo(a.z); v[5] = bfhi(a.z); v[6] = bflo(a.w); v[7] = bfhi(a.w);
        const float rs = (KIND == 0 ? (1.0f - lam_init) : 1.0f) / sqrtf(qv[k] * (1.0f / 128.0f) + NORM_EPS);
#pragma unroll
        for (int e = 0; e < 8; ++e) v[e] *= rs * gd[e];
        if (KIND == 1) {
            const v4u g0 = gv[k];
            float g[8];
            g[0] = bflo(g0.x); g[1] = bfhi(g0.x); g[2] = bflo(g0.y); g[3] = bfhi(g0.y); g[4] = bflo(g0.z); g[5] = bfhi(g0.z); g[6] = bflo(g0.w); g[7] = bfhi(g0.w);
#pragma unroll
            for (int e = 0; e < 8; ++e) v[e] *= g[e] * __builtin_amdgcn_rcpf(1.0f + __builtin_amdgcn_exp2f(g[e] * -LOG2E));
        }
        v4u o0;
        o0.x = pk2(v[0], v[1]); o0.y = pk2(v[2], v[3]); o0.z = pk2(v[4], v[5]); o0.w = pk2(v[6], v[7]);
        *(GAS v4u*)(mixrow + (size_t)row * D) = o0; }
    asm volatile("s_waitcnt lgkmcnt(0)" ::: "memory");
}
__device__ __forceinline__ int diff_tskip(const float* qn, const float* kn, int b, int hj, int qb, float cs) {
    const float* q4 = qn + (b * 8 + hj) * 32 + 4 * qb; const float* kt = kn + (b * 8 + hj) * 32;
    const float Qn = sqrtf(fmaxf(fmaxf(q4[0], q4[1]), fmaxf(q4[2], q4[3]))) * 1.01f;
    const float Ku = sqrtf(fmaxf(fmaxf(kt[4 * qb], kt[4 * qb + 1]), fmaxf(kt[4 * qb + 2], kt[4 * qb + 3]))) * 1.01f;
    int ts = 0;
    for (int t = 0; t + 1 < 4 * qb; t += 2) {
        const float km = sqrtf(fmaxf(kt[t], kt[t + 1])) * 1.01f;
        if (cs * (float)(256 * qb - 64 * (t + 1) - 63) - Qn * (km + Ku) >= 35.0f) ts = t + 2; else break;
    }
    return __builtin_amdgcn_readfirstlane(ts);
}
constexpr int MIX_NITEM = 36;
constexpr unsigned char MIX_ITEM[MIX_NITEM] = {23, 31, 22, 30, 21, 29, 12, 13, 14, 15, 20, 28, 32, 33, 34, 35, 11, 19, 27, 10, 18, 26, 2, 3, 4, 5, 6, 7, 1, 9, 17, 25, 0, 8, 16, 24};
__device__ __forceinline__ int mix_claim(gu32* ctr, volatile LAS unsigned* mb, int k) {
    if (threadIdx.x == 0) mb[16 + (k & 1)] = __hip_atomic_fetch_add((unsigned*)ctr, 1u, __ATOMIC_RELAXED, __HIP_MEMORY_SCOPE_AGENT);
    __syncthreads();
    return __builtin_amdgcn_readfirstlane((int)mb[16 + (k & 1)]);
}
__device__ __forceinline__ void mixer_phase(unsigned char* lds_, int l, int q_ = 0) {
    Frame F; make_frame(F, lds_); Ptrs P; load_ptrs(P); char* lds = (char*)lds_ + RING_OFF;
    using attn_body::attn_unit;
    const attn_body::bf16* proj = (const attn_body::bf16*)(P.ws + WS_PROJ);
    const float lam_init = lam_init_of(l);
    const float lam = __builtin_bit_cast(float, __builtin_amdgcn_readfirstlane(__builtin_bit_cast(int, ((const GAS float*)(P.ws + WS_LAM))[l])));
    const int b = F.vcu >> 3;
    const long rowbase = (long)b * SEQ;
    volatile LAS int* tst = (volatile LAS int*)(F.lds + LDSCTL_OFF + 512);
    { int tsv = 0;
#if !NO_TSKIP
      LAS float* ldn = (LAS float*)(F.lds + RING_OFF);
      if (F.tid < 256) { ldn[F.tid] = ((const GAS float*)(P.ws + WS_QN))[b * 256 + F.tid]; ldn[256 + F.tid] = ((const GAS float*)(P.ws + WS_KN))[b * 256 + F.tid]; }
      __syncthreads();
      const int hj = F.lane >> 3, qb = F.lane & 7; const float cs = exp2f(-2.0f * (float)((hj >> 1) + 1)) * LOG2E;
      const LAS float* q4 = ldn + hj * 32 + 4 * qb; const LAS float* kt = ldn + 256 + hj * 32;
      const float Qn = sqrtf(fmaxf(fmaxf(q4[0], q4[1]), fmaxf(q4[2], q4[3]))) * 1.01f;
      const float Ku = sqrtf(fmaxf(fmaxf(kt[4 * qb], kt[4 * qb + 1]), fmaxf(kt[4 * qb + 2], kt[4 * qb + 3]))) * 1.01f;
      for (int t = 0; t + 1 < 4 * qb; t += 2) {
          const float km = sqrtf(fmaxf(kt[t], kt[t + 1])) * 1.01f;
          if (cs * (float)(256 * qb - 64 * (t + 1) - 63) - Qn * (km + Ku) >= 35.0f) tsv = t + 2; else break;
      }
#endif
      if (F.wave == 0) tst[F.lane] = tsv;
      __syncthreads(); }
#define TSK(h, j, qb) __builtin_amdgcn_readfirstlane(tst[(2 * (h) + (j)) * 8 + (qb)])
#define GO(c) (((c) >> 6) * (M * 64))
    gu32* ctr = (gu32*)(P.ws + WS_CTL) + (l * 32 + b) * 16 + 8 * q_;
    int slot = 0; attn_body::bf16x8 qr[4]; bool pre = false;
    attn_body::f32x16 T;
#pragma unroll
    for (int r = 0; r < 16; ++r) T[r] = 0.f;
    int nclaim = 0;
    int cur = mix_claim(ctr, F.MISC, nclaim++);
    while (cur < MIX_NITEM) {
        const int nxt = mix_claim(ctr, F.MISC, nclaim++);
        const int it = MIX_ITEM[cur]; const int nit = nxt < MIX_NITEM ? (int)MIX_ITEM[nxt] : -1;
        if (it < 32) {
            const int h = it >> 3, qb = it & 7;
            const float cs = __builtin_bit_cast(float, __builtin_amdgcn_readfirstlane(__builtin_bit_cast(int, exp2f(-2.0f * (float)(h + 1)) * LOG2E)));
            const attn_body::PassArgs a1{qb, GO(C_DQ + h * 128), GO(C_DK + h * 128), GO(C_DV + h * 128), TSK(h, 0, qb)};
            const attn_body::PassArgs a2{qb, GO(C_DQ + h * 128 + 64), GO(C_DK + h * 128 + 64), GO(C_DV + h * 128), TSK(h, 1, qb)};
            attn_body::PassArgs nx = a1; const bool more = nit >= 0;
            if (nit >= 32) nx = attn_body::PassArgs{0, GO(C_RQ + (nit - 32) * 64), GO(C_RK + (nit - 32) * 64), GO(C_RV + (nit - 32) * 128), 0};
            else if (nit >= 0) { const int h2 = nit >> 3, qb2 = nit & 7; nx = attn_body::PassArgs{qb2, GO(C_DQ + h2 * 128), GO(C_DK + h2 * 128), GO(C_DV + h2 * 128), TSK(h2, 0, qb2)}; }
            attn_unit<ATT_THR, 0>(proj, rowbase, a1, cs, lam, lds, slot, pre, qr, true, a2, T);
            attn_unit<ATT_THR, 1>(proj, rowbase, a2, cs, lam, lds, slot, true, qr, more, nx, T);
            mixer_finalize<0>(P, l, lds, rowbase + qb * 256 + F.wave * 32, h, lam_init);
            pre = more;
        } else {
            const int h = it - 32;
            const float lg = h == 0 ? -0.04580368961312479f : h == 1 ? -0.02272007650008353f : h == 2 ? -0.011315313227834146f : -0.005646563141142063f;
            const GAS float* gn = (const GAS float*)(P.ret_norm + l * 128); asm volatile("" : "+s"(gn));
            attn_body::ret_chain(proj, rowbase, GO(C_RQ + h * 64), GO(C_RK + h * 64), GO(C_RV + h * 128), GO(C_RG + h * 128), lg, lds, slot, pre, gn, (unsigned short*)(P.ws + WS_MIX) + h * 128, D);
            pre = false;
            asm volatile("" : "=v"(qr[0]), "=v"(qr[1]), "=v"(qr[2]), "=v"(qr[3]));
        }
        cur = nxt;
    }
#undef TSK
#undef GO
}

template <int l>
__device__ __forceinline__ void layer_phases(const XcdBarrier& bar, unsigned char* lds, int lo, int hi) {
#define GRID_BAR() do { if (!MK_PER_PHASE) xcd_barrier(bar, true); } while (0)
#define GRID_BAR_G() do { if (!MK_PER_PHASE) xcd_barrier(bar); } while (0)
#define IN(k) (lo <= (k) && (k) < hi)
#define BOTH(k) (IN(k) && IN((k) + 1))
#define LP_SETUP() Ptrs P; load_ptrs(P); const int G_ = gridDim.x; LAS unsigned char* ldsr = (LAS unsigned char*)lds + RING_OFF; \
    bf16* hb = (bf16*)(P.ws + WS_HB); bf16* mixb = (bf16*)(P.ws + WS_MIX); bf16* projb = (bf16*)(P.ws + WS_PROJ); bf16* hidb = (bf16*)(P.ws + WS_PROJ); \
    float* ssa = (float*)(P.ws + WS_SSA); float* ssb = (float*)(P.ws + WS_SSB); const unsigned char* wl = P.ws + WS_W + (size_t)l * W_LAYER; \
    (void)hb; (void)mixb; (void)projb; (void)hidb; (void)ssa; (void)ssb; (void)wl
        const int pb = 1 + 5 * l;
        if (IN(pb)) {
            LP_SETUP();
            pg8::Gemm g{hb, (const bf16*)(wl + W_IN), M, NIN, D}; pg8::StaticOrder S; S.init(M, NIN, G_, (int)blockIdx.x);
            pg8::EpiProj E{projb, 64, ssa, (float*)(P.ws + WS_QN), (float*)(P.ws + WS_KN), (long)M * 64, (const LAS float*)(ldsr + pg8::SS_LDS_OFF)};
            for (int rep_ = 0; rep_ < (PROBE_DUP == 1 ? 2 : 1); ++rep_) {
            pg8::gemm_phase<pg8::EpiProj, pg8::StaticOrder, PG8_ALIGN, PG8_SP2>(ldsr, g, S, E);
            if (BOTH(pb)) GRID_BAR(); }
        }
        if (IN(pb + 1)) {
#if PROBE_DUP == 2
            mixer_phase(lds, l, 1); if (BOTH(pb + 1)) GRID_BAR();
#endif
            mixer_phase(lds, l);
#if RET_NAIVE
            naive_mixer_phase<1>(lds, l);
#endif
            if (BOTH(pb + 1)) GRID_BAR();
        }
        if (IN(pb + 2)) {
            LP_SETUP();
            pg8::Gemm g{mixb, (const bf16*)(wl + W_OUT), M, D, D}; pg8::StaticOrder S; S.init(M, D, G_, (int)blockIdx.x);
            for (int rep_ = 0; rep_ < (PROBE_DUP == 3 ? 2 : 1); ++rep_) {
            const bool dummy_ = (PROBE_DUP == 3) && rep_ == 0;
            pg8::EpiResid E{hb, dummy_ ? projb : hb, dummy_ ? (float*)(P.ws + WS_END) : ssb};
            pg8::gemm_phase<pg8::EpiResid, pg8::StaticOrder, PG8_ALIGN, PG8_SP2>(ldsr, g, S, E);
            if (BOTH(pb + 2)) GRID_BAR(); }
        }
        if (IN(pb + 3)) {
            LP_SETUP();
            pg8::Gemm g{hb, (const bf16*)(wl + W_GU), M, NGU, D};
#if PROBE_DUP == 7
            typedef pg8::DupOrder P4Order;
#else
            typedef pg8::StaticOrder P4Order;
#endif
            P4Order S; S.init(M, NGU, G_, (int)blockIdx.x);
            pg8::EpiSwiglu E{hidb, (long)M * 32, ssb, (const LAS float*)(ldsr + pg8::SS_LDS_OFF)};
            for (int rep_ = 0; rep_ < (PROBE_DUP == 4 ? 2 : 1); ++rep_) {
            pg8::gemm_phase<pg8::EpiSwiglu, P4Order, PG8_ALIGN, PG8_SP2>(ldsr, g, S, E);
            if (BOTH(pb + 3)) GRID_BAR(); }
        }
        if (IN(pb + 4)) {
            LP_SETUP();
            pg8::Gemm g{hidb, (const bf16*)(wl + W_DN), M, D, FF, 32, (long)M * 32}; pg8::StaticOrder S; S.init(M, D, G_, (int)blockIdx.x);
            for (int rep_ = 0; rep_ < (PROBE_DUP == 5 ? 2 : 1); ++rep_) {
            const bool dummy_ = (PROBE_DUP == 5) && rep_ == 0;
            pg8::EpiResid E{hb, dummy_ ? mixb : hb, dummy_ ? (float*)(P.ws + WS_END) : ssa};
            pg8::gemm_phase<pg8::EpiResid, pg8::StaticOrder, PG8_ALIGN, PG8_SP2>(ldsr, g, S, E);
            if (BOTH(pb + 4)) { if (l == DEPTH - 1) GRID_BAR_G(); else GRID_BAR(); } }
        }
    #undef IN
#undef BOTH
#undef GRID_BAR
#undef GRID_BAR_G
#undef LP_SETUP
}

__global__ void __launch_bounds__(NWAVES * 64, 2) hybrid_fwd(Args args) {
    extern __shared__ __attribute__((aligned(16))) unsigned char lds[];
    for (int u = threadIdx.x; u < (LDS_BYTES - LDSCTL_OFF) / 4; u += NWAVES * 64) ((LAS unsigned*)((LAS unsigned char*)lds + LDSCTL_OFF))[u] = 0u;
    __syncthreads();
    unsigned* barw = (unsigned*)(args.ws + WS_CTL) + CW_BAR;
    XcdBarrier bar; bar.bar = barw; bar.x = 0; bar.st = nullptr;
    if (!MK_PER_PHASE) bar = xcd_barrier_post(barw, (volatile LAS unsigned*)((LAS unsigned char*)lds + MISC_OFF) + 8);
#define GRID_BAR() do { if (!MK_PER_PHASE) xcd_barrier(bar); } while (0)
    const int lo = args.ph_lo, hi = args.ph_hi;
#define IN(k) (lo <= (k) && (k) < hi)
#define BOTH(k) (IN(k) && IN((k) + 1))
    for (int rep_ = 0; rep_ < (PROBE_DUP == 6 ? 2 : 1); ++rep_) if (IN(0)) { p0_prologue(lds); if (BOTH(0)) { if (!MK_PER_PHASE) xcd_tag_post(bar); GRID_BAR(); if (!MK_PER_PHASE) xcd_local_check(bar); } }
    layer_phases<0>(bar, lds, lo, hi);
    layer_phases<1>(bar, lds, lo, hi);
    if (IN(11)) final_norm_phase(lds);
#undef IN
#undef BOTH
#undef GRID_BAR
}

extern "C" void kernel_launch(void* const* d_in, const int* in_sizes, int n_in, void* d_out, int out_size, void* d_ws, size_t ws_size, hipStream_t stream) {
    static int grid = 0;
    if (grid == 0) {
        if (n_in != 15 || in_sizes[0] != M * D || out_size != M * D || ws_size < WS_END) { fprintf(stderr, "kernel_launch: unexpected shapes (n_in %d, in0 %d, out %d, ws %zu; need ws >= %zu); nothing launched\n", n_in, n_in > 0 ? in_sizes[0] : -1, out_size, ws_size, (size_t)WS_END); grid = -1; return; }
        int dev = 0, cus = 0, per_cu = 0;
        if (hipGetDevice(&dev) != hipSuccess || hipDeviceGetAttribute(&cus, hipDeviceAttributeMultiprocessorCount, dev) != hipSuccess) { grid = -1; return; }
        if (hipFuncSetAttribute((const void*)hybrid_fwd, hipFuncAttributeMaxDynamicSharedMemorySize, LDS_BYTES) != hipSuccess) { fprintf(stderr, "kernel_launch: hipFuncSetAttribute failed\n"); grid = -1; return; }
        if (hipOccupancyMaxActiveBlocksPerMultiprocessor(&per_cu, (const void*)hybrid_fwd, NWAVES * 64, LDS_BYTES) != hipSuccess || per_cu < 1) { fprintf(stderr, "kernel_launch: occupancy query reports %d workgroups per CU\n", per_cu); (void)hipGetLastError(); grid = -1; return; }
        if (cus != 256) { fprintf(stderr, "kernel_launch: built for 256 CUs (the mixer's unit deal), found %d; nothing launched\n", cus); grid = -1; return; }
        grid = cus;
    }
    if (grid < 0) return;
    if (hipMemsetAsync((char*)d_ws + WS_CTL, 0, CTL_ZERO_BYTES, stream) != hipSuccess) return;
    Args a{};
    for (int i = 0; i < 15; ++i) a.in[i] = (const float*)d_in[i];
    a.out = (float*)d_out; a.ws = (unsigned char*)d_ws;
#if MK_PER_PHASE
    for (int p = 0; p < N_PHASES; ++p) { a.ph_lo = p; a.ph_hi = p + 1; hipLaunchKernelGGL(hybrid_fwd, dim3(grid), dim3(NWAVES * 64), LDS_BYTES, stream, a); }
#else
    a.ph_lo = 0; a.ph_hi = N_PHASES;
    hipLaunchKernelGGL(hybrid_fwd, dim3(grid), dim3(NWAVES * 64), LDS_BYTES, stream, a);
#endif
}
```

```cpp
#include <hip/hip_runtime.h>
#include <cstdio>
#include <cstdint>
namespace pg8 {
#define PG8_LAS __attribute__((address_space(3)))
typedef unsigned short bf16_t;
typedef short bf16x8 __attribute__((ext_vector_type(8)));
typedef float f32x4 __attribute__((ext_vector_type(4)));
typedef unsigned u32x4 __attribute__((ext_vector_type(4)));
constexpr int BM = 256, BK = 64, HALF = 128, HTB = HALF * BK * 2  , STAGE_BYTES = 8 * HTB, NXCD = 8, WGM = 8;

__host__ __device__ __forceinline__ int lds_byte(int r, int c) { const int st = (r >> 4) * 2 + (c >> 5), rr = r & 15, cc = c & 31, ob = rr * 64 + cc * 2; return st * 1024 + (ob ^ (((ob >> 9) & 1) << 5)); }
__host__ __device__ __forceinline__ void stage_rc(int b, int& R, int& C) { const int st = b / 1024, sb = b % 1024, swz = sb ^ (((sb >> 9) & 1) << 5); R = (st >> 1) * 16 + swz / 64; C = (st & 1) * 32 + (swz % 64) / 2; }
__host__ __device__ __forceinline__ int perm32(int rho) { const int n = rho >> 4, i = rho & 15; return 8 * (i >> 2) + 4 * n + (i & 3); }

struct Unit { int pm, pn; };
struct Gemm { const bf16_t* A; const bf16_t* Bt; int M, N, K; int a_gc = 0; long a_gs = 0; };

struct StaticOrder {
    int nM, nN, nwg, G, c;
    __host__ __device__ void init(int M, int N, int G_, int c_) { nM = M / BM; nN = N / BM; nwg = nM * nN; G = G_; c = c_; }
    __host__ __device__ bool next(int i, Unit& u) const {
        if (G == 256 && WGM == 8 && NXCD == 8 && (nM & 7) == 0) {
            if (i * 256 + c >= nwg) return false;
            const int w = i * 32 + (c >> 3), x = w >> 3, k = (x >= nN) + (x >= 2 * nN) + (x >= 3 * nN);
            u.pm = 8 * (4 * (c & 7) + k) + (w & 7); u.pn = x - k * nN; return true; }
        const long L = (long)i * G + c; if (L >= nwg) return false;
        int wgid = (int)L; { const int q = nwg / NXCD, r = nwg % NXCD, xcd = wgid % NXCD, off = wgid / NXCD; wgid = (xcd < r ? xcd * (q + 1) : r * (q + 1) + (xcd - r) * q) + off; }
        const int nig = WGM * nN, gid = wgid / nig, fm = gid * WGM, gsz = (nM - fm) < WGM ? (nM - fm) : WGM;
        u.pm = fm + ((wgid % nig) % gsz); u.pn = (wgid % nig) / gsz; return true;
    }
    __device__ __forceinline__ void a_ready(const Unit&) const {}
    __device__ __forceinline__ void done(const Unit&) const {}
    __device__ __forceinline__ bool emit(int) const { return true; }
};
struct DupOrder : StaticOrder {
    __host__ __device__ bool next(int i, Unit& u) const { return StaticOrder::next(i >> 1, u); }
    __device__ __forceinline__ bool emit(int ui) const { return (ui & 1) != 0; }
};

__device__ __forceinline__ unsigned cvt_pk_bf16(float lo, float hi) { unsigned r; asm volatile("v_cvt_pk_bf16_f32 %0, %1, %2" : "=v"(r) : "v"(lo), "v"(hi)); return r; }
typedef float f32x2 __attribute__((ext_vector_type(2)));
typedef __bf16 bf16x2v __attribute__((ext_vector_type(2)));
__device__ __forceinline__ unsigned cvt_pk2(f32x2 v) { return __builtin_bit_cast(unsigned, __builtin_convertvector(v, bf16x2v)); }
typedef unsigned u32x2 __attribute__((ext_vector_type(2)));
#ifndef RET_NAIVE
#define RET_NAIVE 0
#endif
#ifndef PROBE_DUP
#define PROBE_DUP 0
#endif
constexpr bool RET_NAIVE_EPI = RET_NAIVE;
constexpr float NORM_EPS = 1e-6f;
__device__ __forceinline__ float row_rstd(const float* ss, int row, int fq) {
    const f32x4 s4 = *(const f32x4*)(ss + (size_t)row * 16 + 4 * fq);
    float s = (s4[0] + s4[1]) + (s4[2] + s4[3]); s += __shfl_xor(s, 16); s += __shfl_xor(s, 32);
    return __builtin_amdgcn_rsqf(s * (1.0f / 1024.0f) + NORM_EPS);
}
constexpr int SS_LDS_OFF = STAGE_BYTES;
__device__ __forceinline__ float row_rstd_l(const PG8_LAS float* ssl, int rl, int fq) {
    const f32x4 s4 = *(const PG8_LAS f32x4*)(ssl + rl * 16 + 4 * fq);
    float s = (s4[0] + s4[1]) + (s4[2] + s4[3]); s += __shfl_xor(s, 16); s += __shfl_xor(s, 32);
    return __builtin_amdgcn_rsqf(s * (1.0f / 1024.0f) + NORM_EPS);
}
__device__ __forceinline__ unsigned dpp_ror8(unsigned v) { return (unsigned)__builtin_amdgcn_update_dpp((int)v, (int)v, 0x128, 0xf, 0xf, false); }
struct EpiProj {
    static constexpr bool PERM = true, AFTER_DRAIN = false, PROBE_TWICE = (PROBE_DUP == 8), LDS_SS = true, ACC_INIT = false;
    bf16_t* O; int ldc; const float* ss; float* qn; float* kn; long gstr; const PG8_LAS float* ssl;
    __device__ __forceinline__ void operator()(const f32x4 (&acc)[2][2][4][2], const Unit& u, int wr, int wc, int fr, int fq) const {
        const int row0 = u.pm * BM + wr * 64 + fr, col0 = u.pn * BM + wc * 64 + 8 * fq;
        const bool gate_tile = !RET_NAIVE_EPI && (u.pn == 4 || u.pn == 5);
        const bool nrm_tile = (u.pn >= 6 && u.pn < 10);
        float lgv = 0.f; int rmask = 0;
        if (!RET_NAIVE_EPI && u.pn < 2) { const int hh = wc; const float lg = hh == 0 ? -0.04580368961312479f : hh == 1 ? -0.02272007650008353f : hh == 2 ? -0.011315313227834146f : -0.005646563141142063f;
            lgv = u.pn == 0 ? lg : -lg; rmask = 63; }
        float nmx[2] = {0.f, 0.f};
        float rsv[2][4];
#pragma unroll
        for (int ai = 0; ai < 2; ++ai)
#pragma unroll
            for (int m = 0; m < 4; ++m) rsv[ai][m] = row_rstd_l(ssl, wr * 64 + fr + ai * HALF + m * 16, fq);
        const bool lo8 = fr < 8;
        const bool timg = (u.pn < 2) || nrm_tile;
        const bool vimg = (u.pn == 2 || u.pn == 3 || u.pn >= 10);
        bf16_t* obase = O + (size_t)(4 * u.pn + wc) * (size_t)gstr + (timg ? (size_t)(4 * u.pm + wr) * 4096 + ((lo8 ? 0 : 4) + fq) * 512 + (fr & 7) * 8
                                                                      : vimg ? (size_t)(4 * u.pm + wr) * 4096 + (lo8 ? 0 : 2048) + (fr & 7) * 32 + 8 * fq
                                                                      : (size_t)(u.pm * BM + wr * 64 + (fr & 7)) * ldc + 8 * fq + (lo8 ? 0 : 32));
        const int st_m = timg ? 128 : vimg ? 512 : 16 * ldc, st_y = timg ? 64 : vimg ? 256 : 8 * ldc;
#pragma unroll
        for (int ai = 0; ai < 2; ++ai)
#pragma unroll
            for (int m = 0; m < 4; ++m) { const int row = row0 + ai * HALF + m * 16;
                const float sc = rsv[ai][m] * __builtin_amdgcn_exp2f(lgv * (float)(row & rmask)); const f32x2 sc2 = {sc, sc};
                f32x2 V[2][4];
#pragma unroll
                for (int bj = 0; bj < 2; ++bj)
#pragma unroll
                    for (int n = 0; n < 2; ++n)
#pragma unroll
                        for (int p = 0; p < 2; ++p) V[bj][2 * n + p] = (f32x2){acc[ai][bj][m][n][2 * p], acc[ai][bj][m][n][2 * p + 1]} * sc2;
                if (gate_tile) {
                    const f32x2 nl2 = {-1.4426950408889634f, -1.4426950408889634f}, one = {1.0f, 1.0f};
#pragma unroll
                    for (int bj = 0; bj < 2; ++bj) { f32x2 X[4];
#pragma unroll
                        for (int k = 0; k < 4; ++k) X[k] = V[bj][k] * nl2;
#pragma unroll
                        for (int k = 0; k < 4; ++k) X[k] = (f32x2){__builtin_amdgcn_exp2f(X[k][0]), __builtin_amdgcn_exp2f(X[k][1])};
#pragma unroll
                        for (int k = 0; k < 4; ++k) X[k] = X[k] + one;
#pragma unroll
                        for (int k = 0; k < 4; ++k) X[k] = (f32x2){__builtin_amdgcn_rcpf(X[k][0]), __builtin_amdgcn_rcpf(X[k][1])};
#pragma unroll
                        for (int k = 0; k < 4; ++k) V[bj][k] = V[bj][k] * X[k]; } }
                if (nrm_tile) { f32x2 q2 = V[0][0] * V[0][0];
#pragma unroll
                    for (int k = 1; k < 8; ++k) { const f32x2 v = V[k >> 2][k & 3]; q2 = v * v + q2; }
                    float nq = q2[0] + q2[1]; nq += __shfl_xor(nq, 16); nq += __shfl_xor(nq, 32); nmx[ai] = fmaxf(nmx[ai], nq); }
                u32x4 w[2];
#pragma unroll
                for (int bj = 0; bj < 2; ++bj) { w[bj].x = cvt_pk2(V[bj][0]); w[bj].y = cvt_pk2(V[bj][1]); w[bj].z = cvt_pk2(V[bj][2]); w[bj].w = cvt_pk2(V[bj][3]); }
                u32x4 t, p; t.x = lo8 ? w[1].x : w[0].x; t.y = lo8 ? w[1].y : w[0].y; t.z = lo8 ? w[1].z : w[0].z; t.w = lo8 ? w[1].w : w[0].w;
                p.x = dpp_ror8(t.x); p.y = dpp_ror8(t.y); p.z = dpp_ror8(t.z); p.w = dpp_ror8(t.w);
                u32x4 x, y;
                x.x = lo8 ? w[0].x : p.x; x.y = lo8 ? w[0].y : p.y; x.z = lo8 ? w[0].z : p.z; x.w = lo8 ? w[0].w : p.w;
                y.x = lo8 ? p.x : w[1].x; y.y = lo8 ? p.y : w[1].y; y.z = lo8 ? p.z : w[1].z; y.w = lo8 ? p.w : w[1].w;
                bf16_t* gp = obase + ai * 8192 + m * st_m;
                *(u32x4*)gp = x; *(u32x4*)(gp + st_y) = y; }
        if (nrm_tile) {
#pragma unroll
            for (int ai = 0; ai < 2; ++ai) { float v = nmx[ai];
                v = fmaxf(v, __builtin_bit_cast(float, __builtin_amdgcn_update_dpp(0, __builtin_bit_cast(int, v), 0x128, 0xf, 0xf, false)));
                v = fmaxf(v, __builtin_bit_cast(float, __builtin_amdgcn_update_dpp(0, __builtin_bit_cast(int, v), 0x124, 0xf, 0xf, false)));
                v = fmaxf(v, __builtin_bit_cast(float, __builtin_amdgcn_update_dpp(0, __builtin_bit_cast(int, v), 0x122, 0xf, 0xf, false)));
                v = fmaxf(v, __builtin_bit_cast(float, __builtin_amdgcn_update_dpp(0, __builtin_bit_cast(int, v), 0x121, 0xf, 0xf, false)));
                if (fr == 0 && fq == 0) { const int b = u.pm >> 3, sub = (u.pm & 7) * 4 + 2 * ai + wr;
                    if (u.pn < 8) qn[(b * 8 + (u.pn - 6) * 4 + wc) * 32 + sub] = v; else kn[(b * 8 + (u.pn - 8) * 4 + wc) * 32 + sub] = v; } }
        }
    }
};
struct EpiSwiglu {
    static constexpr bool PERM = true, AFTER_DRAIN = false, PROBE_TWICE = (PROBE_DUP == 9), LDS_SS = true, ACC_INIT = false;
    bf16_t* O; long gstr; const float* ss; const PG8_LAS float* ssl;
    __device__ __forceinline__ void operator()(const f32x4 (&acc)[2][2][4][2], const Unit& u, int wr, int wc, int fr, int fq) const {
        const int row0 = u.pm * BM + wr * 64 + fr; bf16_t* ob = O + (size_t)(4 * u.pn + wc) * (size_t)gstr + 8 * fq;
        float rsv[2][4];
#pragma unroll
        for (int ai = 0; ai < 2; ++ai)
#pragma unroll
            for (int m = 0; m < 4; ++m) rsv[ai][m] = row_rstd_l(ssl, wr * 64 + fr + ai * HALF + m * 16, fq);
#pragma unroll
        for (int ai = 0; ai < 2; ++ai)
#pragma unroll
            for (int m = 0; m < 4; ++m) { const int row = row0 + ai * HALF + m * 16; const float rs = rsv[ai][m];
                const f32x2 rsn = {rs * -1.4426950408889634f, rs * -1.4426950408889634f}, rs2 = {rs * rs, rs * rs}, one = {1.0f, 1.0f};
                f32x2 G[4], U[4], X[4];
#pragma unroll
                for (int n = 0; n < 2; ++n)
#pragma unroll
                    for (int p = 0; p < 2; ++p) { G[n * 2 + p] = (f32x2){acc[ai][0][m][n][2 * p], acc[ai][0][m][n][2 * p + 1]}; U[n * 2 + p] = (f32x2){acc[ai][1][m][n][2 * p], acc[ai][1][m][n][2 * p + 1]}; }
#pragma unroll
                for (int k = 0; k < 4; ++k) X[k] = G[k] * rsn;
#pragma unroll
                for (int k = 0; k < 4; ++k) X[k] = (f32x2){__builtin_amdgcn_exp2f(X[k][0]), __builtin_amdgcn_exp2f(X[k][1])};
#pragma unroll
                for (int k = 0; k < 4; ++k) { X[k] = X[k] + one; G[k] = (G[k] * U[k]) * rs2; }
#pragma unroll
                for (int k = 0; k < 4; ++k) X[k] = (f32x2){__builtin_amdgcn_rcpf(X[k][0]), __builtin_amdgcn_rcpf(X[k][1])};
#pragma unroll
                for (int k = 0; k < 4; ++k) G[k] = G[k] * X[k];
                u32x4 w; w.x = cvt_pk2(G[0]); w.y = cvt_pk2(G[1]); w.z = cvt_pk2(G[2]); w.w = cvt_pk2(G[3]);
                *(u32x4*)(ob + (size_t)row * 32) = w; }
    }
};
__device__ __forceinline__ float bf_lo(unsigned w) { return __builtin_bit_cast(float, w << 16); }
__device__ __forceinline__ float bf_hi(unsigned w) { return __builtin_bit_cast(float, w & 0xffff0000u); }
struct EpiResid {
    static constexpr bool PERM = true, AFTER_DRAIN = false, PROBE_TWICE = false, LDS_SS = false, ACC_INIT = true;
    const bf16_t* hbin; bf16_t* hb; float* ss;
    __device__ __forceinline__ void load_c(u32x4 (&res)[4][2], const Unit& u, int wr, int wc, int fr, int fq, int ai) const {
        const int row0 = u.pm * BM + wr * 64 + fr + ai * HALF, col0 = u.pn * BM + wc * 64 + 8 * fq;
#pragma unroll
        for (int m = 0; m < 4; ++m)
#pragma unroll
            for (int bj = 0; bj < 2; ++bj) res[m][bj] = *(const u32x4*)(hbin + (size_t)(row0 + m * 16) * 1024 + col0 + bj * 32);
    }
    template <int ai> __device__ __forceinline__ void init_acc(f32x4 (&acc)[2][2][4][2], const u32x4 (&res)[4][2]) const {
#pragma unroll
        for (int m = 0; m < 4; ++m)
#pragma unroll
            for (int bj = 0; bj < 2; ++bj) { const u32x4 r = res[m][bj];
                acc[ai][bj][m][0] = (f32x4){bf_lo(r.x), bf_hi(r.x), bf_lo(r.y), bf_hi(r.y)}; acc[ai][bj][m][1] = (f32x4){bf_lo(r.z), bf_hi(r.z), bf_lo(r.w), bf_hi(r.w)}; }
    }
    template <int ai> __device__ __forceinline__ void half(const f32x4 (&acc)[2][2][4][2], const Unit& u, int wr, int wc, int fr, int fq) const {
        const int row0 = u.pm * BM + wr * 64 + fr, col0 = u.pn * BM + wc * 64 + 8 * fq;
#pragma unroll
        for (int m = 0; m < 4; ++m) { const int row = row0 + ai * HALF + m * 16; f32x2 q2 = {0.f, 0.f};
#pragma unroll
            for (int bj = 0; bj < 2; ++bj) { const f32x4 a0 = acc[ai][bj][m][0], a1 = acc[ai][bj][m][1];
                const f32x2 v01 = {a0[0], a0[1]}, v23 = {a0[2], a0[3]}, v45 = {a1[0], a1[1]}, v67 = {a1[2], a1[3]};
                q2 = v01 * v01 + q2; q2 = v23 * v23 + q2; q2 = v45 * v45 + q2; q2 = v67 * v67 + q2;
                u32x4 w; w.x = cvt_pk2(v01); w.y = cvt_pk2(v23); w.z = cvt_pk2(v45); w.w = cvt_pk2(v67);
                *(u32x4*)(hb + (size_t)row * 1024 + col0 + bj * 32) = w; }
            float q = q2[0] + q2[1]; q += __shfl_xor(q, 16); q += __shfl_xor(q, 32);
            if (fq == 0) ss[(size_t)row * 16 + u.pn * 4 + wc] = q; }
    }
    __device__ __forceinline__ void operator()(const f32x4 (&acc)[2][2][4][2], const Unit& u, int wr, int wc, int fr, int fq) const { half<0>(acc, u, wr, wc, fr, fq); half<1>(acc, u, wr, wc, fr, fq); }
};

template <class Epi, class Sched, bool ALIGN_EPI = false, bool SP2 = false>
__device__ __forceinline__ void gemm_phase(PG8_LAS unsigned char* lds, const Gemm g, const Sched& S, const Epi& E) {
    int tid_ = threadIdx.x; asm volatile("" : "+v"(tid_));
    const int tid = tid_, wid = __builtin_amdgcn_readfirstlane(tid >> 6), lane = tid & 63, wr = wid >> 2, wc = wid & 3, fr = lane & 15, fq = lane >> 4;
    const int K = g.K, nt = K / BK;
    unsigned voffA[2], voffB[2];
#pragma unroll
    for (int i = 0; i < 2; ++i) { int R, C; stage_rc(tid * 16 + i * 8192, R, C); const int Rb = 64 * (R >> 5) + (Epi::PERM ? perm32(R & 31) : (R & 31));
        voffA[i] = g.a_gc ? (unsigned)((size_t)(C / g.a_gc) * (size_t)g.a_gs + (size_t)(R * g.a_gc + C % g.a_gc)) * 2u : (unsigned)(R * K + C) * 2u; voffB[i] = (unsigned)(Rb * K + C) * 2u; }
    const size_t kstep = (size_t)(BK * 2);
    const size_t hstep = (size_t)HALF * K * 2;
    const size_t bhalf = (size_t)32 * K * 2;
    const size_t tstep = 2 * hstep;
    const size_t kstepA = g.a_gc ? (size_t)(BK / g.a_gc) * (size_t)g.a_gs * 2 : kstep, hstepA = g.a_gc ? (size_t)HALF * g.a_gc * 2 : hstep, tstepA = 2 * hstepA;
    const unsigned ldsw = (unsigned)wid * 1024u;
    const int aoff = lds_byte(wr * 64 + fr, fq * 8), boff = lds_byte(wc * 32 + fr, fq * 8);
#define PG8_SA(b, h) (((b) * 2 + (h)) * HTB)
#define PG8_SB(b, h) ((4 + (b) * 2 + (h)) * HTB)
#define PG8_STAGE_R(rs, bufoff, soff, voff) do { _Pragma("unroll") for (int _i = 0; _i < 2; ++_i) \
        __builtin_amdgcn_raw_ptr_buffer_load_lds(rs, (PG8_LAS unsigned*)(lds + (bufoff) + ldsw + _i * 8192), 16, (int)(voff)[_i], (int)(soff), 0, 0); } while (0)
#define PG8_STAGE_A(bufoff, soff, voff) PG8_STAGE_R(rA, bufoff, soff, voff)
#define PG8_STAGE_B(bufoff, soff, voff) PG8_STAGE_R(rB, bufoff, soff, voff)
#define PG8_LDA(dst, b, h) do { _Pragma("unroll") for (int m = 0; m < 4; ++m) _Pragma("unroll") for (int k = 0; k < 2; ++k) dst[m][k] = *(const PG8_LAS bf16x8*)(lds + PG8_SA(b, h) + aoff + m * 2048 + k * 1024); } while (0)
#define PG8_LDB(dst, b, h) do { _Pragma("unroll") for (int n = 0; n < 2; ++n) _Pragma("unroll") for (int k = 0; k < 2; ++k) dst[n][k] = *(const PG8_LAS bf16x8*)(lds + PG8_SB(b, h) + boff + n * 2048 + k * 1024); } while (0)
#define PG8_MMA(ai, bj, At, Bt) do { __builtin_amdgcn_s_setprio(1); _Pragma("unroll") for (int m = 0; m < 4; ++m) _Pragma("unroll") for (int n = 0; n < 2; ++n) _Pragma("unroll") for (int k = 0; k < 2; ++k) \
        acc[ai][bj][m][n] = __builtin_amdgcn_mfma_f32_16x16x32_bf16(Bt[n][k], At[m][k], acc[ai][bj][m][n], 0, 0, 0); __builtin_amdgcn_s_setprio(0); } while (0)
#define PG8_WAIT_V(n) asm volatile("s_waitcnt vmcnt(" #n ")" ::: "memory")
#define PG8_WAIT_L(n) asm volatile("s_waitcnt lgkmcnt(" #n ")" ::: "memory")
#define PG8_BAR __builtin_amdgcn_s_barrier()
#define PG8_SCHED __builtin_amdgcn_sched_barrier(0)
    Unit cur, nxt; int ui = 0;
    if (!S.next(0, cur)) return;
    f32x4 acc[2][2][4][2];
#pragma unroll
    for (int a = 0; a < 2; ++a)
#pragma unroll
        for (int b = 0; b < 2; ++b)
#pragma unroll
            for (int m = 0; m < 4; ++m)
#pragma unroll
                for (int n = 0; n < 2; ++n) acc[a][b][m][n] = (f32x4){0.f, 0.f, 0.f, 0.f};
    if constexpr (Epi::ACC_INIT) { u32x4 res0[4][2]; E.load_c(res0, cur, wr, wc, fr, fq, 0); E.template init_acc<0>(acc, res0); E.load_c(res0, cur, wr, wc, fr, fq, 1); E.template init_acc<1>(acc, res0); }
    bf16x8 At[4][2], B0[2][2], B1[2][2];
    const __amdgpu_buffer_rsrc_t rA = __builtin_amdgcn_make_buffer_rsrc((void*)g.A, (short)0, 0x7fffffff, 0x00020000), rB = __builtin_amdgcn_make_buffer_rsrc((void*)g.Bt, (short)0, 0x7fffffff, 0x00020000);
    unsigned cA = (unsigned)cur.pm * (unsigned)tstepA, cB = (unsigned)cur.pn * (unsigned)tstep;
    S.a_ready(cur);
    if constexpr (SP2) {
        PG8_STAGE_B(PG8_SB(0, 0), cB, voffB); PG8_STAGE_B(PG8_SB(0, 1), cB + bhalf, voffB); PG8_STAGE_A(PG8_SA(0, 0), cA, voffA); PG8_STAGE_A(PG8_SA(0, 1), cA + hstepA, voffA);
        if (wr == 1) PG8_BAR;
        PG8_WAIT_V(2); PG8_BAR;
        PG8_STAGE_B(PG8_SB(1, 0), cB + kstep, voffB); PG8_STAGE_A(PG8_SA(1, 0), cA + kstepA, voffA); PG8_STAGE_B(PG8_SB(1, 1), cB + bhalf + kstep, voffB);
        PG8_WAIT_V(6); PG8_BAR;
    } else {
        PG8_STAGE_B(PG8_SB(0, 0), cB, voffB); PG8_STAGE_A(PG8_SA(0, 0), cA, voffA); PG8_STAGE_B(PG8_SB(0, 1), cB + bhalf, voffB); PG8_STAGE_A(PG8_SA(0, 1), cA + hstepA, voffA);
        if (wr == 1) PG8_BAR;
        PG8_WAIT_V(4); PG8_BAR;
        PG8_STAGE_B(PG8_SB(1, 0), cB + kstep, voffB); PG8_STAGE_A(PG8_SA(1, 0), cA + kstepA, voffA); PG8_STAGE_B(PG8_SB(1, 1), cB + bhalf + kstep, voffB);
        PG8_WAIT_V(6); PG8_BAR;
    }
    for (;;) {
        const bool has_next = S.next(ui + 1, nxt);
        const unsigned nA = has_next ? (unsigned)nxt.pm * (unsigned)tstepA : cA, nB = has_next ? (unsigned)nxt.pn * (unsigned)tstep : cB;
        asm volatile(".p2align 6");
        for (int t = 0; t < nt; t += 2) {
            const bool last = (t == nt - 2);
            const unsigned a1 = cA + (unsigned)(t + 1) * (unsigned)kstepA;
            const unsigned a2 = last ? nA : cA + (unsigned)(t + 2) * (unsigned)kstepA, b2 = last ? nB : cB + (unsigned)(t + 2) * (unsigned)kstep;
            const unsigned a3 = a2 + (unsigned)kstepA, b3 = b2 + (unsigned)kstep;
            if (last && has_next) S.a_ready(nxt);
            if constexpr (SP2) {
            PG8_LDB(B0, 0, 0); PG8_LDB(B1, 0, 1); PG8_SCHED; PG8_LDA(At, 0, 0); PG8_STAGE_A(PG8_SA(1, 1), a1 + hstepA, voffA);
            PG8_WAIT_V(8); PG8_WAIT_L(0); PG8_BAR;
            if constexpr (Epi::LDS_SS) __builtin_amdgcn_global_load_lds((const unsigned*)((const char*)E.ss + (size_t)cur.pm * 16384 + (size_t)(((t >> 1) & 7) * 2048 + wid * 256 + lane * 4)), (PG8_LAS unsigned*)(lds + SS_LDS_OFF + ((t >> 1) & 7) * 2048 + wid * 256), 4, 0, 0);
            PG8_MMA(0, 0, At, B0); PG8_MMA(0, 1, At, B1); PG8_BAR; PG8_SCHED;
            PG8_LDA(At, 0, 1); PG8_STAGE_B(PG8_SB(0, 0), b2, voffB); PG8_STAGE_B(PG8_SB(0, 1), b2 + bhalf, voffB); PG8_STAGE_A(PG8_SA(0, 0), a2, voffA);
            PG8_WAIT_V(8); PG8_WAIT_L(0); PG8_BAR; PG8_MMA(1, 0, At, B0); PG8_MMA(1, 1, At, B1); PG8_BAR; PG8_SCHED;
            PG8_LDB(B0, 1, 0); PG8_LDB(B1, 1, 1); PG8_SCHED; PG8_LDA(At, 1, 0); PG8_STAGE_A(PG8_SA(0, 1), a2 + hstepA, voffA);
            PG8_WAIT_V(8); PG8_WAIT_L(0); PG8_BAR; PG8_MMA(0, 0, At, B0); PG8_MMA(0, 1, At, B1); PG8_BAR; PG8_SCHED;
            PG8_LDA(At, 1, 1); PG8_STAGE_B(PG8_SB(1, 0), b3, voffB); PG8_STAGE_B(PG8_SB(1, 1), b3 + bhalf, voffB); PG8_STAGE_A(PG8_SA(1, 0), a3, voffA);
            PG8_WAIT_V(8); PG8_WAIT_L(0); PG8_BAR; PG8_MMA(1, 0, At, B0); PG8_MMA(1, 1, At, B1); PG8_BAR; PG8_SCHED;
            } else {
            PG8_LDB(B0, 0, 0); PG8_SCHED; PG8_LDA(At, 0, 0); PG8_STAGE_A(PG8_SA(1, 1), a1 + hstepA, voffA);
            PG8_WAIT_L(8); PG8_BAR; PG8_WAIT_L(0); PG8_MMA(0, 0, At, B0); PG8_BAR; PG8_SCHED;
            PG8_LDB(B1, 0, 1); PG8_STAGE_B(PG8_SB(0, 0), b2, voffB);
            PG8_BAR; PG8_WAIT_L(0); PG8_MMA(0, 1, At, B1); PG8_BAR;
            PG8_LDA(At, 0, 1); PG8_STAGE_A(PG8_SA(0, 0), a2, voffA);
            PG8_BAR; PG8_WAIT_L(0); PG8_MMA(1, 0, At, B0); PG8_BAR; PG8_SCHED;
            PG8_STAGE_B(PG8_SB(0, 1), b2 + bhalf, voffB);
            PG8_WAIT_V(6); PG8_BAR; PG8_MMA(1, 1, At, B1); PG8_BAR;
            PG8_LDB(B0, 1, 0); PG8_SCHED; PG8_LDA(At, 1, 0); PG8_STAGE_A(PG8_SA(0, 1), a2 + hstepA, voffA);
            PG8_WAIT_L(8); PG8_BAR; PG8_WAIT_L(0); PG8_MMA(0, 0, At, B0); PG8_BAR; PG8_SCHED;
            PG8_LDB(B1, 1, 1); PG8_STAGE_B(PG8_SB(1, 0), b3, voffB);
            PG8_BAR; PG8_WAIT_L(0); PG8_MMA(0, 1, At, B1); PG8_BAR;
            PG8_LDA(At, 1, 1); PG8_STAGE_A(PG8_SA(1, 0), a3, voffA);
            PG8_BAR; PG8_WAIT_L(0); PG8_MMA(1, 0, At, B0); PG8_BAR; PG8_SCHED;
            PG8_STAGE_B(PG8_SB(1, 1), b3 + bhalf, voffB);
            PG8_WAIT_V(6); PG8_BAR; PG8_MMA(1, 1, At, B1); PG8_BAR;
            }
        }
        if constexpr (ALIGN_EPI) { if (wr == 0) PG8_BAR; }
        if constexpr (Epi::ACC_INIT) {
            u32x4 resn[4][2];
            Unit un = cur; if (has_next) un = nxt;
            E.load_c(resn, un, wr, wc, fr, fq, 0);
            E.template half<0>(acc, cur, wr, wc, fr, fq);
            E.template init_acc<0>(acc, resn); E.load_c(resn, un, wr, wc, fr, fq, 1);
            E.template half<1>(acc, cur, wr, wc, fr, fq);
            E.template init_acc<1>(acc, resn);
            S.done(cur);
        } else
        if constexpr (!Epi::AFTER_DRAIN) { if (S.emit(ui)) { E(acc, cur, wr, wc, fr, fq); if constexpr (Epi::PROBE_TWICE) { asm volatile("" ::: "memory"); E(acc, cur, wr, wc, fr, fq); } } S.done(cur); }
        if (!has_next) break;
        if constexpr (!Epi::ACC_INIT)
#pragma unroll
        for (int a = 0; a < 2; ++a)
#pragma unroll
            for (int b = 0; b < 2; ++b)
#pragma unroll
                for (int m = 0; m < 4; ++m)
#pragma unroll
                    for (int n = 0; n < 2; ++n) acc[a][b][m][n] = (f32x4){0.f, 0.f, 0.f, 0.f};
        cur = nxt; cA = nA; cB = nB; ++ui;
        if constexpr (ALIGN_EPI) { if (wr == 1) PG8_BAR; }
    }
    PG8_WAIT_V(0);
    if constexpr (!ALIGN_EPI) { if (wr == 0) PG8_BAR; }
    PG8_BAR;
    if constexpr (Epi::AFTER_DRAIN) { E.fused(acc, cur, wr, wc, fr, fq, lds, wid, lane); S.done(cur); }
#undef PG8_SA
#undef PG8_SB
#undef PG8_STAGE_R
#undef PG8_STAGE_A
#undef PG8_STAGE_B
#undef PG8_LDA
#undef PG8_LDB
#undef PG8_MMA
#undef PG8_WAIT_V
#undef PG8_WAIT_L
#undef PG8_BAR
#undef PG8_SCHED
}
}
#include <hip/hip_bf16.h>
#include <cmath>
namespace attn_body {
using bf16=__hip_bfloat16;
using bf16x8=__attribute__((ext_vector_type(8)))short;
using s16x4=__attribute__((ext_vector_type(4)))short;
using f32x16=__attribute__((ext_vector_type(16)))float;
using u32x4=__attribute__((ext_vector_type(4)))unsigned;
constexpr int SEQ=2048,D=64,DM=64;
constexpr long GSTR=65536L*64;
constexpr int NW=8,QBLK=32,QB=QBLK*NW,KVBLK=64;
__device__ __forceinline__ int crow(int r,int hi){return (r&3)+8*(r>>2)+4*hi;}
#define SBAR() __builtin_amdgcn_sched_barrier(0)
__device__ __forceinline__ void cmask(f32x16&p0,f32x16&p1,int jb,int qrel,int hi,const float NEG){
  int kb=64*jb+4*hi;
  #pragma unroll
  for(int r=0;r<16;++r){int kv=kb+(r&3)+8*(r>>2); if(kv>qrel)p0[r]=NEG; if(kv+32>qrel)p1[r]=NEG;}
}
constexpr int NSLOT=3, SLOTB=8192, VSLOTB=16384;
constexpr int LDS_K=0, LDS_V=NSLOT*SLOTB, LDS_WS=LDS_V+NSLOT*VSLOTB, LDS_OST=LDS_WS+NW*64*4, LDS_ST=LDS_OST+NW*8192, LDS_BYTES=LDS_ST+16384;
__device__ __forceinline__ void glds16(const void*gsrc,unsigned lds_dst){unsigned keep;
  asm volatile("s_mov_b32 %0, m0\n\ts_mov_b32 m0, %2\n\ts_nop 0\n\tglobal_load_lds_dwordx4 %1, off\n\ts_mov_b32 m0, %0":"=&s"(keep):"v"(gsrc),"s"(lds_dst):"memory");}
__device__ __forceinline__ float max3f(float a,float b,float c){float r;asm("v_max3_f32 %0, %1, %2, %3":"=v"(r):"v"(a),"v"(b),"v"(c));return r;}
__device__ __forceinline__ float max2f(float a,float b){float r;asm("v_max_f32_e32 %0, %1, %2":"=v"(r):"v"(a),"v"(b));return r;}
__device__ __forceinline__ float fadd_s(float a,float b){float r;asm("v_add_f32_e32 %0, %1, %2":"=v"(r):"v"(a),"v"(b));return r;}
__device__ __forceinline__ float fsub_s(float a,float b){float r;asm("v_sub_f32_e32 %0, %1, %2":"=v"(r):"v"(a),"v"(b));return r;}
typedef float f32x2_t __attribute__((ext_vector_type(2))); typedef __bf16 bf16x2_t __attribute__((ext_vector_type(2)));
__device__ __forceinline__ unsigned cvtpk_s(float lo,float hi){f32x2_t v={lo,hi};bf16x2_t b=__builtin_convertvector(v,bf16x2_t);return __builtin_bit_cast(unsigned,b);}
#define WAIT_BAR(N) asm volatile("s_waitcnt vmcnt(" #N ") lgkmcnt(0)\n\ts_barrier":::"memory")

__device__ __forceinline__ void qkt(f32x16&p0,f32x16&p1,const char*Kslot,const bf16x8*qr,int r32,int hi){
  const char*kb=Kslot+hi*1024+r32*16;
  #pragma unroll
  for(int d0=0;d0<4;++d0){
    const bf16x8 b0=*reinterpret_cast<const bf16x8*>(kb+d0*2048);
    const bf16x8 b1=*reinterpret_cast<const bf16x8*>(kb+d0*2048+512);
    p0=__builtin_amdgcn_mfma_f32_32x32x16_bf16(b0,qr[d0],p0,0,0,0);p1=__builtin_amdgcn_mfma_f32_32x32x16_bf16(b1,qr[d0],p1,0,0,0);}
}
typedef __attribute__((address_space(3))) const char* lds_cptr;
typedef short v4i16_t __attribute__((ext_vector_type(4)));
__device__ __forceinline__ void kload8(bf16x8*kf,lds_cptr kp){
  kf[0]=*(const __attribute__((address_space(3))) bf16x8*)(kp);      kf[1]=*(const __attribute__((address_space(3))) bf16x8*)(kp+512);
  kf[2]=*(const __attribute__((address_space(3))) bf16x8*)(kp+2048); kf[3]=*(const __attribute__((address_space(3))) bf16x8*)(kp+2560);
  kf[4]=*(const __attribute__((address_space(3))) bf16x8*)(kp+4096); kf[5]=*(const __attribute__((address_space(3))) bf16x8*)(kp+4608);
  kf[6]=*(const __attribute__((address_space(3))) bf16x8*)(kp+6144); kf[7]=*(const __attribute__((address_space(3))) bf16x8*)(kp+6656);
}
__device__ __forceinline__ void kload2(bf16x8*kf,lds_cptr kp,int j){ kf[2*j]=*(const __attribute__((address_space(3))) bf16x8*)(kp+j*2048); kf[2*j+1]=*(const __attribute__((address_space(3))) bf16x8*)(kp+j*2048+512); }
__device__ __forceinline__ s16x4 vtr(lds_cptr p){ return __builtin_bit_cast(s16x4,__builtin_amdgcn_ds_read_tr16_b64_v4i16((__attribute__((address_space(3))) v4i16_t*)p)); }
__device__ __forceinline__ float rowmax(const f32x16&p0,const f32x16&p1){
  float a=max3f(p0[0],p0[1],p1[0]),b=max3f(p0[2],p0[3],p1[1]);a=max3f(a,p1[2],p1[3]);
  #pragma unroll
  for(int r=4;r<16;r+=4){a=max3f(a,p0[r],p0[r+1]);b=max3f(b,p0[r+2],p0[r+3]);a=max3f(a,p1[r],p1[r+1]);b=max3f(b,p1[r+2],p1[r+3]);}
  const float m=max2f(a,b);
  auto rr=__builtin_amdgcn_permlane32_swap(__float_as_uint(m),__float_as_uint(m),false,false);
  return max2f(__uint_as_float(rr[0]),__uint_as_float(rr[1]));
}
__device__ __forceinline__ void pv(f32x16*o,int vb,bf16x8 pa0,bf16x8 pa1,bf16x8 pa2,bf16x8 pa3){
  #pragma unroll
  for(int d0=0;d0<4;++d0){s16x4 lo[4],hi[4];
    #pragma unroll
    for(int ks=0;ks<4;++ks){
      asm volatile("ds_read_b64_tr_b16 %0,%1 offset:%c2":"=&v"(lo[ks]):"v"(vb),"i"(d0*4096+ks*1024):"memory");
      asm volatile("ds_read_b64_tr_b16 %0,%1 offset:%c2":"=&v"(hi[ks]):"v"(vb),"i"(d0*4096+ks*1024+512):"memory");}
    asm volatile("s_waitcnt lgkmcnt(0)":::"memory");SBAR();
    #define PK(k) (bf16x8){lo[k][0],lo[k][1],lo[k][2],lo[k][3],hi[k][0],hi[k][1],hi[k][2],hi[k][3]}
    o[d0]=__builtin_amdgcn_mfma_f32_32x32x16_bf16(pa0,PK(0),o[d0],0,0,0);
    o[d0]=__builtin_amdgcn_mfma_f32_32x32x16_bf16(pa1,PK(1),o[d0],0,0,0);
    o[d0]=__builtin_amdgcn_mfma_f32_32x32x16_bf16(pa2,PK(2),o[d0],0,0,0);
    o[d0]=__builtin_amdgcn_mfma_f32_32x32x16_bf16(pa3,PK(3),o[d0],0,0,0);
    #undef PK
  }
}

struct PassArgs { int qb, cq, ck, cv, tsk; };
template<int THRL,int MODE> __device__ __forceinline__ void attn_unit(const bf16*__restrict__ proj,long rowbase,const PassArgs A_,float cs,float lam,char*shm,int&slot0,bool pre,bf16x8(&qr)[4],bool has_next,const PassArgs N_,f32x16&Sreg){
  const int qb=A_.qb; const bf16*Qh=proj+A_.cq; const bf16*__restrict__ Kh_=proj+A_.ck; const bf16*__restrict__ Vh_=proj+A_.cv;
  int tid_=threadIdx.x; asm volatile("":"+v"(tid_));
  const int tid=tid_,lane=tid&63,r32=lane&31,hi=lane>>5; const int wid=__builtin_amdgcn_readfirstlane(tid>>6);
  constexpr bool LIN=(MODE==2); const float lgam=LIN?cs:0.f; if(LIN)cs=0.f; float ftv=1.f;
  const int q0=qb*QB;
  const bf16*Qw=Qh+(rowbase+q0+(wid>>1)*KVBLK)*DM+(wid&1)*(QBLK*8);
  const int tsk=A_.tsk;
  const bf16*Kh=Kh_+(rowbase+(long)tsk*KVBLK)*DM,*Vh=Vh_+(rowbase+(long)tsk*KVBLK)*DM;
  const unsigned lds0=(unsigned)(uintptr_t)shm;
  float*wsf=(float*)(shm+LDS_WS)+wid*64;
  const float g64=LIN?__builtin_amdgcn_exp2f(64.f*lgam):1.f;
  const __attribute__((address_space(3))) char* ktp0=(const __attribute__((address_space(3))) char*)shm+LDS_K+(4*(wid>>2)+2*((lane>>4)&1)+((lane&3)>>1))*1024+(4*hi+((lane&15)>>2))*16+(lane&1)*8;
  const bf16*ksrc=Kh+(long)lane*8+wid*512;
  const bf16*vsrc=Vh+(wid>>2)*2048+(wid&3)*512+(long)lane*8;
  const unsigned kdst=lds0+LDS_K+wid*1024, vdst=lds0+LDS_V+wid*1024;
  #define DMA_K(t,slot) glds16(ksrc+(long)(t)*KVBLK*DM,(unsigned)__builtin_amdgcn_readfirstlane(kdst+(slot)))
  #define DMA_V(t,slot) do{ glds16(vsrc+(long)(t)*KVBLK*DM,(unsigned)__builtin_amdgcn_readfirstlane(vdst+2*(slot))); glds16(vsrc+(long)(t)*KVBLK*DM+GSTR,(unsigned)__builtin_amdgcn_readfirstlane(vdst+2*(slot)+8192)); }while(0)
  const int vb0=(int)(lds0+LDS_V)+((lane>>4)&1)*32+(lane&3)*8+(4*hi+((lane&15)>>2))*64;
  const char*Kbase=shm+LDS_K; bf16x8 kf[8];
  const lds_cptr shm3=(lds_cptr)shm; const lds_cptr kp0=shm3+LDS_K+hi*1024+r32*16; const lds_cptr vp0=shm3+LDS_V+((lane>>4)&1)*32+(lane&3)*8+(4*hi+((lane&15)>>2))*64;
  const int NT=(q0+QB)/KVBLK-tsk;
  #define NXS(s) (((s)==(NSLOT-1)*SLOTB)?0:(s)+SLOTB)
  const int sA=slot0,sB=NXS(sA),sC=NXS(sB);
  if(!pre){ DMA_K(0,sA);DMA_V(0,sA);DMA_K(1,sB);
    #pragma unroll
    for(int d0=0;d0<4;++d0)qr[d0]=*reinterpret_cast<const bf16x8*>(&Qw[(2*d0+hi)*512+r32*8]);
    DMA_K(2,sC); }
  float l_reg=0.f;f32x16 o[4];
  { _Pragma("unroll") for(int d_=0;d_<4;++d_) _Pragma("unroll") for(int r=0;r<16;++r){float z_;asm volatile("v_mov_b32 %0, 0":"=v"(z_));o[d_][r]=z_;} }
  const int qrel=wid*QBLK+r32;
  float csv=cs; asm volatile("":"+v"(csv)); const float cs64=64.f*cs, cs59=59.f*cs; float nb=0.f;
  #define ALIBI_IN(P0,P1) do{ _Pragma("unroll") for(int r=0;r<16;++r){ P0[r]=__builtin_fmaf(csv,(float)((r&3)+8*(r>>2)),P0[r]); P1[r]=__builtin_fmaf(csv,(float)((r&3)+8*(r>>2)+32),P1[r]); } }while(0)
  #define CMASK(P0,P1,t) do{int jb_=(t)-(NT-4); if(jb_>=0)cmask(P0,P1,jb_,qrel,hi,LIN?0.f:-INFINITY);}while(0)
  bool resc=false;
  #define START(P0,P1) do{ resc=false; if constexpr(LIN){ _Pragma("unroll") for(int r=0;r<16;++r)P0[r]*=ftv; break; } const float rm=rowmax(P0,P1); \
    { const float dl=rm; \
      _Pragma("unroll") for(int r=0;r<16;++r){P0[r]=fsub_s(P0[r],dl);P1[r]=fsub_s(P1[r],dl);} \
      nb=bt0+cs64-dl; } \
    _Pragma("unroll") for(int r=0;r<16;++r)P0[r]=__builtin_amdgcn_exp2f(P0[r]); }while(0)
  #define RESC() do{ if(resc){ asm volatile("s_waitcnt lgkmcnt(0)":::"memory"); \
      _Pragma("unroll") for(int d_=0;d_<4;++d_) _Pragma("unroll") for(int r=0;r<16;++r)o[d_][r]*=wsf[crow(r,hi)]; } }while(0)
  f32x16 pA0,pA1,pB0,pB1;
  int sl_prev=sA,sl_cur=sA,sl_next=sB;
  #define ROT() do{sl_prev=sl_cur;sl_cur=sl_next;sl_next=(sl_next==(NSLOT-1)*SLOTB)?0:sl_next+SLOTB;}while(0)
  #define MF32(a,b,c) __builtin_amdgcn_mfma_f32_32x32x16_bf16(a,b,c,0,0,0)
  if constexpr(LIN){
    char*st_=shm+LDS_ST+((wid&3)*32+r32)*128+((wid>>2)*32+4*hi)*2;
    #pragma unroll
    for(int g4=0;g4<4;++g4){ uint2 w_; w_.x=cvtpk_s(Sreg[4*g4]*g64,Sreg[4*g4+1]*g64); w_.y=cvtpk_s(Sreg[4*g4+2]*g64,Sreg[4*g4+3]*g64); *reinterpret_cast<uint2*>(st_+g4*16)=w_; } }
  WAIT_BAR(4);
  if constexpr(LIN){
    const char*sr_=shm+LDS_ST+r32*128+hi*16;
    #pragma unroll
    for(int cq=0;cq<4;++cq){
      #pragma unroll
      for(int d0=0;d0<4;++d0){ const bf16x8 sf_=*reinterpret_cast<const bf16x8*>(sr_+cq*4096+d0*32); o[cq]=MF32(qr[d0],sf_,o[cq]); } } }
  #define KVUPD(slot) do{ _Pragma("unroll") for(int r=0;r<16;++r)Sreg[r]*=g64; \
    const __attribute__((address_space(3))) char*kt_=ktp0+(slot); const lds_cptr vt_=vp0+2*(slot)+(wid&3)*4096; \
    _Pragma("unroll") for(int ks=0;ks<4;++ks){ const s16x4 a0_=vtr((lds_cptr)(kt_+ks*256)),a1_=vtr((lds_cptr)(kt_+ks*256+128)),b0_=vtr(vt_+ks*1024),b1_=vtr(vt_+ks*1024+512); \
      Sreg=MF32(((bf16x8){a0_[0],a0_[1],a0_[2],a0_[3],a1_[0],a1_[1],a1_[2],a1_[3]}),((bf16x8){b0_[0],b0_[1],b0_[2],b0_[3],b1_[0],b1_[1],b1_[2],b1_[3]}),Sreg); } }while(0)
  const float bt0=cs*(float)(4*hi-(q0+QB-1)+64*tsk);
  { _Pragma("unroll") for(int r=0;r<16;++r){float z_,y_;asm volatile("v_mov_b32 %0, 0\n\tv_mov_b32 %1, 0":"=v"(z_),"=v"(y_));pA0[r]=z_;pA1[r]=y_;} asm volatile("s_nop 1":"+v"(pA0),"+v"(pA1)); }
  qkt(pA0,pA1,Kbase+sA,qr,r32,hi);asm volatile("s_nop 15\n\ts_nop 7":"+v"(pA0),"+v"(pA1));
  if constexpr(LIN) ftv=__builtin_amdgcn_exp2f(lgam*(float)(q0-64*tsk));
  if constexpr(!LIN){ _Pragma("unroll") for(int r=0;r<16;++r){pA0[r]+=bt0;pA1[r]+=bt0;} ALIBI_IN(pA0,pA1); } CMASK(pA0,pA1,0);
  START(pA0,pA1);
  _Pragma("unroll") for(int r=0;r<16;++r)pA1[r]=LIN?pA1[r]*ftv:__builtin_amdgcn_exp2f(pA1[r]);
  WAIT_BAR(0);
  if constexpr(LIN){ KVUPD(sA); asm volatile("s_waitcnt lgkmcnt(0)\n\ts_barrier":::"memory"); }
  DMA_K(3,sA);DMA_V(1,sB);
  ROT();
  kload8(kf,kp0+sl_cur);
  WAIT_BAR(3);
  s16x4 fl[16],fh[16]; u32x4 pw0,pw1,pw2,pw3;
  #define PKW(P,B) cvtpk_s(P[B],P[B+1])
  #define PAF(k) __builtin_bit_cast(bf16x8,pw##k)
  #define FFR(i) (bf16x8){fl[i][0],fl[i][1],fl[i][2],fl[i][3],fh[i][0],fh[i][1],fh[i][2],fh[i][3]}
  #define PIN(x) asm volatile("":"+v"(x))
  #define MX3(a,b,c) __builtin_fmaxf(__builtin_fmaxf((a),(b)),(c))
  #define GAPA(MF,A0,A1,A2,A3,W0,W1,PW) do{ MF; if constexpr(!LIN){ sacc+=A0; sacc+=A1; sacc+=A2; sacc+=A3; PIN(sacc); } W0; W1; PIN(PW); SBAR(); }while(0)
  #define KR(B) ((float)(((B)&3)+8*((B)>>2)))
  #define FMAK(a,K,c) ({ float r_; asm("v_fmamk_f32 %0, %1, %2, %3":"=v"(r_):"v"(a),"n"(__builtin_bit_cast(unsigned,(float)(K))),"v"(c)); r_; })
  #define EXB(v,k) (LIN?(v)*ftv:__builtin_amdgcn_exp2f(v))
  #define GAPB(MF,X,B,OFF,Y) do{ MF; X[B]=EXB(X[B],KR(B)+(OFF)); X[B+1]=EXB(X[B+1],KR((B)+1)+(OFF)); PIN(X); if constexpr(!LIN){ Y[B]=FMAK(csv,KR(B)+(OFF),nbn_); Y[B+1]=FMAK(csv,KR((B)+1)+(OFF),nbn_); PIN(Y); } SBAR(); }while(0)
  #define FRD(i) do{ fl[i]=vtr(vp_+(((i)>>2)*4096+((i)&3)*1024)); fh[i]=vtr(vp_+(((i)>>2)*4096+((i)&3)*1024+512)); SBAR(); }while(0)
  #define KRD(G,j) do{ if(G){ kload2(kf,kp0+sl_next,j); SBAR(); } }while(0)
  #define CST(Cx) (LIN?f32x16{}:Cx)
  #define STEP(C0,C1,P0,P1,t,GK,GV,GL) do{ SBAR(); \
    if constexpr(LIN){ ftv=__builtin_amdgcn_exp2f(lgam*(float)(q0-64*((t)+tsk))); if((t)>=2){ KVUPD(sl_prev); } } SBAR(); \
    const lds_cptr vp_=vp0+2*sl_prev; \
    FRD(0); float sacc=(P0[0]+P0[1]); \
    GAPA(C0=MF32(kf[0],qr[0],CST(C0)), P0[2],P0[3],P0[4],P0[5],     pw0[0]=PKW(P0,0), pw0[1]=PKW(P0,2), pw0); \
    GAPA(C1=MF32(kf[1],qr[0],CST(C1)), P0[6],P0[7],P0[8],P0[9],     pw0[2]=PKW(P0,4), pw0[3]=PKW(P0,6), pw0); \
    FRD(4); GAPA(C0=MF32(kf[2],qr[1],C0),   P0[10],P0[11],P0[12],P0[13], pw1[0]=PKW(P0,8), pw1[1]=PKW(P0,10), pw1); \
    GAPA(C1=MF32(kf[3],qr[1],C1),   P0[14],P0[15],P1[0],P1[1],   pw1[2]=PKW(P0,12),pw1[3]=PKW(P0,14), pw1); \
    FRD(1); GAPA(C0=MF32(kf[4],qr[2],C0),   P1[2],P1[3],P1[4],P1[5],     pw2[0]=PKW(P1,0), pw2[1]=PKW(P1,2), pw2); \
    GAPA(C1=MF32(kf[5],qr[2],C1),   P1[6],P1[7],P1[8],P1[9],     pw2[2]=PKW(P1,4), pw2[3]=PKW(P1,6), pw2); \
    FRD(5); GAPA(C0=MF32(kf[6],qr[3],C0),   P1[10],P1[11],P1[12],P1[13], pw3[0]=PKW(P1,8), pw3[1]=PKW(P1,10), pw3); \
    GAPA(C1=MF32(kf[7],qr[3],C1),   P1[14],P1[15],0.f,0.f,       pw3[2]=PKW(P1,12),pw3[3]=PKW(P1,14), pw3); \
    l_reg+=sacc; \
    if(GK){DMA_K((t)+3,sl_cur);} if(GV){DMA_V((t)+1,sl_next);} \
    CMASK(C0,C1,t); \
    if constexpr(!LIN){ float a=MX3(C0[0],C0[1],C1[0]),b=MX3(C0[2],C0[3],C1[1]); a=MX3(a,C1[2],C1[3]); \
      _Pragma("unroll") for(int r=4;r<16;r+=4){a=MX3(a,C0[r],C0[r+1]);b=MX3(b,C0[r+2],C0[r+3]);a=MX3(a,C1[r],C1[r+1]);b=MX3(b,C1[r+2],C1[r+3]);} \
      float rm=__builtin_fmaxf(a,b); { auto rr=__builtin_amdgcn_permlane32_swap(__float_as_uint(rm),__float_as_uint(rm),false,false); rm=__builtin_fmaxf(__uint_as_float(rr[0]),__uint_as_float(rr[1])); } \
      resc=false; \
      if(__builtin_expect(__any(rm>(float)THRL),0)){ const float dl=__builtin_fmaxf(rm,0.f); \
        _Pragma("unroll") for(int r=0;r<16;++r){C0[r]-=dl;C1[r]-=dl;} \
        nb-=dl; \
        const float f=__builtin_amdgcn_exp2f(-dl); l_reg*=f; if(hi==0)wsf[r32]=f; resc=true; } } \
    float nbn_=nb+cs64; asm volatile("":"+v"(nbn_)); \
    SBAR(); \
    FRD(2);  GAPB(o[0]=MF32(PAF(0),FFR(0),o[0]), C0,0,0.f,P0); \
    FRD(6);  GAPB(o[1]=MF32(PAF(0),FFR(4),o[1]), C0,2,0.f,P0); \
    FRD(3);  GAPB(o[0]=MF32(PAF(1),FFR(1),o[0]), C0,4,0.f,P0); \
    FRD(7);  GAPB(o[1]=MF32(PAF(1),FFR(5),o[1]), C0,6,0.f,P0); \
    FRD(8);  GAPB(o[0]=MF32(PAF(2),FFR(2),o[0]), C0,8,0.f,P0); \
    FRD(12); GAPB(o[1]=MF32(PAF(2),FFR(6),o[1]), C0,10,0.f,P0); \
    FRD(9);  GAPB(o[0]=MF32(PAF(3),FFR(3),o[0]), C0,12,0.f,P0); \
    FRD(13); GAPB(o[1]=MF32(PAF(3),FFR(7),o[1]), C0,14,0.f,P0); \
    FRD(10); GAPB(o[2]=MF32(PAF(0),FFR(8),o[2]), C1,0,32.f,P1); \
    FRD(14); GAPB(o[3]=MF32(PAF(0),FFR(12),o[3]), C1,2,32.f,P1); \
    FRD(11); GAPB(o[2]=MF32(PAF(1),FFR(9),o[2]), C1,4,32.f,P1); \
    FRD(15); GAPB(o[3]=MF32(PAF(1),FFR(13),o[3]), C1,6,32.f,P1); \
    KRD(GL,0); KRD(GL,1); GAPB(o[2]=MF32(PAF(2),FFR(10),o[2]), C1,8,32.f,P1); \
    KRD(GL,2); GAPB(o[3]=MF32(PAF(2),FFR(14),o[3]), C1,10,32.f,P1); \
    KRD(GL,3); GAPB(o[2]=MF32(PAF(3),FFR(11),o[2]), C1,12,32.f,P1); \
    GAPB(o[3]=MF32(PAF(3),FFR(15),o[3]), C1,14,32.f,P1); \
    nb=nbn_; \
    }while(0)
  if constexpr(!LIN){ float nbv_=nb; asm volatile("":"+v"(nbv_)); _Pragma("unroll") for(int r=0;r<16;++r){pB0[r]=__builtin_fmaf(csv,(float)((r&3)+8*(r>>2)),nbv_);pB1[r]=__builtin_fmaf(csv,(float)((r&3)+8*(r>>2)+32),nbv_);} asm volatile("":"+v"(pB0),"+v"(pB1)); }
  int t=1;
  #undef CMASK
  #define CMASK(P0,P1,t) do{}while(0)
  asm volatile(".p2align 6");
  for(;t+5<NT;t+=2){
    STEP(pB0,pB1,pA0,pA1,t,true,true,true);     WAIT_BAR(3); RESC(); ROT();
    STEP(pA0,pA1,pB0,pB1,t+1,true,true,true);   WAIT_BAR(3); RESC(); ROT();
  }
  #undef CMASK
  #define CMASK(P0,P1,t) do{int jb_=(t)-(NT-4); if(jb_>=0)cmask(P0,P1,jb_,qrel,hi,LIN?0.f:-INFINITY);}while(0)
  #define ENDW(tt) do{ if((tt)+3<NT){WAIT_BAR(3);} else if((tt)+2<NT){WAIT_BAR(2);} else {WAIT_BAR(0);} }while(0)
  for(;t+1<NT;t+=2){
    STEP(pB0,pB1,pA0,pA1,t,(t+3<NT),(t+1<NT),(t+1<NT));       ENDW(t);   RESC(); ROT();
    STEP(pA0,pA1,pB0,pB1,t+1,(t+4<NT),(t+2<NT),(t+2<NT));     ENDW(t+1); RESC(); ROT();
  }
  STEP(pB0,pB1,pA0,pA1,NT-1,false,false,false); RESC();
  if constexpr(LIN){ KVUPD(sl_cur); asm volatile("s_waitcnt lgkmcnt(0)\n\ts_barrier":::"memory"); }
  if(has_next){ const int sN=sl_next,sN1=NXS(sN),sN2=NXS(sN1);
    int ln2=lane; asm volatile("":"+v"(ln2)); const int r32n=ln2&31,hin=ln2>>5;
    const long nrb=rowbase+(long)N_.tsk*KVBLK;
    const bf16*nK=proj+N_.ck+nrb*DM+(long)ln2*8+wid*512; const bf16*nV=proj+N_.cv+nrb*DM+(wid>>2)*2048+(wid&3)*512+(long)ln2*8; const bf16*nQ=proj+N_.cq+(rowbase+N_.qb*QB+(wid>>1)*KVBLK)*DM+(wid&1)*(QBLK*8);
    glds16(nK,(unsigned)__builtin_amdgcn_readfirstlane(kdst+sN)); glds16(nV,(unsigned)__builtin_amdgcn_readfirstlane(vdst+2*sN)); glds16(nV+GSTR,(unsigned)__builtin_amdgcn_readfirstlane(vdst+2*sN+8192));
    glds16(nK+(long)KVBLK*DM,(unsigned)__builtin_amdgcn_readfirstlane(kdst+sN1));
    #pragma unroll
    for(int d0=0;d0<4;++d0)qr[d0]=*reinterpret_cast<const bf16x8*>(&nQ[(2*d0+hin)*512+r32n*8]);
    glds16(nK+(long)2*KVBLK*DM,(unsigned)__builtin_amdgcn_readfirstlane(kdst+sN2));
    slot0=sN; }
  { float sacc=pB0[0]+pB0[1]; _Pragma("unroll") for(int r=2;r<16;++r)sacc+=pB0[r]; _Pragma("unroll") for(int r=0;r<16;++r)sacc+=pB1[r]; l_reg+=sacc;
    pw0=(u32x4){PKW(pB0,0),PKW(pB0,2),PKW(pB0,4),PKW(pB0,6)};pw1=(u32x4){PKW(pB0,8),PKW(pB0,10),PKW(pB0,12),PKW(pB0,14)};pw2=(u32x4){PKW(pB1,0),PKW(pB1,2),PKW(pB1,4),PKW(pB1,6)};pw3=(u32x4){PKW(pB1,8),PKW(pB1,10),PKW(pB1,12),PKW(pB1,14)};
    SBAR(); pv(o,vb0+2*sl_cur,PAF(0),PAF(1),PAF(2),PAF(3)); }
  #undef PKW
  #undef PAF
  #undef FFR
  #undef PIN
  #undef MX3
  #undef GAPA
  #undef GAPB
  #undef EXB
  #undef KR
  #undef FMAK
  #undef FRD
  #undef KRD
  #undef MF32
  #undef CST
  #undef KVUPD
  #undef STEP
  #undef ENDW
  {auto rr=__builtin_amdgcn_permlane32_swap(__float_as_uint(l_reg),__float_as_uint(l_reg),false,false);l_reg=__uint_as_float(rr[0])+__uint_as_float(rr[1]);}
  if(hi==0)wsf[32+r32]=l_reg;asm volatile("s_waitcnt lgkmcnt(0)":::"memory");
  float rli[16];
  #pragma unroll
  for(int r=0;r<16;++r)rli[r]=__builtin_amdgcn_rcpf(wsf[32+crow(r,hi)]);
  { int ln_=lane; asm volatile("":"+v"(ln_));
    const int r32e=ln_&31, hie=ln_>>5;
    bf16*stg=(bf16*)(shm+LDS_OST)+wid*4096+hie*512+r32e;
    #pragma unroll
    for(int r=0;r<16;++r){const int orow=(r&3)+8*(r>>2);
      #pragma unroll
      for(int d0=0;d0<4;++d0){ float val=LIN?o[d0][r]:o[d0][r]*rli[r];
        if(MODE==1) val=__bfloat162float(stg[orow*128+d0*32])-lam*val;
        stg[orow*128+d0*32]=__float2bfloat16(val);} }
    asm volatile("s_waitcnt lgkmcnt(0)":::"memory"); }
  asm volatile("s_waitcnt lgkmcnt(0)\n\ts_barrier":::"memory");
  #undef DMA_K
  #undef DMA_V
  #undef CMASK
  #undef START
  #undef RESC
  #undef ROT
  #undef ALIBI_IN
  #undef NXS
}

typedef unsigned u32x2r __attribute__((ext_vector_type(2)));
typedef float f32x4r __attribute__((ext_vector_type(4)));
constexpr int R2_Q=LDS_OST, R2_SIMG=R2_Q+NSLOT*SLOTB, R2_SROW=144, R2_SBUF=128*R2_SROW, R2_STG=R2_SIMG+R2_SBUF, R2_STROW=264, R2_GATE=R2_STG+64*R2_STROW, R2_END=R2_GATE+16384;
static_assert(R2_END<=LDS_BYTES,"ret_chain LDS map");
__device__ __forceinline__ u32x4 gld16_async(const void*p){u32x4 r;asm volatile("global_load_dwordx4 %0, %1, off":"=v"(r):"v"(p):"memory");return r;}
__device__ __forceinline__ void ret_chain(const bf16*__restrict__ proj,long rowbase,int cq,int ck,int cv,int cg,float lgam,char*shm,int slot0,bool pre,const __attribute__((address_space(1))) float*gain,unsigned short*mixh,int DMX){
  #define NXS(s) (((s)==(NSLOT-1)*SLOTB)?0:(s)+SLOTB)
  int tid_=threadIdx.x; asm volatile("":"+v"(tid_));
  const int tid=tid_,lane=tid&63,r32=lane&31,hi=lane>>5; const int wid=__builtin_amdgcn_readfirstlane(tid>>6);
  const int rb=wid>>2,cb=wid&3;
  const unsigned lds0=(unsigned)(uintptr_t)shm; const lds_cptr shm3=(lds_cptr)shm;
  const bf16*ksrc=proj+ck+rowbase*DM+lane*8+wid*512; const bf16*qsrc=proj+cq+rowbase*DM+lane*8+wid*512;
  const bf16*vsrc=proj+cv+rowbase*DM+(wid>>2)*2048+(wid&3)*512+lane*8;
  const unsigned kdst=lds0+LDS_K+wid*1024, qdst=lds0+R2_Q+wid*1024, vdst=lds0+LDS_V+wid*1024;
  #define R2_DMA(t,slot) do{ glds16(ksrc+(long)(t)*KVBLK*DM,(unsigned)__builtin_amdgcn_readfirstlane(kdst+(slot))); glds16(qsrc+(long)(t)*KVBLK*DM,(unsigned)__builtin_amdgcn_readfirstlane(qdst+(slot))); \
    glds16(vsrc+(long)(t)*KVBLK*DM,(unsigned)__builtin_amdgcn_readfirstlane(vdst+2*(slot))); glds16(vsrc+(long)(t)*KVBLK*DM+GSTR,(unsigned)__builtin_amdgcn_readfirstlane(vdst+2*(slot)+8192)); }while(0)
  const lds_cptr kp0=shm3+LDS_K+hi*1024+r32*16;
  const lds_cptr qp0=shm3+R2_Q+hi*1024+(32*rb+r32)*16;
  const lds_cptr ktp0=shm3+LDS_K+(4*rb+2*((lane>>4)&1)+((lane&3)>>1))*1024+(4*hi+((lane&15)>>2))*16+(lane&1)*8;
  const lds_cptr vp0=shm3+LDS_V+((lane>>4)&1)*32+(lane&3)*8+(4*hi+((lane&15)>>2))*64+cb*4096;
  const lds_cptr sr0=shm3+R2_SIMG+(32*cb+r32)*R2_SROW+hi*16;
  char*const sw0=shm+R2_SIMG+(32*cb+r32)*R2_SROW+(32*rb+4*hi)*2;
  const int qrow=32*rb+r32;
  char*const stw=shm+R2_STG+qrow*R2_STROW+(32*cb+4*hi)*2;
  const int ch=lane&15, frow=8*wid+(lane>>4);
  const char*const str=shm+R2_STG+frow*R2_STROW+ch*16;
  const bf16*gsrc=proj+cg+(long)(ch>>3)*GSTR+(rowbase+frow)*DM+(ch&7)*8;
  unsigned short*msrc=mixh+(rowbase+frow)*(long)DMX+ch*8;
  float gd[8];
  #pragma unroll
  for(int r=0;r<8;++r)gd[r]=gain[ch*8+r];
  const float g64=__builtin_amdgcn_exp2f(64.f*lgam);
  f32x16 T,O;
  { _Pragma("unroll") for(int r=0;r<16;++r){float z_,y_;asm volatile("v_mov_b32 %0, 0\n\tv_mov_b32 %1, 0":"=v"(z_),"=v"(y_));T[r]=z_;O[r]=y_;} }
  #define MF32(a,b,c) __builtin_amdgcn_mfma_f32_32x32x16_bf16(a,b,c,0,0,0)
  asm volatile("s_waitcnt vmcnt(0) lgkmcnt(0)\n\ts_barrier":::"memory");
  { _Pragma("unroll") for(int r=0;r<8;++r)asm volatile("":"+v"(gd[r])); }
  const int sA=slot0,sB=NXS(sA),sC=NXS(sB);
  const unsigned gdst=lds0+R2_GATE+wid*2048; const char*const grd=shm+R2_GATE+wid*2048+lane*16;
  #define R2_GDMA(tt) do{ const bf16*gp_=gsrc+(long)(tt)*KVBLK*DM; asm volatile("s_waitcnt lgkmcnt(0)":::"memory"); glds16(gp_,(unsigned)__builtin_amdgcn_readfirstlane(gdst)); glds16(gp_+(long)4*DM,(unsigned)__builtin_amdgcn_readfirstlane(gdst+1024)); }while(0)
  if(!pre){ glds16(ksrc,(unsigned)__builtin_amdgcn_readfirstlane(kdst+sA)); glds16(vsrc,(unsigned)__builtin_amdgcn_readfirstlane(vdst+2*sA)); glds16(vsrc+GSTR,(unsigned)__builtin_amdgcn_readfirstlane(vdst+2*sA+8192)); }
  glds16(qsrc,(unsigned)__builtin_amdgcn_readfirstlane(qdst+sA));
  R2_DMA(1,sB);
  { u32x2r z_; z_.x=0u; z_.y=0u;
    #pragma unroll
    for(int g4=0;g4<4;++g4)*reinterpret_cast<u32x2r*>(sw0+g4*16)=z_; }
  int s_cur=sA,s_n1=sB,s_n2=sC;
  u32x4 ow[2];
  #define R2_FINAL() do{ u32x4 av_[2],gv_[2]; float qv_[2]; \
      _Pragma("unroll") for(int k=0;k<2;++k){ av_[k]=*reinterpret_cast<const u32x4*>(str+k*4*R2_STROW); gv_[k]=*reinterpret_cast<const u32x4*>(grd+k*1024); } \
      _Pragma("unroll") for(int k=0;k<2;++k){ const u32x4 a_=av_[k]; float s_=0.f; \
        _Pragma("unroll") for(int e=0;e<4;++e){ const float lo_=__uint_as_float(a_[e]<<16),hi_=__uint_as_float(a_[e]&0xffff0000u); s_=__builtin_fmaf(lo_,lo_,s_); s_=__builtin_fmaf(hi_,hi_,s_); } qv_[k]=s_; } \
      _Pragma("unroll") for(int o_=1;o_<16;o_<<=1){ _Pragma("unroll") for(int k=0;k<2;++k)qv_[k]+=__shfl_xor(qv_[k],o_); } \
      _Pragma("unroll") for(int k=0;k<2;++k){ const u32x4 a_=av_[k]; const float rs_=__builtin_amdgcn_rsqf(qv_[k]*(1.0f/128.0f)+1e-6f); \
        _Pragma("unroll") for(int e=0;e<4;++e){ const float lo_=__uint_as_float(a_[e]<<16),hi_=__uint_as_float(a_[e]&0xffff0000u); const unsigned gw_=gv_[k][e]; \
          ow[k][e]=cvtpk_s(lo_*rs_*gd[2*e]*__uint_as_float(gw_<<16),hi_*rs_*gd[2*e+1]*__uint_as_float(gw_&0xffff0000u)); } } }while(0)
  #define R2_STORE(tt) do{ unsigned short*mp_=msrc+(long)(tt)*KVBLK*DMX; _Pragma("unroll") for(int k=0;k<2;++k)*(__attribute__((address_space(1))) u32x4*)(mp_+(long)k*4*DMX)=ow[k]; }while(0)
  #define R2_BODY(t,GV) do{ \
    if(t<=1){ WAIT_BAR(4); } else if(t==31){ WAIT_BAR(2); } else { WAIT_BAR(6); } \
    const lds_cptr vt_=vp0+2*s_cur; const lds_cptr kt_=ktp0+s_cur; const lds_cptr kf_=kp0+s_cur; const lds_cptr qf_=qp0+s_cur; const lds_cptr sr_=sr0; \
    bf16x8 vf[4],ka[4],sf[4],qf[4],kb0[4],kb1[4]; \
    _Pragma("unroll") \
    for(int ks=0;ks<4;++ks){ const s16x4 b0_=vtr(vt_+ks*1024),b1_=vtr(vt_+ks*1024+512); vf[ks]=(bf16x8){b0_[0],b0_[1],b0_[2],b0_[3],b1_[0],b1_[1],b1_[2],b1_[3]}; \
      const s16x4 a0_=vtr(kt_+ks*256),a1_=vtr(kt_+ks*256+128); ka[ks]=(bf16x8){a0_[0],a0_[1],a0_[2],a0_[3],a1_[0],a1_[1],a1_[2],a1_[3]}; } \
    _Pragma("unroll") \
    for(int d0=0;d0<4;++d0){ sf[d0]=*(const __attribute__((address_space(3))) bf16x8*)(sr_+d0*32); qf[d0]=*(const __attribute__((address_space(3))) bf16x8*)(qf_+d0*2048); \
      kb0[d0]=*(const __attribute__((address_space(3))) bf16x8*)(kf_+d0*2048); kb1[d0]=*(const __attribute__((address_space(3))) bf16x8*)(kf_+d0*2048+512); } \
    SBAR(); \
    if(t>0){ R2_FINAL(); } \
    R2_GDMA(t); \
    if(t+2<32){ R2_DMA(t+2,s_n2); } \
    asm volatile("s_waitcnt lgkmcnt(0)":::"memory"); SBAR(); \
    f32x16 p0,p1; \
 \
    _Pragma("unroll") \
    for(int d0=0;d0<4;++d0){ O=MF32(sf[d0],qf[d0],d0==0?f32x16{}:O); T=MF32(ka[d0],vf[d0],T); p0=MF32(kb0[d0],qf[d0],d0==0?f32x16{}:p0); p1=MF32(kb1[d0],qf[d0],d0==0?f32x16{}:p1); SBAR(); } \
    { _Pragma("unroll") for(int r=0;r<16;++r){ const int kv=4*hi+(r&3)+8*(r>>2); p0[r]=(kv>qrow)?0.f:p0[r]; p1[r]=(kv+32>qrow)?0.f:p1[r]; } } \
    { u32x4 pw0,pw1,pw2,pw3; \
      pw0=(u32x4){cvtpk_s(p0[0],p0[1]),cvtpk_s(p0[2],p0[3]),cvtpk_s(p0[4],p0[5]),cvtpk_s(p0[6],p0[7])}; pw1=(u32x4){cvtpk_s(p0[8],p0[9]),cvtpk_s(p0[10],p0[11]),cvtpk_s(p0[12],p0[13]),cvtpk_s(p0[14],p0[15])}; \
      pw2=(u32x4){cvtpk_s(p1[0],p1[1]),cvtpk_s(p1[2],p1[3]),cvtpk_s(p1[4],p1[5]),cvtpk_s(p1[6],p1[7])}; pw3=(u32x4){cvtpk_s(p1[8],p1[9]),cvtpk_s(p1[10],p1[11]),cvtpk_s(p1[12],p1[13]),cvtpk_s(p1[14],p1[15])}; \
      O=MF32(vf[0],__builtin_bit_cast(bf16x8,pw0),O); O=MF32(vf[1],__builtin_bit_cast(bf16x8,pw1),O); O=MF32(vf[2],__builtin_bit_cast(bf16x8,pw2),O); O=MF32(vf[3],__builtin_bit_cast(bf16x8,pw3),O); } \
    asm volatile("s_waitcnt lgkmcnt(0)\n\ts_barrier":::"memory"); \
    { _Pragma("unroll") for(int r=0;r<16;++r)T[r]*=g64; } \
    if(t<31){ char*sw_=sw0; \
      _Pragma("unroll") for(int g4=0;g4<4;++g4){ u32x2r w_; w_.x=cvtpk_s(T[4*g4],T[4*g4+1]); w_.y=cvtpk_s(T[4*g4+2],T[4*g4+3]); *reinterpret_cast<u32x2r*>(sw_+g4*16)=w_; } } \
    { _Pragma("unroll") for(int g=0;g<4;++g){ u32x2r w_; w_.x=cvtpk_s(O[4*g],O[4*g+1]); w_.y=cvtpk_s(O[4*g+2],O[4*g+3]); *reinterpret_cast<u32x2r*>(stw+g*16)=w_; } } \
    if(t>0){ R2_STORE(t-1); } \
    { const int s_=s_cur; s_cur=s_n1; s_n1=s_n2; s_n2=s_; } \
  }while(0)
  asm volatile(".p2align 6");
  for(int t=0;t<32;++t){ R2_BODY(t,0); }
  WAIT_BAR(0);
  { R2_FINAL(); R2_STORE(31); }
  #undef R2_DMA
  #undef R2_FINAL
  #undef R2_STORE
  #undef R2_BODY
  #undef R2_GDMA
  #undef MF32
  #undef NXS
}
constexpr int ATTN_LDS_BYTES=LDS_BYTES;
#undef SBAR
#undef WAIT_BAR
}
#ifndef PG8_SP2
#define PG8_SP2 true
#endif
#ifndef PG8_ALIGN
#define PG8_ALIGN true
#endif
#ifndef RET_NAIVE
#define RET_NAIVE 0
#endif
#ifndef PROBE_DUP
#define PROBE_DUP 0
#endif
constexpr int ATT_THR = 40;
#ifndef NO_TSKIP
#define NO_TSKIP 0
#endif
#ifndef STAGGER_US
#define STAGGER_US 0
#endif
constexpr int NWAVES = 8;
using pg8::NORM_EPS;
#ifndef MK_PER_PHASE
#define MK_PER_PHASE 0
#endif
constexpr int BATCH = 32, SEQ = 2048, D = 1024, DEPTH = 2;
constexpr int M = BATCH * SEQ;
constexpr int NIN = 3072, FF = 2816, NGU = 2 * FF;
constexpr int C_RQ = 0, C_RK = 256, C_RV = 512, C_RG = 1024, C_DQ = 1536, C_DK = 2048, C_DV = 2560;
constexpr float LOG2E = 1.4426950408889634f;
constexpr float C2 = 0.125f * LOG2E;
constexpr int N_PHASES = 12;
constexpr size_t MiB = 1u << 20;
constexpr size_t WS_CTL = 0, CTL_ZERO_BYTES = 64 * 1024;
constexpr size_t WS_W = 2 * MiB, W_LAYER = 25 * MiB, W_IN = 0, W_OUT = 6 * MiB, W_GU = 8 * MiB, W_DN = 19 * MiB;
constexpr size_t WS_SSA = 52 * MiB, WS_SSB = 56 * MiB;
constexpr size_t WS_HB = 64 * MiB;
constexpr size_t WS_MIX = 192 * MiB;
constexpr size_t WS_PROJ = 320 * MiB;
constexpr size_t WS_END = 704 * MiB;
static_assert(W_DN + (size_t)D * FF * 2 <= W_LAYER && WS_W + 2 * W_LAYER <= WS_SSA && WS_SSB + (size_t)M * 64 <= WS_HB && WS_HB + (size_t)M * D * 2 <= WS_MIX && WS_MIX + (size_t)M * D * 2 <= WS_PROJ && WS_PROJ + (size_t)M * NIN * 2 <= WS_END, "d_ws map");
constexpr size_t WS_LAM = 60 * MiB;
constexpr size_t WS_QN = 61 * MiB, WS_KN = 61 * MiB + 65536;
constexpr int CW_BAR = 1024;
constexpr int RING_OFF = 0, RING_BYTES = 157696;
constexpr int LDSCTL_OFF = RING_BYTES, MISC_OFF = LDSCTL_OFF + 320;
constexpr int LDS_BYTES = 158720;
static_assert(MISC_OFF + 128 <= LDS_BYTES && attn_body::ATTN_LDS_BYTES <= RING_BYTES && pg8::STAGE_BYTES <= RING_BYTES, "LDS map");
#define GAS __attribute__((address_space(1)))
#define LAS __attribute__((address_space(3)))
typedef unsigned short bf16;
typedef unsigned v4u __attribute__((ext_vector_type(4)));
typedef float f32x4 __attribute__((ext_vector_type(4)));
typedef short bf16x8 __attribute__((ext_vector_type(8)));
typedef GAS unsigned gu32;
typedef GAS unsigned long long gu64;
#define RLX_AGENT __ATOMIC_RELAXED, __HIP_MEMORY_SCOPE_AGENT
#define LDS_WAIT() asm volatile("s_waitcnt lgkmcnt(0)" ::: "memory")
#define VM_WAIT() asm volatile("s_waitcnt vmcnt(0)" ::: "memory")
__device__ __forceinline__ unsigned long long rt() { return __builtin_amdgcn_s_memrealtime(); }
__device__ __forceinline__ unsigned f2bf(float f) { unsigned u = __builtin_bit_cast(unsigned, f); return (u + 0x7fffu + ((u >> 16) & 1u)) >> 16; }
__device__ __forceinline__ unsigned pk2(float lo, float hi) { return f2bf(lo) | (f2bf(hi) << 16); }

#define XB_TMO      128
#define XB_XCNT(j)  (256  + 64 * (j))
#define XB_XSUB(j)  (1280 + 64 * (j))
#define XB_XGEN(j)  (2304 + 64 * (j))
#define XB_TOP      3328
#define XB_TOPGEN   3392
#define XCD_BAR_WORDS 3456
#define XB_TAGMAX(j) (3520 + 64 * (j))
#define XB_TAGNEG(j) (4544 + 64 * (j))
#define XB_SPIN_CAP (1u << 22)

__device__ __forceinline__ unsigned xb_ld(unsigned* p)              { return __hip_atomic_load(p, __ATOMIC_RELAXED, __HIP_MEMORY_SCOPE_AGENT); }
__device__ __forceinline__ unsigned xb_add(unsigned* p, unsigned v) { return __hip_atomic_fetch_add(p, v, __ATOMIC_RELAXED, __HIP_MEMORY_SCOPE_AGENT); }
__device__ __forceinline__ unsigned xb_xcc_id() { return (unsigned)__builtin_amdgcn_s_getreg((3 << 11) | 20) & 0xFu; }
#define XB_SPIN(cond, bar) do { unsigned _sp = 0; while (cond) { __builtin_amdgcn_s_sleep(1); \
    if ((++_sp & 255u) == 0u) { if (xb_ld(&(bar)[XB_TMO])) break; if (_sp > XB_SPIN_CAP) { atomicAdd(&(bar)[XB_TMO], 1u); break; } } } } while (0)

struct XcdBarrier {
    unsigned* bar; unsigned x;
    volatile LAS unsigned* st;
};

__device__ __forceinline__ XcdBarrier xcd_barrier_post(unsigned* bar, volatile LAS unsigned* st) {
    XcdBarrier b; b.bar = bar; b.x = xb_xcc_id(); b.st = st;
    if (threadIdx.x == 0) { (void)xb_add(&bar[XB_XCNT(b.x)], 1u);
}
    return b;
}
__device__ __forceinline__ void xcd_barrier_complete(unsigned* bar, unsigned x, unsigned& nloc, unsigned& nx) {
    const unsigned G = gridDim.x * gridDim.y * gridDim.z;
    unsigned sum, cnt, mine, sp = 0u;
    for (;;) {
        sum = 0u; cnt = 0u; mine = 0u;
#pragma unroll
        for (unsigned j = 0; j < 16; ++j) { const unsigned c = xb_ld(&bar[XB_XCNT(j)]); sum += c; cnt += (c > 0u) ? 1u : 0u; mine = (j == x) ? c : mine; }
        if (sum == G) break;
        __builtin_amdgcn_s_sleep(1);
        if ((++sp & 255u) == 0u) { if (xb_ld(&bar[XB_TMO])) break; if (sp > XB_SPIN_CAP) { atomicAdd(&bar[XB_TMO], 1u); break; } }
    }
    nloc = mine > 0u ? mine : 1u; nx = cnt > 0u ? cnt : 1u;
}

__device__ __forceinline__ void xcd_barrier(const XcdBarrier& b, bool may_local = false) {
    asm volatile("s_waitcnt vmcnt(0)" ::: "memory");
    __syncthreads();
    if (threadIdx.x == 0) {
        unsigned* bar = b.bar; unsigned bx_ = b.x; asm volatile("" : "+s"(bx_));
        __builtin_amdgcn_s_waitcnt(0);
        unsigned nloc = b.st[0], nx = b.st[1];
        if (nloc == 0u) { xcd_barrier_complete(bar, bx_, nloc, nx); b.st[0] = nloc; b.st[1] = nx; }
        const unsigned old = xb_add(&bar[XB_XSUB(bx_)], 1u);
        const unsigned gen = old / nloc;
        if (old + 1u == (gen + 1u) * nloc && may_local && b.st[2] != 0u) {
            __builtin_amdgcn_fence(__ATOMIC_ACQUIRE, "agent");
            xb_add(&bar[XB_XGEN(bx_)], 1u);
            asm volatile("s_waitcnt vmcnt(0)" ::: "memory");
        } else
        if (old + 1u == (gen + 1u) * nloc) {
            __builtin_amdgcn_fence(__ATOMIC_RELEASE, "agent");
            asm volatile("s_waitcnt vmcnt(0)" ::: "memory");
            const unsigned og = xb_add(&bar[XB_TOP], 1u);
            const unsigned tg = og / nx;
            if (og + 1u == (tg + 1u) * nx) xb_add(&bar[XB_TOPGEN], 1u);
            else XB_SPIN(xb_ld(&bar[XB_TOPGEN]) == tg, bar);
            __builtin_amdgcn_fence(__ATOMIC_ACQUIRE, "agent");
            xb_add(&bar[XB_XGEN(bx_)], 1u);
            asm volatile("s_waitcnt vmcnt(0)" ::: "memory");
        } else {
            XB_SPIN(xb_ld(&bar[XB_XGEN(bx_)]) == gen, bar);
            __builtin_amdgcn_fence(__ATOMIC_ACQUIRE, "agent");
            asm volatile("s_waitcnt vmcnt(0)" ::: "memory");
        }
    }
    __syncthreads();
}

__device__ __forceinline__ void xcd_tag_post(const XcdBarrier& b) {
    if (threadIdx.x == 0) { unsigned x = b.x; asm volatile("" : "+s"(x)); const unsigned tag = blockIdx.x & 7u;
        (void)__hip_atomic_fetch_max(&b.bar[XB_TAGMAX(x)], tag + 1u, __ATOMIC_RELAXED, __HIP_MEMORY_SCOPE_AGENT);
        (void)__hip_atomic_fetch_max(&b.bar[XB_TAGNEG(x)], 8u - tag, __ATOMIC_RELAXED, __HIP_MEMORY_SCOPE_AGENT); }
}
__device__ __forceinline__ void xcd_local_check(const XcdBarrier& b) {
    if (threadIdx.x == 0) {
        unsigned ok = (gridDim.x * gridDim.y * gridDim.z == 256u) ? 1u : 0u, npop = 0u;
#pragma nounroll
        for (unsigned j_ = 0; j_ < 16; ++j_) { unsigned j = j_; asm volatile("" : "+s"(j));
            const unsigned c = xb_ld(&b.bar[XB_XCNT(j)]);
            if (c) { ++npop; const unsigned tmax = xb_ld(&b.bar[XB_TAGMAX(j)]), tneg = xb_ld(&b.bar[XB_TAGNEG(j)]); if (c != 32u || tmax - 1u != 8u - tneg) ok = 0u; } }
        if (npop != 8u) ok = 0u;
        b.st[2] = ok;
    }
    __syncthreads();
}
struct Frame {
    LAS unsigned char* lds;
    volatile LAS unsigned* MISC;
    gu32* ctl;
    int tid, lane, wave;
    int vcu, G;
};
__device__ __forceinline__ float wave_sum(float v) {
#pragma unroll
    for (int o = 1; o < 64; o <<= 1) v += __shfl_xor(v, o);
    return v;
}
__device__ __forceinline__ float bf2f(bf16 b) { return __builtin_bit_cast(float, (unsigned)b << 16); }
__device__ __forceinline__ float bflo(unsigned w) { return __builtin_bit_cast(float, w << 16); }
__device__ __forceinline__ float bfhi(unsigned w) { return __builtin_bit_cast(float, w & 0xffff0000u); }
__device__ __forceinline__ float lam_init_of(int l) { return l == 0 ? 0.2f : 0.35550907f; }

template <int MODE, bool HAS_GAIN>
__device__ __forceinline__ void p0_transpose_item(const float* W, int K, int N, bf16* WT, const float* gain, LAS float* scr, int item, int lane) {
    const int nblk = N / 32, kb = item / nblk, nb = item % nblk, k0 = 64 * kb, n0 = 32 * nb;
    float cs = 1.f;
    if (MODE == 1) { if (n0 >= C_RK && n0 < C_RV) cs = 0.125f; else if (n0 >= C_DQ && n0 < C_DK) cs = C2; }
#pragma unroll 8
    for (int i = 0; i < 32; ++i) { const int kk = 2 * i + (lane >> 5); const float g = HAS_GAIN ? gain[k0 + kk] * cs : cs; scr[kk * 33 + (lane & 31)] = W[(size_t)(k0 + kk) * N + n0 + (lane & 31)] * g; }
    LDS_WAIT(); asm volatile("" ::: "memory");
    const int c = lane & 7;
#pragma unroll
    for (int j = 0; j < 4; ++j) { const int n = (lane >> 3) + 8 * j; const LAS float* s = scr + (8 * c) * 33 + n;
        v4u o; o.x = pk2(s[0 * 33], s[1 * 33]); o.y = pk2(s[2 * 33], s[3 * 33]); o.z = pk2(s[4 * 33], s[5 * 33]); o.w = pk2(s[6 * 33], s[7 * 33]);
        const int nn = n0 + n; int drow = nn;
        if (MODE == 2) drow = 256 * (nn >> 7) + 64 * ((nn >> 5) & 3) + (nn & 31);
        if (MODE == 3) drow = 256 * (nn >> 7) + 64 * ((nn >> 5) & 3) + 32 + (nn & 31);
        *(GAS v4u*)(WT + (size_t)drow * K + k0 + 8 * c) = o; }
    LDS_WAIT(); asm volatile("" ::: "memory");
}
struct Ptrs {
    const float *x, *attn_norm, *w_in, *ret_norm, *lq1, *lk1, *lq2, *lk2, *diff_norm, *w_out, *ffn_norm, *w_gate, *w_up, *w_down, *final_norm;
    float* out; unsigned char* ws;
};

struct Args { const float* in[15]; float* out; unsigned char* ws; int ph_lo, ph_hi; };
typedef const __attribute__((address_space(4))) Args* KArgsPtr;
__device__ __forceinline__ KArgsPtr kargs() { KArgsPtr p = (KArgsPtr)__builtin_amdgcn_kernarg_segment_ptr(); asm volatile("" : "+s"(p)); return p; }
__device__ __forceinline__ void load_ptrs(Ptrs& P) {
    KArgsPtr a = kargs();
#define GP(T, e) ((T*)(GAS T*)(e))
    P.x = GP(const float, a->in[0]); P.attn_norm = GP(const float, a->in[1]); P.w_in = GP(const float, a->in[2]); P.ret_norm = GP(const float, a->in[3]);
    P.lq1 = GP(const float, a->in[4]); P.lk1 = GP(const float, a->in[5]); P.lq2 = GP(const float, a->in[6]); P.lk2 = GP(const float, a->in[7]);
    P.diff_norm = GP(const float, a->in[8]); P.w_out = GP(const float, a->in[9]); P.ffn_norm = GP(const float, a->in[10]); P.w_gate = GP(const float, a->in[11]);
    P.w_up = GP(const float, a->in[12]); P.w_down = GP(const float, a->in[13]); P.final_norm = GP(const float, a->in[14]);
    P.out = GP(float, a->out); P.ws = GP(unsigned char, a->ws);
#undef GP
}
__device__ __forceinline__ void make_frame(Frame& F, unsigned char* lds) {
    int t = threadIdx.x; asm volatile("" : "+v"(t));
    F.lds = (LAS unsigned char*)lds; F.MISC = (volatile LAS unsigned*)(F.lds + MISC_OFF);
    F.tid = t; F.lane = t & 63; F.wave = __builtin_amdgcn_readfirstlane(t >> 6);
    F.G = gridDim.x; { const int bx = blockIdx.x; F.vcu = (F.G % 8 == 0) ? (bx % 8) * (F.G / 8) + bx / 8 : bx; }
}
__device__ __forceinline__ void p0_prologue(unsigned char* lds_) {
    Frame F; make_frame(F, lds_); Ptrs P; load_ptrs(P);
    LAS float* scr = (LAS float*)(F.lds + RING_OFF + F.wave * 16384);
    const int gw = F.vcu * NWAVES + F.wave, NGW = F.G * NWAVES;
    constexpr int I_IN = (D / 64) * (NIN / 32), I_OUT = (D / 64) * (D / 32), I_G = (D / 64) * (FF / 32), I_DN = (FF / 64) * (D / 32);
    constexpr int I_LAYER = I_IN + I_OUT + 2 * I_G + I_DN;
    for (int it = gw; it < DEPTH * I_LAYER; it += NGW) {
        const int l = it / I_LAYER; int r = it % I_LAYER;
        bf16* wl = (bf16*)(P.ws + WS_W + (size_t)l * W_LAYER);
        if (r < I_IN) { p0_transpose_item<1, true>(P.w_in + (size_t)l * D * NIN, D, NIN, (bf16*)((unsigned char*)wl + W_IN), P.attn_norm + l * D, scr, r, F.lane); continue; } r -= I_IN;
        if (r < I_OUT) { p0_transpose_item<0, false>(P.w_out + (size_t)l * D * D, D, D, (bf16*)((unsigned char*)wl + W_OUT), nullptr, scr, r, F.lane); continue; } r -= I_OUT;
        if (r < I_G) { p0_transpose_item<2, true>(P.w_gate + (size_t)l * D * FF, D, FF, (bf16*)((unsigned char*)wl + W_GU), P.ffn_norm + l * D, scr, r, F.lane); continue; } r -= I_G;
        if (r < I_G) { p0_transpose_item<3, true>(P.w_up + (size_t)l * D * FF, D, FF, (bf16*)((unsigned char*)wl + W_GU), P.ffn_norm + l * D, scr, r, F.lane); continue; } r -= I_G;
        p0_transpose_item<0, false>(P.w_down + (size_t)l * FF * D, FF, D, (bf16*)((unsigned char*)wl + W_DN), nullptr, scr, r, F.lane);
    }
    if (gw == 0) {
        for (int l = 0; l < DEPTH; ++l) { const float s1 = wave_sum(P.lq1[l * 64 + F.lane] * P.lk1[l * 64 + F.lane]), s2 = wave_sum(P.lq2[l * 64 + F.lane] * P.lk2[l * 64 + F.lane]);
            if (F.lane == 0) ((GAS float*)(P.ws + WS_LAM))[l] = __expf(s1) - __expf(s2) + lam_init_of(l); } }
    bf16* hb = (bf16*)(P.ws + WS_HB); float* ssa = (float*)(P.ws + WS_SSA);
    for (int m0 = gw; m0 < M; m0 += 2 * NGW) {
        f32x4 v[2][4]; float s[2] = {0.f, 0.f};
#pragma unroll
        for (int r = 0; r < 2; ++r) { const int m = m0 + r * NGW; const GAS f32x4* xr = (const GAS f32x4*)(P.x + (size_t)(m < M ? m : m0) * D) + F.lane;
#pragma unroll
            for (int j = 0; j < 4; ++j) v[r][j] = xr[64 * j]; }
#pragma unroll
        for (int r = 0; r < 2; ++r) { const int m = m0 + r * NGW; if (m >= M) break;
#pragma unroll
            for (int j = 0; j < 4; ++j) s[r] += (v[r][j].x * v[r][j].x + v[r][j].y * v[r][j].y) + (v[r][j].z * v[r][j].z + v[r][j].w * v[r][j].w);
            s[r] = wave_sum(s[r]);
            GAS unsigned long long* o8 = (GAS unsigned long long*)(hb + (size_t)m * D) + F.lane;
#pragma unroll
            for (int j = 0; j < 4; ++j) o8[64 * j] = (unsigned long long)pk2(v[r][j].x, v[r][j].y) | ((unsigned long long)pk2(v[r][j].z, v[r][j].w) << 32);
            if (F.lane < 16) ssa[(size_t)m * 16 + F.lane] = F.lane == 0 ? s[r] : 0.f; }
    }
}
__device__ __forceinline__ void final_norm_phase(unsigned char* lds_) {
    Frame F; make_frame(F, lds_); Ptrs P; load_ptrs(P);
    const int gw = F.vcu * NWAVES + F.wave, NGW = F.G * NWAVES;
    const bf16* hb = (const bf16*)(P.ws + WS_HB);
    f32x4 g[4];
#pragma unroll
    for (int j = 0; j < 2; ++j) { g[2 * j] = ((const GAS f32x4*)P.final_norm)[128 * j + 2 * F.lane]; g[2 * j + 1] = ((const GAS f32x4*)P.final_norm)[128 * j + 2 * F.lane + 1]; }
    for (int m = gw; m < M; m += NGW) {
        const GAS v4u* hr = (const GAS v4u*)(hb + (size_t)m * D) + F.lane;
        f32x4 v[4]; float s = 0.f;
#pragma unroll
        for (int j = 0; j < 2; ++j) { const v4u w = hr[64 * j];
            v[2 * j] = (f32x4){bflo(w.x), bfhi(w.x), bflo(w.y), bfhi(w.y)}; v[2 * j + 1] = (f32x4){bflo(w.z), bfhi(w.z), bflo(w.w), bfhi(w.w)}; }
#pragma unroll
        for (int j = 0; j < 4; ++j) s += (v[j].x * v[j].x + v[j].y * v[j].y) + (v[j].z * v[j].z + v[j].w * v[j].w);
        const float rs = 1.0f / sqrtf(wave_sum(s) * (1.0f / D) + NORM_EPS);
        GAS f32x4* o = (GAS f32x4*)(P.out + (size_t)m * D);
#pragma unroll
        for (int j = 0; j < 2; ++j) { o[128 * j + 2 * F.lane] = v[2 * j] * rs * g[2 * j]; o[128 * j + 2 * F.lane + 1] = v[2 * j + 1] * rs * g[2 * j + 1]; }
    }
}
template <int KINDS  >
__device__ __forceinline__ void naive_mixer_phase(unsigned char* lds_, int l) {
    Frame F; make_frame(F, lds_); Ptrs P; load_ptrs(P);
    const bf16* proj = (const bf16*)(P.ws + WS_PROJ); bf16* mix = (bf16*)(P.ws + WS_MIX);
    const int gw = F.vcu * NWAVES + F.wave, NGW = F.G * NWAVES, lane = F.lane;
    const float lam_init = lam_init_of(l);
    const float s1 = wave_sum(P.lq1[l * 64 + lane] * P.lk1[l * 64 + lane]), s2 = wave_sum(P.lq2[l * 64 + lane] * P.lk2[l * 64 + lane]);
    const float lam = __expf(s1) - __expf(s2) + lam_init;
    for (int it = gw; it < M * 8; it += NGW) {
        const int m = it >> 3, h = it & 3, kind = (it >> 2) & 1, t = m % SEQ;
        if (!((KINDS >> kind) & 1)) continue;
        const bf16* rowp = proj + (size_t)m * NIN; const bf16* seq0 = proj + (size_t)(m - t) * NIN;
        if (kind == 0) {
            const float q = bf2f(rowp[C_RQ + h * 64 + lane]);
            const float lg = log2f(1.0f - exp2f(-5.0f - (float)h));
            float a0 = 0.f, a1 = 0.f;
            for (int s = 0; s <= t; ++s) { const bf16* pr = seq0 + (size_t)s * NIN;
                const float dot = wave_sum(q * bf2f(pr[C_RK + h * 64 + lane]));
                const float w = dot * exp2f((float)(t - s) * lg);
                const unsigned vv = *(const unsigned*)(pr + C_RV + h * 128 + 2 * lane);
                a0 += w * bflo(vv); a1 += w * bfhi(vv); }
            const float rs = 1.0f / sqrtf(wave_sum(a0 * a0 + a1 * a1) * (1.0f / 128.0f) + NORM_EPS);
            const unsigned gg = *(const unsigned*)(rowp + C_RG + h * 128 + 2 * lane);
            const float g0 = bflo(gg), g1 = bfhi(gg);
            const float y0 = a0 * rs * P.ret_norm[l * 128 + 2 * lane], y1 = a1 * rs * P.ret_norm[l * 128 + 2 * lane + 1];
            const float o0 = g0 / (1.0f + __expf(-g0)) * y0, o1 = g1 / (1.0f + __expf(-g1)) * y1;
            *(unsigned*)(mix + (size_t)m * D + h * 128 + 2 * lane) = pk2(o0, o1);
        } else {
            const float cs = exp2f(-8.0f * (float)(h + 1) / 4.0f) * LOG2E;
            float oj[2][2];
#pragma unroll
            for (int j = 0; j < 2; ++j) {
                const float q = bf2f(rowp[C_DQ + h * 128 + j * 64 + lane]);
                float mx = -INFINITY, lsum = 0.f, a0 = 0.f, a1 = 0.f;
                for (int s = 0; s <= t; ++s) { const bf16* pr = seq0 + (size_t)s * NIN;
                    const float sc = wave_sum(q * bf2f(pr[C_DK + h * 128 + j * 64 + lane])) - cs * (float)(t - s);
                    const unsigned vv = *(const unsigned*)(pr + C_DV + h * 128 + 2 * lane);
                    const float mn = fmaxf(mx, sc), f = exp2f(mx - mn), p = exp2f(sc - mn);
                    lsum = lsum * f + p; a0 = a0 * f + p * bflo(vv); a1 = a1 * f + p * bfhi(vv); mx = mn; }
                oj[j][0] = a0 / lsum; oj[j][1] = a1 / lsum;
            }
            const float d0 = oj[0][0] - lam * oj[1][0], d1 = oj[0][1] - lam * oj[1][1];
            const float rs = 1.0f / sqrtf(wave_sum(d0 * d0 + d1 * d1) * (1.0f / 128.0f) + NORM_EPS) * (1.0f - lam_init);
            *(unsigned*)(mix + (size_t)m * D + 512 + h * 128 + 2 * lane) = pk2(d0 * rs * P.diff_norm[l * 128 + 2 * lane], d1 * rs * P.diff_norm[l * 128 + 2 * lane + 1]);
        }
    }
}


template <int KIND  >
__device__ __forceinline__ void mixer_finalize(const Ptrs& P, int l, char* lds, long row0  , int h, float lam_init) {
    int ln = threadIdx.x & 63; asm volatile("" : "+v"(ln));
    const int wv = __builtin_amdgcn_readfirstlane((int)threadIdx.x >> 6);
    const GAS float* dn = (const GAS float*)((KIND == 0 ? P.diff_norm : P.ret_norm) + l * 128); asm volatile("" : "+s"(dn));
    const attn_body::bf16* stg = (const attn_body::bf16*)(lds + attn_body::LDS_OST) + wv * 4096;
    const int ch = ln & 15;
    float gd[8];
#pragma unroll
    for (int e = 0; e < 8; ++e) gd[e] = dn[ch * 8 + e];
    const int colo = (KIND == 0 ? 512 : 0) + h * 128 + ch * 8;
    unsigned short* mixrow = (unsigned short*)(P.ws + WS_MIX) + (size_t)row0 * D + colo;
    const unsigned short* gaterow = (const unsigned short*)(P.ws + WS_PROJ) + (size_t)row0 * NIN + C_RG + h * 128 + ch * 8;
    v4u av[8]; float qv[8]; v4u gv[8];
#pragma unroll
    for (int k = 0; k < 8; ++k) { const int row = k * 4 + (ln >> 4);
        av[k] = *(const v4u*)(stg + row * 128 + ch * 8);
        if (KIND == 1) gv[k] = *(const GAS v4u*)(gaterow + (size_t)row * NIN); }
#pragma unroll
    for (int k = 0; k < 8; ++k) { const v4u a = av[k];
        const float v0 = bflo(a.x), v1 = bfhi(a.x), v2 = bflo(a.y), v3 = bfhi(a.y), v4 = bflo(a.z), v5 = bfhi(a.z), v6 = bflo(a.w), v7 = bfhi(a.w);
        qv[k] = ((v0 * v0 + v1 * v1) + (v2 * v2 + v3 * v3)) + ((v4 * v4 + v5 * v5) + (v6 * v6 + v7 * v7)); }
#pragma unroll
    for (int o = 1; o < 16; o <<= 1) {
#pragma unroll
        for (int k = 0; k < 8; ++k) qv[k] += __shfl_xor(qv[k], o); }
#pragma unroll
    for (int k = 0; k < 8; ++k) { const int row = k * 4 + (ln >> 4); const v4u a = av[k];
        float v[8];
        v[0] = bflo(a.x); v[1] = bfhi(a.x); v[2] = bflo(a.y); v[3] = bfhi(a.y); v[4] = bflo(a.z); v[5] = bfhi(a.z); v[6] = bflo(a.w); v[7] = bfhi(a.w);
        const float rs = (KIND == 0 ? (1.0f - lam_init) : 1.0f) / sqrtf(qv[k] * (1.0f / 128.0f) + NORM_EPS);
#pragma unroll
        for (int e = 0; e < 8; ++e) v[e] *= rs * gd[e];
        if (KIND == 1) {
            const v4u g0 = gv[k];
            float g[8];
            g[0] = bflo(g0.x); g[1] = bfhi(g0.x); g[2] = bflo(g0.y); g[3] = bfhi(g0.y); g[4] = bflo(g0.z); g[5] = bfhi(g0.z); g[6] = bflo(g0.w); g[7] = bfhi(g0.w);
#pragma unroll
            for (int e = 0; e < 8; ++e) v[e] *= g[e] * __builtin_amdgcn_rcpf(1.0f + __builtin_amdgcn_exp2f(g[e] * -LOG2E));
        }
        v4u o0;
        o0.x = pk2(v[0], v[1]); o0.y = pk2(v[2], v[3]); o0.z = pk2(v[4], v[5]); o0.w = pk2(v[6], v[7]);
        *(GAS v4u*)(mixrow + (size_t)row * D) = o0; }
    asm volatile("s_waitcnt lgkmcnt(0)" ::: "memory");
}
__device__ __forceinline__ int diff_tskip(const float* qn, const float* kn, int b, int hj, int qb, float cs) {
    const float* q4 = qn + (b * 8 + hj) * 32 + 4 * qb; const float* kt = kn + (b * 8 + hj) * 32;
    const float Qn = sqrtf(fmaxf(fmaxf(q4[0], q4[1]), fmaxf(q4[2], q4[3]))) * 1.01f;
    const float Ku = sqrtf(fmaxf(fmaxf(kt[4 * qb], kt[4 * qb + 1]), fmaxf(kt[4 * qb + 2], kt[4 * qb + 3]))) * 1.01f;
    int ts = 0;
    for (int t = 0; t + 1 < 4 * qb; t += 2) {
        const float km = sqrtf(fmaxf(kt[t], kt[t + 1])) * 1.01f;
        if (cs * (float)(256 * qb - 64 * (t + 1) - 63) - Qn * (km + Ku) >= 35.0f) ts = t + 2; else break;
    }
    return __builtin_amdgcn_readfirstlane(ts);
}
constexpr int MIX_NITEM = 36;
constexpr unsigned char MIX_ITEM[MIX_NITEM] = {23, 31, 22, 30, 21, 29, 12, 13, 14, 15, 20, 28, 32, 33, 34, 35, 11, 19, 27, 10, 18, 26, 2, 3, 4, 5, 6, 7, 1, 9, 17, 25, 0, 8, 16, 24};
__device__ __forceinline__ int mix_claim(gu32* ctr, volatile LAS unsigned* mb, int k) {
    if (threadIdx.x == 0) mb[16 + (k & 1)] = __hip_atomic_fetch_add((unsigned*)ctr, 1u, __ATOMIC_RELAXED, __HIP_MEMORY_SCOPE_AGENT);
    __syncthreads();
    return __builtin_amdgcn_readfirstlane((int)mb[16 + (k & 1)]);
}
__device__ __forceinline__ void mixer_phase(unsigned char* lds_, int l, int q_ = 0) {
    Frame F; make_frame(F, lds_); Ptrs P; load_ptrs(P); char* lds = (char*)lds_ + RING_OFF;
    using attn_body::attn_unit;
    const attn_body::bf16* proj = (const attn_body::bf16*)(P.ws + WS_PROJ);
    const float lam_init = lam_init_of(l);
    const float lam = __builtin_bit_cast(float, __builtin_amdgcn_readfirstlane(__builtin_bit_cast(int, ((const GAS float*)(P.ws + WS_LAM))[l])));
    const int b = F.vcu >> 3;
    const long rowbase = (long)b * SEQ;
    volatile LAS int* tst = (volatile LAS int*)(F.lds + LDSCTL_OFF + 512);
    { int tsv = 0;
#if !NO_TSKIP
      LAS float* ldn = (LAS float*)(F.lds + RING_OFF);
      if (F.tid < 256) { ldn[F.tid] = ((const GAS float*)(P.ws + WS_QN))[b * 256 + F.tid]; ldn[256 + F.tid] = ((const GAS float*)(P.ws + WS_KN))[b * 256 + F.tid]; }
      __syncthreads();
      const int hj = F.lane >> 3, qb = F.lane & 7; const float cs = exp2f(-2.0f * (float)((hj >> 1) + 1)) * LOG2E;
      const LAS float* q4 = ldn + hj * 32 + 4 * qb; const LAS float* kt = ldn + 256 + hj * 32;
      const float Qn = sqrtf(fmaxf(fmaxf(q4[0], q4[1]), fmaxf(q4[2], q4[3]))) * 1.01f;
      const float Ku = sqrtf(fmaxf(fmaxf(kt[4 * qb], kt[4 * qb + 1]), fmaxf(kt[4 * qb + 2], kt[4 * qb + 3]))) * 1.01f;
      for (int t = 0; t + 1 < 4 * qb; t += 2) {
          const float km = sqrtf(fmaxf(kt[t], kt[t + 1])) * 1.01f;
          if (cs * (float)(256 * qb - 64 * (t + 1) - 63) - Qn * (km + Ku) >= 35.0f) tsv = t + 2; else break;
      }
#endif
      if (F.wave == 0) tst[F.lane] = tsv;
      __syncthreads(); }
#define TSK(h, j, qb) __builtin_amdgcn_readfirstlane(tst[(2 * (h) + (j)) * 8 + (qb)])
#define GO(c) (((c) >> 6) * (M * 64))
    gu32* ctr = (gu32*)(P.ws + WS_CTL) + (l * 32 + b) * 16 + 8 * q_;
    int slot = 0; attn_body::bf16x8 qr[4]; bool pre = false;
    attn_body::f32x16 T;
#pragma unroll
    for (int r = 0; r < 16; ++r) T[r] = 0.f;
    int nclaim = 0;
    int cur = mix_claim(ctr, F.MISC, nclaim++);
    while (cur < MIX_NITEM) {
        const int nxt = mix_claim(ctr, F.MISC, nclaim++);
        const int it = MIX_ITEM[cur]; const int nit = nxt < MIX_NITEM ? (int)MIX_ITEM[nxt] : -1;
        if (it < 32) {
            const int h = it >> 3, qb = it & 7;
            const float cs = __builtin_bit_cast(float, __builtin_amdgcn_readfirstlane(__builtin_bit_cast(int, exp2f(-2.0f * (float)(h + 1)) * LOG2E)));
            const attn_body::PassArgs a1{qb, GO(C_DQ + h * 128), GO(C_DK + h * 128), GO(C_DV + h * 128), TSK(h, 0, qb)};
            const attn_body::PassArgs a2{qb, GO(C_DQ + h * 128 + 64), GO(C_DK + h * 128 + 64), GO(C_DV + h * 128), TSK(h, 1, qb)};
            attn_body::PassArgs nx = a1; const bool more = nit >= 0;
            if (nit >= 32) nx = attn_body::PassArgs{0, GO(C_RQ + (nit - 32) * 64), GO(C_RK + (nit - 32) * 64), GO(C_RV + (nit - 32) * 128), 0};
            else if (nit >= 0) { const int h2 = nit >> 3, qb2 = nit & 7; nx = attn_body::PassArgs{qb2, GO(C_DQ + h2 * 128), GO(C_DK + h2 * 128), GO(C_DV + h2 * 128), TSK(h2, 0, qb2)}; }
            attn_unit<ATT_THR, 0>(proj, rowbase, a1, cs, lam, lds, slot, pre, qr, true, a2, T);
            attn_unit<ATT_THR, 1>(proj, rowbase, a2, cs, lam, lds, slot, true, qr, more, nx, T);
            mixer_finalize<0>(P, l, lds, rowbase + qb * 256 + F.wave * 32, h, lam_init);
            pre = more;
        } else {
            const int h = it - 32;
            const float lg = h == 0 ? -0.04580368961312479f : h == 1 ? -0.02272007650008353f : h == 2 ? -0.011315313227834146f : -0.005646563141142063f;
            const GAS float* gn = (const GAS float*)(P.ret_norm + l * 128); asm volatile("" : "+s"(gn));
            attn_body::ret_chain(proj, rowbase, GO(C_RQ + h * 64), GO(C_RK + h * 64), GO(C_RV + h * 128), GO(C_RG + h * 128), lg, lds, slot, pre, gn, (unsigned short*)(P.ws + WS_MIX) + h * 128, D);
            pre = false;
            asm volatile("" : "=v"(qr[0]), "=v"(qr[1]), "=v"(qr[2]), "=v"(qr[3]));
        }
        cur = nxt;
    }
#undef TSK
#undef GO
}

template <int l>
__device__ __forceinline__ void layer_phases(const XcdBarrier& bar, unsigned char* lds, int lo, int hi) {
#define GRID_BAR() do { if (!MK_PER_PHASE) xcd_barrier(bar, true); } while (0)
#define GRID_BAR_G() do { if (!MK_PER_PHASE) xcd_barrier(bar); } while (0)
#define IN(k) (lo <= (k) && (k) < hi)
#define BOTH(k) (IN(k) && IN((k) + 1))
#define LP_SETUP() Ptrs P; load_ptrs(P); const int G_ = gridDim.x; LAS unsigned char* ldsr = (LAS unsigned char*)lds + RING_OFF; \
    bf16* hb = (bf16*)(P.ws + WS_HB); bf16* mixb = (bf16*)(P.ws + WS_MIX); bf16* projb = (bf16*)(P.ws + WS_PROJ); bf16* hidb = (bf16*)(P.ws + WS_PROJ); \
    float* ssa = (float*)(P.ws + WS_SSA); float* ssb = (float*)(P.ws + WS_SSB); const unsigned char* wl = P.ws + WS_W + (size_t)l * W_LAYER; \
    (void)hb; (void)mixb; (void)projb; (void)hidb; (void)ssa; (void)ssb; (void)wl
        const int pb = 1 + 5 * l;
        if (IN(pb)) {
            LP_SETUP();
            pg8::Gemm g{hb, (const bf16*)(wl + W_IN), M, NIN, D}; pg8::StaticOrder S; S.init(M, NIN, G_, (int)blockIdx.x);
            pg8::EpiProj E{projb, 64, ssa, (float*)(P.ws + WS_QN), (float*)(P.ws + WS_KN), (long)M * 64, (const LAS float*)(ldsr + pg8::SS_LDS_OFF)};
            for (int rep_ = 0; rep_ < (PROBE_DUP == 1 ? 2 : 1); ++rep_) {
            pg8::gemm_phase<pg8::EpiProj, pg8::StaticOrder, PG8_ALIGN, PG8_SP2>(ldsr, g, S, E);
            if (BOTH(pb)) GRID_BAR(); }
        }
        if (IN(pb + 1)) {
#if PROBE_DUP == 2
            mixer_phase(lds, l, 1); if (BOTH(pb + 1)) GRID_BAR();
#endif
            mixer_phase(lds, l);
#if RET_NAIVE
            naive_mixer_phase<1>(lds, l);
#endif
            if (BOTH(pb + 1)) GRID_BAR_G();
        }
        if (IN(pb + 2)) {
            LP_SETUP();
            pg8::Gemm g{mixb, (const bf16*)(wl + W_OUT), M, D, D}; pg8::StaticOrder S; S.init(M, D, G_, (int)blockIdx.x);
            for (int rep_ = 0; rep_ < (PROBE_DUP == 3 ? 2 : 1); ++rep_) {
            const bool dummy_ = (PROBE_DUP == 3) && rep_ == 0;
            pg8::EpiResid E{hb, dummy_ ? projb : hb, dummy_ ? (float*)(P.ws + WS_END) : ssb};
            pg8::gemm_phase<pg8::EpiResid, pg8::StaticOrder, PG8_ALIGN, PG8_SP2>(ldsr, g, S, E);
            if (BOTH(pb + 2)) GRID_BAR(); }
        }
        if (IN(pb + 3)) {
            LP_SETUP();
            pg8::Gemm g{hb, (const bf16*)(wl + W_GU), M, NGU, D};
#if PROBE_DUP == 7
            typedef pg8::DupOrder P4Order;
#else
            typedef pg8::StaticOrder P4Order;
#endif
            P4Order S; S.init(M, NGU, G_, (int)blockIdx.x);
            pg8::EpiSwiglu E{hidb, (long)M * 32, ssb, (const LAS float*)(ldsr + pg8::SS_LDS_OFF)};
            for (int rep_ = 0; rep_ < (PROBE_DUP == 4 ? 2 : 1); ++rep_) {
            pg8::gemm_phase<pg8::EpiSwiglu, P4Order, PG8_ALIGN, PG8_SP2>(ldsr, g, S, E);
            if (BOTH(pb + 3)) GRID_BAR(); }
        }
        if (IN(pb + 4)) {
            LP_SETUP();
            pg8::Gemm g{hidb, (const bf16*)(wl + W_DN), M, D, FF, 32, (long)M * 32}; pg8::StaticOrder S; S.init(M, D, G_, (int)blockIdx.x);
            for (int rep_ = 0; rep_ < (PROBE_DUP == 5 ? 2 : 1); ++rep_) {
            const bool dummy_ = (PROBE_DUP == 5) && rep_ == 0;
            pg8::EpiResid E{hb, dummy_ ? mixb : hb, dummy_ ? (float*)(P.ws + WS_END) : ssa};
            pg8::gemm_phase<pg8::EpiResid, pg8::StaticOrder, PG8_ALIGN, PG8_SP2>(ldsr, g, S, E);
            if (BOTH(pb + 4)) GRID_BAR_G(); }
        }
    #undef IN
#undef BOTH
#undef GRID_BAR
#undef GRID_BAR_G
#undef LP_SETUP
}

__global__ void __launch_bounds__(NWAVES * 64, 2) hybrid_fwd(Args args) {
    extern __shared__ __attribute__((aligned(16))) unsigned char lds[];
    for (int u = threadIdx.x; u < (LDS_BYTES - LDSCTL_OFF) / 4; u += NWAVES * 64) ((LAS unsigned*)((LAS unsigned char*)lds + LDSCTL_OFF))[u] = 0u;
    __syncthreads();
    unsigned* barw = (unsigned*)(args.ws + WS_CTL) + CW_BAR;
    XcdBarrier bar; bar.bar = barw; bar.x = 0; bar.st = nullptr;
    if (!MK_PER_PHASE) bar = xcd_barrier_post(barw, (volatile LAS unsigned*)((LAS unsigned char*)lds + MISC_OFF) + 8);
#define GRID_BAR() do { if (!MK_PER_PHASE) xcd_barrier(bar); } while (0)
    const int lo = args.ph_lo, hi = args.ph_hi;
#define IN(k) (lo <= (k) && (k) < hi)
#define BOTH(k) (IN(k) && IN((k) + 1))
    for (int rep_ = 0; rep_ < (PROBE_DUP == 6 ? 2 : 1); ++rep_) if (IN(0)) { p0_prologue(lds); if (BOTH(0)) { if (!MK_PER_PHASE) xcd_tag_post(bar); GRID_BAR(); if (!MK_PER_PHASE) xcd_local_check(bar); } }
    layer_phases<0>(bar, lds, lo, hi);
    layer_phases<1>(bar, lds, lo, hi);
    if (IN(11)) final_norm_phase(lds);
#undef IN
#undef BOTH
#undef GRID_BAR
}

extern "C" void kernel_launch(void* const* d_in, const int* in_sizes, int n_in, void* d_out, int out_size, void* d_ws, size_t ws_size, hipStream_t stream) {
    static int grid = 0;
    if (grid == 0) {
        if (n_in != 15 || in_sizes[0] != M * D || out_size != M * D || ws_size < WS_END) { fprintf(stderr, "kernel_launch: unexpected shapes (n_in %d, in0 %d, out %d, ws %zu; need ws >= %zu); nothing launched\n", n_in, n_in > 0 ? in_sizes[0] : -1, out_size, ws_size, (size_t)WS_END); grid = -1; return; }
        int dev = 0, cus = 0, per_cu = 0;
        if (hipGetDevice(&dev) != hipSuccess || hipDeviceGetAttribute(&cus, hipDeviceAttributeMultiprocessorCount, dev) != hipSuccess) { grid = -1; return; }
        if (hipFuncSetAttribute((const void*)hybrid_fwd, hipFuncAttributeMaxDynamicSharedMemorySize, LDS_BYTES) != hipSuccess) { fprintf(stderr, "kernel_launch: hipFuncSetAttribute failed\n"); grid = -1; return; }
        if (hipOccupancyMaxActiveBlocksPerMultiprocessor(&per_cu, (const void*)hybrid_fwd, NWAVES * 64, LDS_BYTES) != hipSuccess || per_cu < 1) { fprintf(stderr, "kernel_launch: occupancy query reports %d workgroups per CU\n", per_cu); (void)hipGetLastError(); grid = -1; return; }
        if (cus != 256) { fprintf(stderr, "kernel_launch: built for 256 CUs (the mixer's unit deal), found %d; nothing launched\n", cus); grid = -1; return; }
        grid = cus;
    }
    if (grid < 0) return;
    if (hipMemsetAsync((char*)d_ws + WS_CTL, 0, CTL_ZERO_BYTES, stream) != hipSuccess) return;
    Args a{};
    for (int i = 0; i < 15; ++i) a.in[i] = (const float*)d_in[i];
    a.out = (float*)d_out; a.ws = (unsigned char*)d_ws;
#if MK_PER_PHASE
    for (int p = 0; p < N_PHASES; ++p) { a.ph_lo = p; a.ph_hi = p + 1; hipLaunchKernelGGL(hybrid_fwd, dim3(grid), dim3(NWAVES * 64), LDS_BYTES, stream, a); }
#else
    a.ph_lo = 0; a.ph_hi = N_PHASES;
    hipLaunchKernelGGL(hybrid_fwd, dim3(grid), dim3(NWAVES * 64), LDS_BYTES, stream, a);
#endif
}
```

```cpp
#include <hip/hip_runtime.h>
#include <cstdio>
#include <cstdint>
namespace pg8 {
#define PG8_LAS __attribute__((address_space(3)))
typedef unsigned short bf16_t;
typedef short bf16x8 __attribute__((ext_vector_type(8)));
typedef float f32x4 __attribute__((ext_vector_type(4)));
typedef unsigned u32x4 __attribute__((ext_vector_type(4)));
constexpr int BM = 256, BK = 64, HALF = 128, HTB = HALF * BK * 2  , STAGE_BYTES = 8 * HTB, NXCD = 8, WGM = 8;

__host__ __device__ __forceinline__ int lds_byte(int r, int c) { const int st = (r >> 4) * 2 + (c >> 5), rr = r & 15, cc = c & 31, ob = rr * 64 + cc * 2; return st * 1024 + (ob ^ (((ob >> 9) & 1) << 5)); }
__host__ __device__ __forceinline__ void stage_rc(int b, int& R, int& C) { const int st = b / 1024, sb = b % 1024, swz = sb ^ (((sb >> 9) & 1) << 5); R = (st >> 1) * 16 + swz / 64; C = (st & 1) * 32 + (swz % 64) / 2; }
__host__ __device__ __forceinline__ int perm32(int rho) { const int n = rho >> 4, i = rho & 15; return 8 * (i >> 2) + 4 * n + (i & 3); }

struct Unit { int pm, pn; };
struct Gemm { const bf16_t* A; const bf16_t* Bt; int M, N, K; int a_gc = 0; long a_gs = 0; long a_ks = 0; long a_bx = 0; };

struct StaticOrder {
    int nM, nN, nwg, G, c;
    __host__ __device__ void init(int M, int N, int G_, int c_) { nM = M / BM; nN = N / BM; nwg = nM * nN; G = G_; c = c_; }
    __host__ __device__ bool next(int i, Unit& u) const {
        if (G == 256 && WGM == 8 && NXCD == 8 && (nM & 7) == 0) {
            if (i * 256 + c >= nwg) return false;
            const int w = i * 32 + (c >> 3), x = w >> 3, k = (x >= nN) + (x >= 2 * nN) + (x >= 3 * nN);
            u.pm = 8 * (4 * (c & 7) + k) + (w & 7); u.pn = x - k * nN; return true; }
        const long L = (long)i * G + c; if (L >= nwg) return false;
        int wgid = (int)L; { const int q = nwg / NXCD, r = nwg % NXCD, xcd = wgid % NXCD, off = wgid / NXCD; wgid = (xcd < r ? xcd * (q + 1) : r * (q + 1) + (xcd - r) * q) + off; }
        const int nig = WGM * nN, gid = wgid / nig, fm = gid * WGM, gsz = (nM - fm) < WGM ? (nM - fm) : WGM;
        u.pm = fm + ((wgid % nig) % gsz); u.pn = (wgid % nig) / gsz; return true;
    }
    __device__ __forceinline__ void a_ready(const Unit&) const {}
    __device__ __forceinline__ void done(const Unit&) const {}
    __device__ __forceinline__ bool emit(int) const { return true; }
};
struct DupOrder : StaticOrder {
    __host__ __device__ bool next(int i, Unit& u) const { return StaticOrder::next(i >> 1, u); }
    __device__ __forceinline__ bool emit(int ui) const { return (ui & 1) != 0; }
};

__device__ __forceinline__ unsigned cvt_pk_bf16(float lo, float hi) { unsigned r; asm volatile("v_cvt_pk_bf16_f32 %0, %1, %2" : "=v"(r) : "v"(lo), "v"(hi)); return r; }
typedef float f32x2 __attribute__((ext_vector_type(2)));
typedef __bf16 bf16x2v __attribute__((ext_vector_type(2)));
__device__ __forceinline__ unsigned cvt_pk2(f32x2 v) { return __builtin_bit_cast(unsigned, __builtin_convertvector(v, bf16x2v)); }
typedef unsigned u32x2 __attribute__((ext_vector_type(2)));
#ifndef RET_NAIVE
#define RET_NAIVE 0
#endif
#ifndef PROBE_DUP
#define PROBE_DUP 0
#endif
constexpr bool RET_NAIVE_EPI = RET_NAIVE;
constexpr float NORM_EPS = 1e-6f;
__device__ __forceinline__ float row_rstd(const float* ss, int row, int fq) {
    const f32x4 s4 = *(const f32x4*)(ss + (size_t)row * 16 + 4 * fq);
    float s = (s4[0] + s4[1]) + (s4[2] + s4[3]); s += __shfl_xor(s, 16); s += __shfl_xor(s, 32);
    return __builtin_amdgcn_rsqf(s * (1.0f / 1024.0f) + NORM_EPS);
}
constexpr int SS_LDS_OFF = STAGE_BYTES;
__device__ __forceinline__ float row_ms_l(const PG8_LAS float* ssl, int rl, int fq) {
    const f32x4 s4 = *(const PG8_LAS f32x4*)(ssl + rl * 16 + 4 * fq);
    float s = (s4[0] + s4[1]) + (s4[2] + s4[3]); s += __shfl_xor(s, 16); s += __shfl_xor(s, 32);
    return s * (1.0f / 1024.0f) + NORM_EPS;
}
__device__ __forceinline__ float row_rstd_l(const PG8_LAS float* ssl, int rl, int fq) {
    const f32x4 s4 = *(const PG8_LAS f32x4*)(ssl + rl * 16 + 4 * fq);
    float s = (s4[0] + s4[1]) + (s4[2] + s4[3]); s += __shfl_xor(s, 16); s += __shfl_xor(s, 32);
    return __builtin_amdgcn_rsqf(s * (1.0f / 1024.0f) + NORM_EPS);
}
__device__ __forceinline__ unsigned dpp_ror8(unsigned v) { return (unsigned)__builtin_amdgcn_update_dpp((int)v, (int)v, 0x128, 0xf, 0xf, false); }
struct EpiProj {
    static constexpr bool PERM = true, AFTER_DRAIN = false, PROBE_TWICE = (PROBE_DUP == 8), LDS_SS = true, ACC_INIT = false; static constexpr int EPI_VM = 16;
    bf16_t* O; int ldc; const float* ss; float* qn; float* kn; long gstr; const PG8_LAS float* ssl; unsigned* dz;
    __device__ __forceinline__ void operator()(const f32x4 (&acc)[2][2][4][2], const Unit& u, int wr, int wc, int fr, int fq) const {
        const int row0 = u.pm * BM + wr * 64 + fr, col0 = u.pn * BM + wc * 64 + 8 * fq;
        const bool gate_tile = !RET_NAIVE_EPI && (u.pn == 4 || u.pn == 5);
        const bool nrm_tile = (u.pn >= 6 && u.pn < 10);
        float lgv = 0.f; int rmask = 0;
        if (!RET_NAIVE_EPI && u.pn < 2) { const int hh = wc; const float lg = hh == 0 ? -0.04580368961312479f : hh == 1 ? -0.02272007650008353f : hh == 2 ? -0.011315313227834146f : -0.005646563141142063f;
            lgv = u.pn == 0 ? lg : -lg; rmask = 63; }
        float nmx[2] = {0.f, 0.f};
        float rsv[2][4];
#pragma unroll
        for (int ai = 0; ai < 2; ++ai)
#pragma unroll
            for (int m = 0; m < 4; ++m) rsv[ai][m] = row_rstd_l(ssl, wr * 64 + fr + ai * HALF + m * 16, fq);
        const bool lo8 = fr < 8;
        const bool timg = (u.pn < 2) || nrm_tile;
        const bool vimg = (u.pn == 2 || u.pn == 3 || u.pn >= 10);
        bf16_t* obase = O + (size_t)(4 * u.pn + wc) * (size_t)gstr + (timg ? (size_t)(4 * u.pm + wr) * 4096 + ((lo8 ? 0 : 4) + fq) * 512 + (fr & 7) * 8
                                                                      : vimg ? (size_t)(4 * u.pm + wr) * 4096 + (lo8 ? 0 : 2048) + (fr & 7) * 32 + 8 * fq
                                                                      : (size_t)(u.pm * BM + wr * 64 + (fr & 7)) * ldc + 8 * fq + (lo8 ? 0 : 32));
        const int st_m = timg ? 128 : vimg ? 512 : 16 * ldc, st_y = timg ? 64 : vimg ? 256 : 8 * ldc;
#pragma unroll
        for (int ai = 0; ai < 2; ++ai)
#pragma unroll
            for (int m = 0; m < 4; ++m) { const int row = row0 + ai * HALF + m * 16;
                const float sc = rsv[ai][m] * __builtin_amdgcn_exp2f(lgv * (float)(row & rmask)); const f32x2 sc2 = {sc, sc};
                f32x2 V[2][4];
#pragma unroll
                for (int bj = 0; bj < 2; ++bj)
#pragma unroll
                    for (int n = 0; n < 2; ++n)
#pragma unroll
                        for (int p = 0; p < 2; ++p) V[bj][2 * n + p] = (f32x2){acc[ai][bj][m][n][2 * p], acc[ai][bj][m][n][2 * p + 1]} * sc2;
                if (gate_tile) {
                    const f32x2 nl2 = {-1.4426950408889634f, -1.4426950408889634f}, one = {1.0f, 1.0f};
#pragma unroll
                    for (int bj = 0; bj < 2; ++bj) { f32x2 X[4];
#pragma unroll
                        for (int k = 0; k < 4; ++k) X[k] = V[bj][k] * nl2;
#pragma unroll
                        for (int k = 0; k < 4; ++k) X[k] = (f32x2){__builtin_amdgcn_exp2f(X[k][0]), __builtin_amdgcn_exp2f(X[k][1])};
#pragma unroll
                        for (int k = 0; k < 4; ++k) X[k] = X[k] + one;
#pragma unroll
                        for (int k = 0; k < 4; ++k) X[k] = (f32x2){__builtin_amdgcn_rcpf(X[k][0]), __builtin_amdgcn_rcpf(X[k][1])};
#pragma unroll
                        for (int k = 0; k < 4; ++k) V[bj][k] = V[bj][k] * X[k]; } }
                if (nrm_tile) { f32x2 q2 = V[0][0] * V[0][0];
#pragma unroll
                    for (int k = 1; k < 8; ++k) { const f32x2 v = V[k >> 2][k & 3]; q2 = v * v + q2; }
                    float nq = q2[0] + q2[1]; nq += __shfl_xor(nq, 16); nq += __shfl_xor(nq, 32); nmx[ai] = fmaxf(nmx[ai], nq); }
                u32x4 w[2];
#pragma unroll
                for (int bj = 0; bj < 2; ++bj) { w[bj].x = cvt_pk2(V[bj][0]); w[bj].y = cvt_pk2(V[bj][1]); w[bj].z = cvt_pk2(V[bj][2]); w[bj].w = cvt_pk2(V[bj][3]); }
                u32x4 t, p; t.x = lo8 ? w[1].x : w[0].x; t.y = lo8 ? w[1].y : w[0].y; t.z = lo8 ? w[1].z : w[0].z; t.w = lo8 ? w[1].w : w[0].w;
                p.x = dpp_ror8(t.x); p.y = dpp_ror8(t.y); p.z = dpp_ror8(t.z); p.w = dpp_ror8(t.w);
                u32x4 x, y;
                x.x = lo8 ? w[0].x : p.x; x.y = lo8 ? w[0].y : p.y; x.z = lo8 ? w[0].z : p.z; x.w = lo8 ? w[0].w : p.w;
                y.x = lo8 ? p.x : w[1].x; y.y = lo8 ? p.y : w[1].y; y.z = lo8 ? p.z : w[1].z; y.w = lo8 ? p.w : w[1].w;
                bf16_t* gp = obase + ai * 8192 + m * st_m;
                *(u32x4*)gp = x; *(u32x4*)(gp + st_y) = y; }
        if (nrm_tile) {
#pragma unroll
            for (int ai = 0; ai < 2; ++ai) { float v = nmx[ai];
                v = fmaxf(v, __builtin_bit_cast(float, __builtin_amdgcn_update_dpp(0, __builtin_bit_cast(int, v), 0x128, 0xf, 0xf, false)));
                v = fmaxf(v, __builtin_bit_cast(float, __builtin_amdgcn_update_dpp(0, __builtin_bit_cast(int, v), 0x124, 0xf, 0xf, false)));
                v = fmaxf(v, __builtin_bit_cast(float, __builtin_amdgcn_update_dpp(0, __builtin_bit_cast(int, v), 0x122, 0xf, 0xf, false)));
                v = fmaxf(v, __builtin_bit_cast(float, __builtin_amdgcn_update_dpp(0, __builtin_bit_cast(int, v), 0x121, 0xf, 0xf, false)));
                if (fr == 0 && fq == 0) { const int b = u.pm >> 3, sub = (u.pm & 7) * 4 + 2 * ai + wr;
                    if (u.pn < 8) qn[(b * 8 + (u.pn - 6) * 4 + wc) * 32 + sub] = v; else kn[(b * 8 + (u.pn - 8) * 4 + wc) * 32 + sub] = v; } }
        }
    }
};
struct EpiSwiglu {
    static constexpr bool PERM = true, AFTER_DRAIN = false, PROBE_TWICE = (PROBE_DUP == 9), LDS_SS = true, ACC_INIT = false; static constexpr int EPI_VM = 8;
    bf16_t* O; long gstr; const float* ss; const PG8_LAS float* ssl; unsigned* dz;
    __device__ __forceinline__ void operator()(const f32x4 (&acc)[2][2][4][2], const Unit& u, int wr, int wc, int fr, int fq) const {
        const int row0 = u.pm * BM + wr * 64 + fr; const int gg = 4 * u.pn + wc;
        bf16_t* ob = O + (size_t)(gg >> 1) * (size_t)gstr + (size_t)(gg & 1) * (size_t)(gstr >> 4) + (size_t)(u.pm >> 5) * (size_t)(gstr >> 4) + 8 * fq;
        float rsv[2][4];
#pragma unroll
        for (int ai = 0; ai < 2; ++ai)
#pragma unroll
            for (int m = 0; m < 4; ++m) rsv[ai][m] = row_ms_l(ssl, wr * 64 + fr + ai * HALF + m * 16, fq);
#pragma unroll
        for (int ai = 0; ai < 2; ++ai)
#pragma unroll
            for (int m = 0; m < 4; ++m) { const int row = row0 + ai * HALF + m * 16; const float ms = rsv[ai][m], rs = __builtin_amdgcn_rsqf(ms);
                const f32x2 rsn = {rs * -1.4426950408889634f, rs * -1.4426950408889634f}, ms2 = {ms, ms};
                f32x2 G[4], U[4], X[4];
#pragma unroll
                for (int n = 0; n < 2; ++n)
#pragma unroll
                    for (int p = 0; p < 2; ++p) { G[n * 2 + p] = (f32x2){acc[ai][0][m][n][2 * p], acc[ai][0][m][n][2 * p + 1]}; U[n * 2 + p] = (f32x2){acc[ai][1][m][n][2 * p], acc[ai][1][m][n][2 * p + 1]}; }
#pragma unroll
                for (int k = 0; k < 4; ++k) X[k] = G[k] * rsn;
#pragma unroll
                for (int k = 0; k < 4; ++k) X[k] = (f32x2){__builtin_amdgcn_exp2f(X[k][0]), __builtin_amdgcn_exp2f(X[k][1])};
#pragma unroll
                for (int k = 0; k < 4; ++k) { X[k] = X[k] * ms2 + ms2; G[k] = G[k] * U[k]; }
#pragma unroll
                for (int k = 0; k < 4; ++k) X[k] = (f32x2){__builtin_amdgcn_rcpf(X[k][0]), __builtin_amdgcn_rcpf(X[k][1])};
#pragma unroll
                for (int k = 0; k < 4; ++k) G[k] = G[k] * X[k];
                u32x4 w; w.x = cvt_pk2(G[0]); w.y = cvt_pk2(G[1]); w.z = cvt_pk2(G[2]); w.w = cvt_pk2(G[3]);
                *(u32x4*)(ob + (size_t)row * 32) = w; }
    }
};
__device__ __forceinline__ float bf_lo(unsigned w) { return __builtin_bit_cast(float, w << 16); }
__device__ __forceinline__ float bf_hi(unsigned w) { return __builtin_bit_cast(float, w & 0xffff0000u); }
struct EpiResid {
    static constexpr bool PERM = true, AFTER_DRAIN = false, PROBE_TWICE = false, LDS_SS = false, ACC_INIT = true; static constexpr int EPI_VM = 32;
    const bf16_t* hbin; bf16_t* hb; float* ss; unsigned* dz;
    __device__ __forceinline__ void load_c(u32x4 (&res)[4][2], const Unit& u, int wr, int wc, int fr, int fq, int ai) const {
        const int row0 = u.pm * BM + wr * 64 + fr + ai * HALF, col0 = u.pn * BM + wc * 64 + 8 * fq;
#pragma unroll
        for (int m = 0; m < 4; ++m)
#pragma unroll
            for (int bj = 0; bj < 2; ++bj) res[m][bj] = *(const u32x4*)(hbin + (size_t)(row0 + m * 16) * 1024 + col0 + bj * 32);
    }
    template <int ai> __device__ __forceinline__ void init_acc(f32x4 (&acc)[2][2][4][2], const u32x4 (&res)[4][2]) const {
#pragma unroll
        for (int m = 0; m < 4; ++m)
#pragma unroll
            for (int bj = 0; bj < 2; ++bj) { const u32x4 r = res[m][bj];
                acc[ai][bj][m][0] = (f32x4){bf_lo(r.x), bf_hi(r.x), bf_lo(r.y), bf_hi(r.y)}; acc[ai][bj][m][1] = (f32x4){bf_lo(r.z), bf_hi(r.z), bf_lo(r.w), bf_hi(r.w)}; }
    }
    template <int ai> __device__ __forceinline__ void half(const f32x4 (&acc)[2][2][4][2], const Unit& u, int wr, int wc, int fr, int fq) const {
        const int row0 = u.pm * BM + wr * 64 + fr, col0 = u.pn * BM + wc * 64 + 8 * fq;
#pragma unroll
        for (int m = 0; m < 4; ++m) { const int row = row0 + ai * HALF + m * 16; f32x2 q2 = {0.f, 0.f};
#pragma unroll
            for (int bj = 0; bj < 2; ++bj) { const f32x4 a0 = acc[ai][bj][m][0], a1 = acc[ai][bj][m][1];
                const f32x2 v01 = {a0[0], a0[1]}, v23 = {a0[2], a0[3]}, v45 = {a1[0], a1[1]}, v67 = {a1[2], a1[3]};
                q2 = v01 * v01 + q2; q2 = v23 * v23 + q2; q2 = v45 * v45 + q2; q2 = v67 * v67 + q2;
                u32x4 w; w.x = cvt_pk2(v01); w.y = cvt_pk2(v23); w.z = cvt_pk2(v45); w.w = cvt_pk2(v67);
                *(u32x4*)(hb + (size_t)row * 1024 + col0 + bj * 32) = w; }
            float q = q2[0] + q2[1]; q += __shfl_xor(q, 16); q += __shfl_xor(q, 32);
            if (fq == 0) ss[(size_t)row * 16 + u.pn * 4 + wc] = q; }
    }
    __device__ __forceinline__ void operator()(const f32x4 (&acc)[2][2][4][2], const Unit& u, int wr, int wc, int fr, int fq) const { half<0>(acc, u, wr, wc, fr, fq); half<1>(acc, u, wr, wc, fr, fq); }
};

template <class Epi, class Sched, bool ALIGN_EPI = false, bool SP2 = false>
__device__ __forceinline__ void gemm_phase(PG8_LAS unsigned char* lds, const Gemm g, const Sched& S, const Epi& E) {
    int tid_ = threadIdx.x; asm volatile("" : "+v"(tid_));
    const int tid = tid_, wid = __builtin_amdgcn_readfirstlane(tid >> 6), lane = tid & 63, wr = wid >> 2, wc = wid & 3, fr = lane & 15, fq = lane >> 4;
    const int K = g.K, nt = K / BK;
    unsigned voffA[2], voffB[2];
#pragma unroll
    for (int i = 0; i < 2; ++i) { int R, C; stage_rc(tid * 16 + i * 8192, R, C); const int Rb = 64 * (R >> 5) + (Epi::PERM ? perm32(R & 31) : (R & 31));
        voffA[i] = g.a_gc ? (unsigned)((size_t)(C / g.a_gc) * (size_t)g.a_gs + (size_t)(R * g.a_gc + C % g.a_gc)) * 2u : (unsigned)(R * K + C) * 2u; voffB[i] = (unsigned)(Rb * K + C) * 2u; }
    const size_t kstep = (size_t)(BK * 2);
    const size_t hstep = (size_t)HALF * K * 2;
    const size_t bhalf = (size_t)32 * K * 2;
    const size_t tstep = 2 * hstep;
    const size_t kstepA = g.a_ks ? (size_t)g.a_ks * 2 : g.a_gc ? (size_t)(BK / g.a_gc) * (size_t)g.a_gs * 2 : kstep, hstepA = g.a_gc ? (size_t)HALF * g.a_gc * 2 : hstep, tstepA = 2 * hstepA;
    const unsigned ldsw = (unsigned)wid * 1024u;
    const int aoff = lds_byte(wr * 64 + fr, fq * 8), boff = lds_byte(wc * 32 + fr, fq * 8);
#define PG8_SA(b, h) (((b) * 2 + (h)) * HTB)
#define PG8_SB(b, h) ((4 + (b) * 2 + (h)) * HTB)
#define PG8_STAGE_R(rs, bufoff, soff, voff) do { _Pragma("unroll") for (int _i = 0; _i < 2; ++_i) \
        __builtin_amdgcn_raw_ptr_buffer_load_lds(rs, (PG8_LAS unsigned*)(lds + (bufoff) + ldsw + _i * 8192), 16, (int)(voff)[_i], (int)(soff), 0, 0); } while (0)
#define PG8_STAGE_A(bufoff, soff, voff) PG8_STAGE_R(rA, bufoff, soff, voff)
#define PG8_STAGE_B(bufoff, soff, voff) PG8_STAGE_R(rB, bufoff, soff, voff)
#define PG8_LDA(dst, b, h) do { _Pragma("unroll") for (int m = 0; m < 4; ++m) _Pragma("unroll") for (int k = 0; k < 2; ++k) dst[m][k] = *(const PG8_LAS bf16x8*)(lds + PG8_SA(b, h) + aoff + m * 2048 + k * 1024); } while (0)
#define PG8_LDB(dst, b, h) do { _Pragma("unroll") for (int n = 0; n < 2; ++n) _Pragma("unroll") for (int k = 0; k < 2; ++k) dst[n][k] = *(const PG8_LAS bf16x8*)(lds + PG8_SB(b, h) + boff + n * 2048 + k * 1024); } while (0)
#define PG8_MMA(ai, bj, At, Bt) do { __builtin_amdgcn_s_setprio(1); _Pragma("unroll") for (int m = 0; m < 4; ++m) _Pragma("unroll") for (int n = 0; n < 2; ++n) _Pragma("unroll") for (int k = 0; k < 2; ++k) \
        acc[ai][bj][m][n] = __builtin_amdgcn_mfma_f32_16x16x32_bf16(Bt[n][k], At[m][k], acc[ai][bj][m][n], 0, 0, 0); __builtin_amdgcn_s_setprio(0); } while (0)
#define PG8_MMAZ(ai, bj, At, Bt) do { if constexpr (Epi::ACC_INIT) { PG8_MMA(ai, bj, At, Bt); } else { __builtin_amdgcn_s_setprio(1); _Pragma("unroll") for (int m = 0; m < 4; ++m) _Pragma("unroll") for (int n = 0; n < 2; ++n) { \
        const f32x4 c_ = __builtin_amdgcn_mfma_f32_16x16x32_bf16(Bt[n][0], At[m][0], (f32x4){0.f, 0.f, 0.f, 0.f}, 0, 0, 0); acc[ai][bj][m][n] = __builtin_amdgcn_mfma_f32_16x16x32_bf16(Bt[n][1], At[m][1], c_, 0, 0, 0); } __builtin_amdgcn_s_setprio(0); } } while (0)
#define PG8_WAIT_V(n) asm volatile("s_waitcnt vmcnt(" #n ")" ::: "memory")
#define PG8_WAIT_VI(N) asm volatile("s_waitcnt vmcnt(%0)" :: "n"(N) : "memory")
#define PG8_WAIT_L(n) asm volatile("s_waitcnt lgkmcnt(" #n ")" ::: "memory")
#define PG8_BAR __builtin_amdgcn_s_barrier()
#define PG8_SCHED __builtin_amdgcn_sched_barrier(0)
    constexpr bool PEEL = SP2 && Epi::EPI_VM > 0;
    Unit cur, nxt; int ui = 0;
    if (!S.next(0, cur)) return;
    f32x4 acc[2][2][4][2];
    if constexpr (!PEEL || Epi::ACC_INIT)
#pragma unroll
    for (int a = 0; a < 2; ++a)
#pragma unroll
        for (int b = 0; b < 2; ++b)
#pragma unroll
            for (int m = 0; m < 4; ++m)
#pragma unroll
                for (int n = 0; n < 2; ++n) acc[a][b][m][n] = (f32x4){0.f, 0.f, 0.f, 0.f};
    if constexpr (Epi::ACC_INIT) { u32x4 res0[4][2]; E.load_c(res0, cur, wr, wc, fr, fq, 0); E.template init_acc<0>(acc, res0); E.load_c(res0, cur, wr, wc, fr, fq, 1); E.template init_acc<1>(acc, res0); }
    bf16x8 At[4][2], B0[2][2], B1[2][2];
    const __amdgpu_buffer_rsrc_t rA = __builtin_amdgcn_make_buffer_rsrc((void*)g.A, (short)0, 0x7fffffff, 0x00020000), rB = __builtin_amdgcn_make_buffer_rsrc((void*)g.Bt, (short)0, 0x7fffffff, 0x00020000);
    const unsigned abx = (unsigned)g.a_bx * 2u;
    unsigned cA = (unsigned)cur.pm * (unsigned)tstepA + (unsigned)(cur.pm >> 5) * abx, cB = (unsigned)cur.pn * (unsigned)tstep;
    S.a_ready(cur);
    if constexpr (SP2) {
        PG8_STAGE_B(PG8_SB(0, 0), cB, voffB); PG8_STAGE_B(PG8_SB(0, 1), cB + bhalf, voffB); PG8_STAGE_A(PG8_SA(0, 0), cA, voffA); PG8_STAGE_A(PG8_SA(0, 1), cA + hstepA, voffA);
        if (wr == 1) PG8_BAR;
        PG8_WAIT_V(2); PG8_BAR;
        PG8_STAGE_B(PG8_SB(1, 0), cB + kstep, voffB); PG8_STAGE_A(PG8_SA(1, 0), cA + kstepA, voffA); PG8_STAGE_B(PG8_SB(1, 1), cB + bhalf + kstep, voffB);
        PG8_WAIT_V(6); PG8_BAR;
        if constexpr (PEEL) PG8_STAGE_A(PG8_SA(1, 1), cA + (unsigned)kstepA + (unsigned)hstepA, voffA);
    } else {
        PG8_STAGE_B(PG8_SB(0, 0), cB, voffB); PG8_STAGE_A(PG8_SA(0, 0), cA, voffA); PG8_STAGE_B(PG8_SB(0, 1), cB + bhalf, voffB); PG8_STAGE_A(PG8_SA(0, 1), cA + hstepA, voffA);
        if (wr == 1) PG8_BAR;
        PG8_WAIT_V(4); PG8_BAR;
        PG8_STAGE_B(PG8_SB(1, 0), cB + kstep, voffB); PG8_STAGE_A(PG8_SA(1, 0), cA + kstepA, voffA); PG8_STAGE_B(PG8_SB(1, 1), cB + bhalf + kstep, voffB);
        PG8_WAIT_V(6); PG8_BAR;
    }
    if constexpr (SP2 && Epi::EPI_VM > 0) {
        unsigned* dz_ = E.dz + threadIdx.x; const unsigned z_ = 0u;
#pragma unroll
        for (int k = 0; k < Epi::EPI_VM; ++k) asm volatile("global_store_dword %0, %1, off" :: "v"(dz_), "v"(z_) : "memory");
    }
    for (;;) {
        const bool has_next = S.next(ui + 1, nxt);
        const unsigned nA = has_next ? (unsigned)nxt.pm * (unsigned)tstepA + (unsigned)(nxt.pm >> 5) * abx : cA, nB = has_next ? (unsigned)nxt.pn * (unsigned)tstep : cB;
        if constexpr (PEEL) { const int t = 0;
            const bool last = (t == nt - 2);
            const unsigned a1 = cA + (unsigned)(t + 1) * (unsigned)kstepA;
            const unsigned a2 = last ? nA : cA + (unsigned)(t + 2) * (unsigned)kstepA, b2 = last ? nB : cB + (unsigned)(t + 2) * (unsigned)kstep;
            const unsigned a3 = a2 + (unsigned)kstepA, b3 = b2 + (unsigned)kstep;
            if (last && has_next) S.a_ready(nxt);
            PG8_LDB(B0, 0, 0); PG8_LDB(B1, 0, 1); PG8_SCHED; PG8_LDA(At, 0, 0);
            PG8_WAIT_VI(8 + Epi::EPI_VM); PG8_WAIT_L(0); PG8_BAR;
            if constexpr (Epi::LDS_SS) __builtin_amdgcn_global_load_lds((const unsigned*)((const char*)E.ss + (size_t)cur.pm * 16384 + (size_t)(((t >> 1) & 7) * 2048 + wid * 256 + lane * 4)), (PG8_LAS unsigned*)(lds + SS_LDS_OFF + ((t >> 1) & 7) * 2048 + wid * 256), 4, 0, 0);
            PG8_MMAZ(0, 0, At, B0); PG8_MMAZ(0, 1, At, B1); PG8_BAR; PG8_SCHED;
            PG8_LDA(At, 0, 1); PG8_STAGE_B(PG8_SB(0, 0), b2, voffB); PG8_STAGE_B(PG8_SB(0, 1), b2 + bhalf, voffB); PG8_STAGE_A(PG8_SA(0, 0), a2, voffA);
            PG8_WAIT_VI(8 + Epi::EPI_VM); PG8_WAIT_L(0); PG8_BAR; PG8_MMAZ(1, 0, At, B0); PG8_MMAZ(1, 1, At, B1); PG8_BAR; PG8_SCHED;
            PG8_LDB(B0, 1, 0); PG8_LDB(B1, 1, 1); PG8_SCHED; PG8_LDA(At, 1, 0); PG8_STAGE_A(PG8_SA(0, 1), a2 + hstepA, voffA);
            PG8_WAIT_VI(8 + Epi::EPI_VM + (Epi::LDS_SS ? 1 : 0)); PG8_WAIT_L(0); PG8_BAR; PG8_MMA(0, 0, At, B0); PG8_MMA(0, 1, At, B1); PG8_BAR; PG8_SCHED;
            PG8_LDA(At, 1, 1); PG8_STAGE_B(PG8_SB(1, 0), b3, voffB); PG8_STAGE_B(PG8_SB(1, 1), b3 + bhalf, voffB); PG8_STAGE_A(PG8_SA(1, 0), a3, voffA);
            PG8_WAIT_V(8); PG8_WAIT_L(0); PG8_BAR; PG8_MMA(1, 0, At, B0); PG8_MMA(1, 1, At, B1); PG8_BAR; PG8_SCHED;
        }
        asm volatile(".p2align 6");
        for (int t = PEEL ? 2 : 0; t < nt; t += 2) {
            const bool last = (t == nt - 2);
            const unsigned a1 = cA + (unsigned)(t + 1) * (unsigned)kstepA;
            const unsigned a2 = last ? nA : cA + (unsigned)(t + 2) * (unsigned)kstepA, b2 = last ? nB : cB + (unsigned)(t + 2) * (unsigned)kstep;
            const unsigned a3 = a2 + (unsigned)kstepA, b3 = b2 + (unsigned)kstep;
            if (last && has_next) S.a_ready(nxt);
            if constexpr (SP2) {
            PG8_LDB(B0, 0, 0); PG8_LDB(B1, 0, 1); PG8_SCHED; PG8_LDA(At, 0, 0); PG8_STAGE_A(PG8_SA(1, 1), a1 + hstepA, voffA);
            PG8_WAIT_V(8); PG8_WAIT_L(0); PG8_BAR;
            if constexpr (Epi::LDS_SS) __builtin_amdgcn_global_load_lds((const unsigned*)((const char*)E.ss + (size_t)cur.pm * 16384 + (size_t)(((t >> 1) & 7) * 2048 + wid * 256 + lane * 4)), (PG8_LAS unsigned*)(lds + SS_LDS_OFF + ((t >> 1) & 7) * 2048 + wid * 256), 4, 0, 0);
            PG8_MMA(0, 0, At, B0); PG8_MMA(0, 1, At, B1); PG8_BAR; PG8_SCHED;
            PG8_LDA(At, 0, 1); PG8_STAGE_B(PG8_SB(0, 0), b2, voffB); PG8_STAGE_B(PG8_SB(0, 1), b2 + bhalf, voffB); PG8_STAGE_A(PG8_SA(0, 0), a2, voffA);
            PG8_WAIT_V(8); PG8_WAIT_L(0); PG8_BAR; PG8_MMA(1, 0, At, B0); PG8_MMA(1, 1, At, B1); PG8_BAR; PG8_SCHED;
            PG8_LDB(B0, 1, 0); PG8_LDB(B1, 1, 1); PG8_SCHED; PG8_LDA(At, 1, 0); PG8_STAGE_A(PG8_SA(0, 1), a2 + hstepA, voffA);
            PG8_WAIT_V(8); PG8_WAIT_L(0); PG8_BAR; PG8_MMA(0, 0, At, B0); PG8_MMA(0, 1, At, B1); PG8_BAR; PG8_SCHED;
            PG8_LDA(At, 1, 1); PG8_STAGE_B(PG8_SB(1, 0), b3, voffB); PG8_STAGE_B(PG8_SB(1, 1), b3 + bhalf, voffB); PG8_STAGE_A(PG8_SA(1, 0), a3, voffA);
            PG8_WAIT_V(8); PG8_WAIT_L(0); PG8_BAR; PG8_MMA(1, 0, At, B0); PG8_MMA(1, 1, At, B1); PG8_BAR; PG8_SCHED;
            } else {
            PG8_LDB(B0, 0, 0); PG8_SCHED; PG8_LDA(At, 0, 0); PG8_STAGE_A(PG8_SA(1, 1), a1 + hstepA, voffA);
            PG8_WAIT_L(8); PG8_BAR; PG8_WAIT_L(0); PG8_MMA(0, 0, At, B0); PG8_BAR; PG8_SCHED;
            PG8_LDB(B1, 0, 1); PG8_STAGE_B(PG8_SB(0, 0), b2, voffB);
            PG8_BAR; PG8_WAIT_L(0); PG8_MMA(0, 1, At, B1); PG8_BAR;
            PG8_LDA(At, 0, 1); PG8_STAGE_A(PG8_SA(0, 0), a2, voffA);
            PG8_BAR; PG8_WAIT_L(0); PG8_MMA(1, 0, At, B0); PG8_BAR; PG8_SCHED;
            PG8_STAGE_B(PG8_SB(0, 1), b2 + bhalf, voffB);
            PG8_WAIT_V(6); PG8_BAR; PG8_MMA(1, 1, At, B1); PG8_BAR;
            PG8_LDB(B0, 1, 0); PG8_SCHED; PG8_LDA(At, 1, 0); PG8_STAGE_A(PG8_SA(0, 1), a2 + hstepA, voffA);
            PG8_WAIT_L(8); PG8_BAR; PG8_WAIT_L(0); PG8_MMA(0, 0, At, B0); PG8_BAR; PG8_SCHED;
            PG8_LDB(B1, 1, 1); PG8_STAGE_B(PG8_SB(1, 0), b3, voffB);
            PG8_BAR; PG8_WAIT_L(0); PG8_MMA(0, 1, At, B1); PG8_BAR;
            PG8_LDA(At, 1, 1); PG8_STAGE_A(PG8_SA(1, 0), a3, voffA);
            PG8_BAR; PG8_WAIT_L(0); PG8_MMA(1, 0, At, B0); PG8_BAR; PG8_SCHED;
            PG8_STAGE_B(PG8_SB(1, 1), b3 + bhalf, voffB);
            PG8_WAIT_V(6); PG8_BAR; PG8_MMA(1, 1, At, B1); PG8_BAR;
            }
        }
        if constexpr (ALIGN_EPI) { if (wr == 0) PG8_BAR; }
        if constexpr (PEEL) { PG8_STAGE_A(PG8_SA(1, 1), nA + (unsigned)kstepA + (unsigned)hstepA, voffA); asm volatile("" ::: "memory"); }
        if constexpr (Epi::ACC_INIT) {
            u32x4 resn[4][2];
            Unit un = cur; if (has_next) un = nxt;
            E.load_c(resn, un, wr, wc, fr, fq, 0);
            E.template half<0>(acc, cur, wr, wc, fr, fq);
            E.template init_acc<0>(acc, resn); E.load_c(resn, un, wr, wc, fr, fq, 1);
            E.template half<1>(acc, cur, wr, wc, fr, fq);
            E.template init_acc<1>(acc, resn);
            S.done(cur);
        } else
        if constexpr (!Epi::AFTER_DRAIN) { if (S.emit(ui)) { E(acc, cur, wr, wc, fr, fq); if constexpr (Epi::PROBE_TWICE) { asm volatile("" ::: "memory"); E(acc, cur, wr, wc, fr, fq); } } S.done(cur); }
        if (!has_next) break;
        if constexpr (!Epi::ACC_INIT && !PEEL)
#pragma unroll
        for (int a = 0; a < 2; ++a)
#pragma unroll
            for (int b = 0; b < 2; ++b)
#pragma unroll
                for (int m = 0; m < 4; ++m)
#pragma unroll
                    for (int n = 0; n < 2; ++n) acc[a][b][m][n] = (f32x4){0.f, 0.f, 0.f, 0.f};
        cur = nxt; cA = nA; cB = nB; ++ui;
        if constexpr (ALIGN_EPI) { if (wr == 1) PG8_BAR; }
    }
    PG8_WAIT_V(0);
    if constexpr (!ALIGN_EPI) { if (wr == 0) PG8_BAR; }
    PG8_BAR;
    if constexpr (Epi::AFTER_DRAIN) { E.fused(acc, cur, wr, wc, fr, fq, lds, wid, lane); S.done(cur); }
#undef PG8_SA
#undef PG8_SB
#undef PG8_STAGE_R
#undef PG8_STAGE_A
#undef PG8_STAGE_B
#undef PG8_LDA
#undef PG8_LDB
#undef PG8_MMA
#undef PG8_WAIT_V
#undef PG8_WAIT_L
#undef PG8_BAR
#undef PG8_SCHED
}
}
#include <hip/hip_bf16.h>
#include <cmath>
namespace attn_body {
using bf16=__hip_bfloat16;
using bf16x8=__attribute__((ext_vector_type(8)))short;
using s16x4=__attribute__((ext_vector_type(4)))short;
using f32x16=__attribute__((ext_vector_type(16)))float;
using u32x4=__attribute__((ext_vector_type(4)))unsigned;
constexpr int SEQ=2048,D=64,DM=64;
constexpr long GSTR=65536L*64;
constexpr int NW=8,QBLK=32,QB=QBLK*NW,KVBLK=64;
__device__ __forceinline__ int crow(int r,int hi){return (r&3)+8*(r>>2)+4*hi;}
#define SBAR() __builtin_amdgcn_sched_barrier(0)
__device__ __forceinline__ void cmask(f32x16&p0,f32x16&p1,int jb,int qrel,int hi,const float NEG){
  int kb=64*jb+4*hi;
  #pragma unroll
  for(int r=0;r<16;++r){int kv=kb+(r&3)+8*(r>>2); if(kv>qrel)p0[r]=NEG; if(kv+32>qrel)p1[r]=NEG;}
}
constexpr int NSLOT=3, SLOTB=8192, VSLOTB=16384;
constexpr int LDS_K=0, LDS_V=NSLOT*SLOTB, LDS_WS=LDS_V+NSLOT*VSLOTB, LDS_OST=LDS_WS+NW*64*4, LDS_ST=LDS_OST+NW*8192, LDS_BYTES=LDS_ST+16384;
__device__ __forceinline__ void glds16(const void*gsrc,unsigned lds_dst){unsigned keep;
  asm volatile("s_mov_b32 %0, m0\n\ts_mov_b32 m0, %2\n\ts_nop 0\n\tglobal_load_lds_dwordx4 %1, off\n\ts_mov_b32 m0, %0":"=&s"(keep):"v"(gsrc),"s"(lds_dst):"memory");}
__device__ __forceinline__ float max3f(float a,float b,float c){float r;asm("v_max3_f32 %0, %1, %2, %3":"=v"(r):"v"(a),"v"(b),"v"(c));return r;}
__device__ __forceinline__ float max2f(float a,float b){float r;asm("v_max_f32_e32 %0, %1, %2":"=v"(r):"v"(a),"v"(b));return r;}
__device__ __forceinline__ float fadd_s(float a,float b){float r;asm("v_add_f32_e32 %0, %1, %2":"=v"(r):"v"(a),"v"(b));return r;}
__device__ __forceinline__ float fsub_s(float a,float b){float r;asm("v_sub_f32_e32 %0, %1, %2":"=v"(r):"v"(a),"v"(b));return r;}
typedef float f32x2_t __attribute__((ext_vector_type(2))); typedef __bf16 bf16x2_t __attribute__((ext_vector_type(2)));
__device__ __forceinline__ unsigned cvtpk_s(float lo,float hi){f32x2_t v={lo,hi};bf16x2_t b=__builtin_convertvector(v,bf16x2_t);return __builtin_bit_cast(unsigned,b);}
#define WAIT_BAR(N) asm volatile("s_waitcnt vmcnt(" #N ") lgkmcnt(0)\n\ts_barrier":::"memory")

__device__ __forceinline__ void qkt(f32x16&p0,f32x16&p1,const char*Kslot,const bf16x8*qr,int r32,int hi){
  const char*kb=Kslot+hi*1024+r32*16;
  #pragma unroll
  for(int d0=0;d0<4;++d0){
    const bf16x8 b0=*reinterpret_cast<const bf16x8*>(kb+d0*2048);
    const bf16x8 b1=*reinterpret_cast<const bf16x8*>(kb+d0*2048+512);
    p0=__builtin_amdgcn_mfma_f32_32x32x16_bf16(b0,qr[d0],p0,0,0,0);p1=__builtin_amdgcn_mfma_f32_32x32x16_bf16(b1,qr[d0],p1,0,0,0);}
}
typedef __attribute__((address_space(3))) const char* lds_cptr;
typedef short v4i16_t __attribute__((ext_vector_type(4)));
__device__ __forceinline__ void kload8(bf16x8*kf,lds_cptr kp){
  kf[0]=*(const __attribute__((address_space(3))) bf16x8*)(kp);      kf[1]=*(const __attribute__((address_space(3))) bf16x8*)(kp+512);
  kf[2]=*(const __attribute__((address_space(3))) bf16x8*)(kp+2048); kf[3]=*(const __attribute__((address_space(3))) bf16x8*)(kp+2560);
  kf[4]=*(const __attribute__((address_space(3))) bf16x8*)(kp+4096); kf[5]=*(const __attribute__((address_space(3))) bf16x8*)(kp+4608);
  kf[6]=*(const __attribute__((address_space(3))) bf16x8*)(kp+6144); kf[7]=*(const __attribute__((address_space(3))) bf16x8*)(kp+6656);
}
__device__ __forceinline__ void kload2(bf16x8*kf,lds_cptr kp,int j){ kf[2*j]=*(const __attribute__((address_space(3))) bf16x8*)(kp+j*2048); kf[2*j+1]=*(const __attribute__((address_space(3))) bf16x8*)(kp+j*2048+512); }
__device__ __forceinline__ s16x4 vtr(lds_cptr p){ return __builtin_bit_cast(s16x4,__builtin_amdgcn_ds_read_tr16_b64_v4i16((__attribute__((address_space(3))) v4i16_t*)p)); }
__device__ __forceinline__ float rowmax(const f32x16&p0,const f32x16&p1){
  float a=max3f(p0[0],p0[1],p1[0]),b=max3f(p0[2],p0[3],p1[1]);a=max3f(a,p1[2],p1[3]);
  #pragma unroll
  for(int r=4;r<16;r+=4){a=max3f(a,p0[r],p0[r+1]);b=max3f(b,p0[r+2],p0[r+3]);a=max3f(a,p1[r],p1[r+1]);b=max3f(b,p1[r+2],p1[r+3]);}
  const float m=max2f(a,b);
  auto rr=__builtin_amdgcn_permlane32_swap(__float_as_uint(m),__float_as_uint(m),false,false);
  return max2f(__uint_as_float(rr[0]),__uint_as_float(rr[1]));
}
__device__ __forceinline__ void pv(f32x16*o,int vb,bf16x8 pa0,bf16x8 pa1,bf16x8 pa2,bf16x8 pa3){
  #pragma unroll
  for(int d0=0;d0<4;++d0){s16x4 lo[4],hi[4];
    #pragma unroll
    for(int ks=0;ks<4;++ks){
      asm volatile("ds_read_b64_tr_b16 %0,%1 offset:%c2":"=&v"(lo[ks]):"v"(vb),"i"(d0*4096+ks*1024):"memory");
      asm volatile("ds_read_b64_tr_b16 %0,%1 offset:%c2":"=&v"(hi[ks]):"v"(vb),"i"(d0*4096+ks*1024+512):"memory");}
    asm volatile("s_waitcnt lgkmcnt(0)":::"memory");SBAR();
    #define PK(k) (bf16x8){lo[k][0],lo[k][1],lo[k][2],lo[k][3],hi[k][0],hi[k][1],hi[k][2],hi[k][3]}
    o[d0]=__builtin_amdgcn_mfma_f32_32x32x16_bf16(pa0,PK(0),o[d0],0,0,0);
    o[d0]=__builtin_amdgcn_mfma_f32_32x32x16_bf16(pa1,PK(1),o[d0],0,0,0);
    o[d0]=__builtin_amdgcn_mfma_f32_32x32x16_bf16(pa2,PK(2),o[d0],0,0,0);
    o[d0]=__builtin_amdgcn_mfma_f32_32x32x16_bf16(pa3,PK(3),o[d0],0,0,0);
    #undef PK
  }
}

struct PassArgs { int qb, cq, ck, cv, tsk, rb; };
template<int THRL,int MODE> __device__ __forceinline__ void attn_unit(const bf16*__restrict__ proj,long rowbase,const PassArgs A_,float cs,float lam,char*shm,int&slot0,bool pre,bf16x8(&qr)[4],bool has_next,const PassArgs N_,f32x16&Sreg){
  const int qb=A_.qb; const bf16*Qh=proj+A_.cq; const bf16*__restrict__ Kh_=proj+A_.ck; const bf16*__restrict__ Vh_=proj+A_.cv;
  int tid_=threadIdx.x; asm volatile("":"+v"(tid_));
  const int tid=tid_,lane=tid&63,r32=lane&31,hi=lane>>5; const int wid=__builtin_amdgcn_readfirstlane(tid>>6);
  constexpr bool LIN=(MODE==2); const float lgam=LIN?cs:0.f; if(LIN)cs=0.f; float ftv=1.f;
  const int q0=qb*QB;
  const bf16*Qw=Qh+(rowbase+q0+(wid>>1)*KVBLK)*DM+(wid&1)*(QBLK*8);
  const int tsk=A_.tsk;
  const bf16*Kh=Kh_+(rowbase+(long)tsk*KVBLK)*DM,*Vh=Vh_+(rowbase+(long)tsk*KVBLK)*DM;
  const unsigned lds0=(unsigned)(uintptr_t)shm;
  float*wsf=(float*)(shm+LDS_WS)+wid*64;
  const float g64=LIN?__builtin_amdgcn_exp2f(64.f*lgam):1.f;
  const __attribute__((address_space(3))) char* ktp0=(const __attribute__((address_space(3))) char*)shm+LDS_K+(4*(wid>>2)+2*((lane>>4)&1)+((lane&3)>>1))*1024+(4*hi+((lane&15)>>2))*16+(lane&1)*8;
  const bf16*ksrc=Kh+(long)lane*8+wid*512;
  const bf16*vsrc=Vh+(wid>>2)*2048+(wid&3)*512+(long)lane*8;
  const unsigned kdst=lds0+LDS_K+wid*1024, vdst=lds0+LDS_V+wid*1024;
  #define DMA_K(t,slot) glds16(ksrc+(long)(t)*KVBLK*DM,(unsigned)__builtin_amdgcn_readfirstlane(kdst+(slot)))
  #define DMA_V(t,slot) do{ glds16(vsrc+(long)(t)*KVBLK*DM,(unsigned)__builtin_amdgcn_readfirstlane(vdst+2*(slot))); glds16(vsrc+(long)(t)*KVBLK*DM+GSTR,(unsigned)__builtin_amdgcn_readfirstlane(vdst+2*(slot)+8192)); }while(0)
  const int vb0=(int)(lds0+LDS_V)+((lane>>4)&1)*32+(lane&3)*8+(4*hi+((lane&15)>>2))*64;
  const char*Kbase=shm+LDS_K; bf16x8 kf[8];
  const lds_cptr shm3=(lds_cptr)shm; const lds_cptr kp0=shm3+LDS_K+hi*1024+r32*16; const lds_cptr vp0=shm3+LDS_V+((lane>>4)&1)*32+(lane&3)*8+(4*hi+((lane&15)>>2))*64;
  const int NT=(q0+QB)/KVBLK-tsk;
  #define NXS(s) (((s)==(NSLOT-1)*SLOTB)?0:(s)+SLOTB)
  const int sA=slot0,sB=NXS(sA),sC=NXS(sB);
  if(!pre){ DMA_K(0,sA);DMA_V(0,sA);DMA_K(1,sB);
    #pragma unroll
    for(int d0=0;d0<4;++d0)qr[d0]=*reinterpret_cast<const bf16x8*>(&Qw[(2*d0+hi)*512+r32*8]);
    DMA_K(2,sC); }
  float l_reg=0.f;f32x16 o[4];
  { _Pragma("unroll") for(int d_=0;d_<4;++d_) _Pragma("unroll") for(int r=0;r<16;++r){float z_;asm volatile("v_mov_b32 %0, 0":"=v"(z_));o[d_][r]=z_;} }
  const int qrel=wid*QBLK+r32;
  float csv=cs; asm volatile("":"+v"(csv)); const float cs64=64.f*cs, cs59=59.f*cs; float nb=0.f;
  #define ALIBI_IN(P0,P1) do{ _Pragma("unroll") for(int r=0;r<16;++r){ P0[r]=__builtin_fmaf(csv,(float)((r&3)+8*(r>>2)),P0[r]); P1[r]=__builtin_fmaf(csv,(float)((r&3)+8*(r>>2)+32),P1[r]); } }while(0)
  #define CMASK(P0,P1,t) do{int jb_=(t)-(NT-4); if(jb_>=0)cmask(P0,P1,jb_,qrel,hi,LIN?0.f:-INFINITY);}while(0)
  bool resc=false;
  #define START(P0,P1) do{ resc=false; if constexpr(LIN){ _Pragma("unroll") for(int r=0;r<16;++r)P0[r]*=ftv; break; } const float rm=rowmax(P0,P1); \
    { const float dl=rm; \
      _Pragma("unroll") for(int r=0;r<16;++r){P0[r]=fsub_s(P0[r],dl);P1[r]=fsub_s(P1[r],dl);} \
      nb=bt0+cs64-dl; } \
    _Pragma("unroll") for(int r=0;r<16;++r)P0[r]=__builtin_amdgcn_exp2f(P0[r]); }while(0)
  #define RESC() do{ if(resc){ asm volatile("s_waitcnt lgkmcnt(0)":::"memory"); \
      _Pragma("unroll") for(int d_=0;d_<4;++d_) _Pragma("unroll") for(int r=0;r<16;++r)o[d_][r]*=wsf[crow(r,hi)]; } }while(0)
  f32x16 pA0,pA1,pB0,pB1;
  int sl_prev=sA,sl_cur=sA,sl_next=sB;
  #define ROT() do{sl_prev=sl_cur;sl_cur=sl_next;sl_next=(sl_next==(NSLOT-1)*SLOTB)?0:sl_next+SLOTB;}while(0)
  #define MF32(a,b,c) __builtin_amdgcn_mfma_f32_32x32x16_bf16(a,b,c,0,0,0)
  if constexpr(LIN){
    char*st_=shm+LDS_ST+((wid&3)*32+r32)*128+((wid>>2)*32+4*hi)*2;
    #pragma unroll
    for(int g4=0;g4<4;++g4){ uint2 w_; w_.x=cvtpk_s(Sreg[4*g4]*g64,Sreg[4*g4+1]*g64); w_.y=cvtpk_s(Sreg[4*g4+2]*g64,Sreg[4*g4+3]*g64); *reinterpret_cast<uint2*>(st_+g4*16)=w_; } }
  if(MODE==0&&pre){ WAIT_BAR(12); } else WAIT_BAR(4);
  if constexpr(LIN){
    const char*sr_=shm+LDS_ST+r32*128+hi*16;
    #pragma unroll
    for(int cq=0;cq<4;++cq){
      #pragma unroll
      for(int d0=0;d0<4;++d0){ const bf16x8 sf_=*reinterpret_cast<const bf16x8*>(sr_+cq*4096+d0*32); o[cq]=MF32(qr[d0],sf_,o[cq]); } } }
  #define KVUPD(slot) do{ _Pragma("unroll") for(int r=0;r<16;++r)Sreg[r]*=g64; \
    const __attribute__((address_space(3))) char*kt_=ktp0+(slot); const lds_cptr vt_=vp0+2*(slot)+(wid&3)*4096; \
    _Pragma("unroll") for(int ks=0;ks<4;++ks){ const s16x4 a0_=vtr((lds_cptr)(kt_+ks*256)),a1_=vtr((lds_cptr)(kt_+ks*256+128)),b0_=vtr(vt_+ks*1024),b1_=vtr(vt_+ks*1024+512); \
      Sreg=MF32(((bf16x8){a0_[0],a0_[1],a0_[2],a0_[3],a1_[0],a1_[1],a1_[2],a1_[3]}),((bf16x8){b0_[0],b0_[1],b0_[2],b0_[3],b1_[0],b1_[1],b1_[2],b1_[3]}),Sreg); } }while(0)
  const float bt0=cs*(float)(4*hi-(q0+QB-1)+64*tsk);
  { _Pragma("unroll") for(int r=0;r<16;++r){float z_,y_;asm volatile("v_mov_b32 %0, 0\n\tv_mov_b32 %1, 0":"=v"(z_),"=v"(y_));pA0[r]=z_;pA1[r]=y_;} asm volatile("s_nop 1":"+v"(pA0),"+v"(pA1)); }
  qkt(pA0,pA1,Kbase+sA,qr,r32,hi);asm volatile("s_nop 15\n\ts_nop 7":"+v"(pA0),"+v"(pA1));
  if constexpr(LIN) ftv=__builtin_amdgcn_exp2f(lgam*(float)(q0-64*tsk));
  if constexpr(!LIN){ _Pragma("unroll") for(int r=0;r<16;++r){pA0[r]+=bt0;pA1[r]+=bt0;} ALIBI_IN(pA0,pA1); } CMASK(pA0,pA1,0);
  START(pA0,pA1);
  _Pragma("unroll") for(int r=0;r<16;++r)pA1[r]=LIN?pA1[r]*ftv:__builtin_amdgcn_exp2f(pA1[r]);
  if(MODE==0&&pre){ WAIT_BAR(8); } else WAIT_BAR(0);
  if constexpr(LIN){ KVUPD(sA); asm volatile("s_waitcnt lgkmcnt(0)\n\ts_barrier":::"memory"); }
  DMA_K(3,sA);DMA_V(1,sB);
  ROT();
  kload8(kf,kp0+sl_cur);
  WAIT_BAR(3);
  s16x4 fl[16],fh[16]; u32x4 pw0,pw1,pw2,pw3;
  #define PKW(P,B) cvtpk_s(P[B],P[B+1])
  #define PAF(k) __builtin_bit_cast(bf16x8,pw##k)
  #define FFR(i) (bf16x8){fl[i][0],fl[i][1],fl[i][2],fl[i][3],fh[i][0],fh[i][1],fh[i][2],fh[i][3]}
  #define PIN(x) asm volatile("":"+v"(x))
  #define MX3(a,b,c) __builtin_fmaxf(__builtin_fmaxf((a),(b)),(c))
  #define GAPA(MF,A0,A1,A2,A3,W0,W1,PW) do{ MF; if constexpr(!LIN){ sacc+=A0; sacc+=A1; sacc+=A2; sacc+=A3; PIN(sacc); } W0; W1; PIN(PW); SBAR(); }while(0)
  #define KR(B) ((float)(((B)&3)+8*((B)>>2)))
  #define FMAK(a,K,c) ({ float r_; asm("v_fmamk_f32 %0, %1, %2, %3":"=v"(r_):"v"(a),"n"(__builtin_bit_cast(unsigned,(float)(K))),"v"(c)); r_; })
  #define EXB(v,k) (LIN?(v)*ftv:__builtin_amdgcn_exp2f(v))
  #define GAPB(MF,X,B,OFF,Y) do{ MF; X[B]=EXB(X[B],KR(B)+(OFF)); X[B+1]=EXB(X[B+1],KR((B)+1)+(OFF)); PIN(X); if constexpr(!LIN){ Y[B]=FMAK(csv,KR(B)+(OFF),nbn_); Y[B+1]=FMAK(csv,KR((B)+1)+(OFF),nbn_); PIN(Y); } SBAR(); }while(0)
  #define FRD(i) do{ fl[i]=vtr(vp_+(((i)>>2)*4096+((i)&3)*1024)); fh[i]=vtr(vp_+(((i)>>2)*4096+((i)&3)*1024+512)); SBAR(); }while(0)
  #define KRD(G,j) do{ if(G){ kload2(kf,kp0+sl_next,j); SBAR(); } }while(0)
  #define CST(Cx) (LIN?f32x16{}:Cx)
  #define STEP(C0,C1,P0,P1,t,GK,GV,GL) do{ SBAR(); \
    if constexpr(LIN){ ftv=__builtin_amdgcn_exp2f(lgam*(float)(q0-64*((t)+tsk))); if((t)>=2){ KVUPD(sl_prev); } } SBAR(); \
    const lds_cptr vp_=vp0+2*sl_prev; \
    FRD(0); float sacc=(P0[0]+P0[1]); \
    GAPA(C0=MF32(kf[0],qr[0],CST(C0)), P0[2],P0[3],P0[4],P0[5],     pw0[0]=PKW(P0,0), pw0[1]=PKW(P0,2), pw0); \
    GAPA(C1=MF32(kf[1],qr[0],CST(C1)), P0[6],P0[7],P0[8],P0[9],     pw0[2]=PKW(P0,4), pw0[3]=PKW(P0,6), pw0); \
    FRD(4); GAPA(C0=MF32(kf[2],qr[1],C0),   P0[10],P0[11],P0[12],P0[13], pw1[0]=PKW(P0,8), pw1[1]=PKW(P0,10), pw1); \
    GAPA(C1=MF32(kf[3],qr[1],C1),   P0[14],P0[15],P1[0],P1[1],   pw1[2]=PKW(P0,12),pw1[3]=PKW(P0,14), pw1); \
    FRD(1); GAPA(C0=MF32(kf[4],qr[2],C0),   P1[2],P1[3],P1[4],P1[5],     pw2[0]=PKW(P1,0), pw2[1]=PKW(P1,2), pw2); \
    GAPA(C1=MF32(kf[5],qr[2],C1),   P1[6],P1[7],P1[8],P1[9],     pw2[2]=PKW(P1,4), pw2[3]=PKW(P1,6), pw2); \
    FRD(5); GAPA(C0=MF32(kf[6],qr[3],C0),   P1[10],P1[11],P1[12],P1[13], pw3[0]=PKW(P1,8), pw3[1]=PKW(P1,10), pw3); \
    GAPA(C1=MF32(kf[7],qr[3],C1),   P1[14],P1[15],0.f,0.f,       pw3[2]=PKW(P1,12),pw3[3]=PKW(P1,14), pw3); \
    l_reg+=sacc; \
    if(GK){DMA_K((t)+3,sl_cur);} if(GV){DMA_V((t)+1,sl_next);} \
    CMASK(C0,C1,t); \
    if constexpr(!LIN){ float a=MX3(C0[0],C0[1],C1[0]),b=MX3(C0[2],C0[3],C1[1]); a=MX3(a,C1[2],C1[3]); \
      _Pragma("unroll") for(int r=4;r<16;r+=4){a=MX3(a,C0[r],C0[r+1]);b=MX3(b,C0[r+2],C0[r+3]);a=MX3(a,C1[r],C1[r+1]);b=MX3(b,C1[r+2],C1[r+3]);} \
      float rm=__builtin_fmaxf(a,b); { auto rr=__builtin_amdgcn_permlane32_swap(__float_as_uint(rm),__float_as_uint(rm),false,false); rm=__builtin_fmaxf(__uint_as_float(rr[0]),__uint_as_float(rr[1])); } \
      resc=false; \
      if(__builtin_expect(__any(rm>(float)THRL),0)){ const float dl=__builtin_fmaxf(rm,0.f); \
        _Pragma("unroll") for(int r=0;r<16;++r){C0[r]-=dl;C1[r]-=dl;} \
        nb-=dl; \
        const float f=__builtin_amdgcn_exp2f(-dl); l_reg*=f; if(hi==0)wsf[r32]=f; resc=true; } } \
    float nbn_=nb+cs64; asm volatile("":"+v"(nbn_)); \
    SBAR(); \
    FRD(2);  GAPB(o[0]=MF32(PAF(0),FFR(0),o[0]), C0,0,0.f,P0); \
    FRD(6);  GAPB(o[1]=MF32(PAF(0),FFR(4),o[1]), C0,2,0.f,P0); \
    FRD(3);  GAPB(o[0]=MF32(PAF(1),FFR(1),o[0]), C0,4,0.f,P0); \
    FRD(7);  GAPB(o[1]=MF32(PAF(1),FFR(5),o[1]), C0,6,0.f,P0); \
    FRD(8);  GAPB(o[0]=MF32(PAF(2),FFR(2),o[0]), C0,8,0.f,P0); \
    FRD(12); GAPB(o[1]=MF32(PAF(2),FFR(6),o[1]), C0,10,0.f,P0); \
    FRD(9);  GAPB(o[0]=MF32(PAF(3),FFR(3),o[0]), C0,12,0.f,P0); \
    FRD(13); GAPB(o[1]=MF32(PAF(3),FFR(7),o[1]), C0,14,0.f,P0); \
    FRD(10); GAPB(o[2]=MF32(PAF(0),FFR(8),o[2]), C1,0,32.f,P1); \
    FRD(14); GAPB(o[3]=MF32(PAF(0),FFR(12),o[3]), C1,2,32.f,P1); \
    FRD(11); GAPB(o[2]=MF32(PAF(1),FFR(9),o[2]), C1,4,32.f,P1); \
    FRD(15); GAPB(o[3]=MF32(PAF(1),FFR(13),o[3]), C1,6,32.f,P1); \
    KRD(GL,0); KRD(GL,1); GAPB(o[2]=MF32(PAF(2),FFR(10),o[2]), C1,8,32.f,P1); \
    KRD(GL,2); GAPB(o[3]=MF32(PAF(2),FFR(14),o[3]), C1,10,32.f,P1); \
    KRD(GL,3); GAPB(o[2]=MF32(PAF(3),FFR(11),o[2]), C1,12,32.f,P1); \
    GAPB(o[3]=MF32(PAF(3),FFR(15),o[3]), C1,14,32.f,P1); \
    nb=nbn_; \
    }while(0)
  if constexpr(!LIN){ float nbv_=nb; asm volatile("":"+v"(nbv_)); _Pragma("unroll") for(int r=0;r<16;++r){pB0[r]=__builtin_fmaf(csv,(float)((r&3)+8*(r>>2)),nbv_);pB1[r]=__builtin_fmaf(csv,(float)((r&3)+8*(r>>2)+32),nbv_);} asm volatile("":"+v"(pB0),"+v"(pB1)); }
  int t=1;
  #undef CMASK
  #define CMASK(P0,P1,t) do{}while(0)
  asm volatile(".p2align 6");
  for(;t+5<NT;t+=2){
    STEP(pB0,pB1,pA0,pA1,t,true,true,true);     WAIT_BAR(3); RESC(); ROT();
    STEP(pA0,pA1,pB0,pB1,t+1,true,true,true);   WAIT_BAR(3); RESC(); ROT();
  }
  #undef CMASK
  #define CMASK(P0,P1,t) do{int jb_=(t)-(NT-4); if(jb_>=0)cmask(P0,P1,jb_,qrel,hi,LIN?0.f:-INFINITY);}while(0)
  #define ENDW(tt) do{ if((tt)+3<NT){WAIT_BAR(3);} else if((tt)+2<NT){WAIT_BAR(2);} else {WAIT_BAR(0);} }while(0)
  for(;t+1<NT;t+=2){
    STEP(pB0,pB1,pA0,pA1,t,(t+3<NT),(t+1<NT),(t+1<NT));       ENDW(t);   RESC(); ROT();
    STEP(pA0,pA1,pB0,pB1,t+1,(t+4<NT),(t+2<NT),(t+2<NT));     ENDW(t+1); RESC(); ROT();
  }
  STEP(pB0,pB1,pA0,pA1,NT-1,false,false,false); RESC();
  if constexpr(LIN){ KVUPD(sl_cur); asm volatile("s_waitcnt lgkmcnt(0)\n\ts_barrier":::"memory"); }
  if(has_next){ const int sN=sl_next,sN1=NXS(sN),sN2=NXS(sN1);
    int ln2=lane; asm volatile("":"+v"(ln2)); const int r32n=ln2&31,hin=ln2>>5;
    const long nrb=(long)N_.rb+(long)N_.tsk*KVBLK;
    const bf16*nK=proj+N_.ck+nrb*DM+(long)ln2*8+wid*512; const bf16*nV=proj+N_.cv+nrb*DM+(wid>>2)*2048+(wid&3)*512+(long)ln2*8; const bf16*nQ=proj+N_.cq+((long)N_.rb+N_.qb*QB+(wid>>1)*KVBLK)*DM+(wid&1)*(QBLK*8);
    glds16(nK,(unsigned)__builtin_amdgcn_readfirstlane(kdst+sN)); glds16(nV,(unsigned)__builtin_amdgcn_readfirstlane(vdst+2*sN)); glds16(nV+GSTR,(unsigned)__builtin_amdgcn_readfirstlane(vdst+2*sN+8192));
    glds16(nK+(long)KVBLK*DM,(unsigned)__builtin_amdgcn_readfirstlane(kdst+sN1));
    #pragma unroll
    for(int d0=0;d0<4;++d0)qr[d0]=*reinterpret_cast<const bf16x8*>(&nQ[(2*d0+hin)*512+r32n*8]);
    glds16(nK+(long)2*KVBLK*DM,(unsigned)__builtin_amdgcn_readfirstlane(kdst+sN2));
    slot0=sN; }
  { float sacc=pB0[0]+pB0[1]; _Pragma("unroll") for(int r=2;r<16;++r)sacc+=pB0[r]; _Pragma("unroll") for(int r=0;r<16;++r)sacc+=pB1[r]; l_reg+=sacc;
    pw0=(u32x4){PKW(pB0,0),PKW(pB0,2),PKW(pB0,4),PKW(pB0,6)};pw1=(u32x4){PKW(pB0,8),PKW(pB0,10),PKW(pB0,12),PKW(pB0,14)};pw2=(u32x4){PKW(pB1,0),PKW(pB1,2),PKW(pB1,4),PKW(pB1,6)};pw3=(u32x4){PKW(pB1,8),PKW(pB1,10),PKW(pB1,12),PKW(pB1,14)};
    SBAR(); pv(o,vb0+2*sl_cur,PAF(0),PAF(1),PAF(2),PAF(3)); }
  #undef PKW
  #undef PAF
  #undef FFR
  #undef PIN
  #undef MX3
  #undef GAPA
  #undef GAPB
  #undef EXB
  #undef KR
  #undef FMAK
  #undef FRD
  #undef KRD
  #undef MF32
  #undef CST
  #undef KVUPD
  #undef STEP
  #undef ENDW
  {auto rr=__builtin_amdgcn_permlane32_swap(__float_as_uint(l_reg),__float_as_uint(l_reg),false,false);l_reg=__uint_as_float(rr[0])+__uint_as_float(rr[1]);}
  if(hi==0)wsf[32+r32]=l_reg;asm volatile("s_waitcnt lgkmcnt(0)":::"memory");
  float rli[16];
  #pragma unroll
  for(int r=0;r<16;++r)rli[r]=__builtin_amdgcn_rcpf(wsf[32+crow(r,hi)]);
  { int ln_=lane; asm volatile("":"+v"(ln_));
    const int r32e=ln_&31, hie=ln_>>5;
    bf16*stg=(bf16*)(shm+LDS_OST)+wid*4096+hie*512+r32e;
    #pragma unroll
    for(int r=0;r<16;++r){const int orow=(r&3)+8*(r>>2);
      #pragma unroll
      for(int d0=0;d0<4;++d0){ float val=LIN?o[d0][r]:o[d0][r]*rli[r];
        if(MODE==1) val=__bfloat162float(stg[orow*128+d0*32])-lam*val;
        stg[orow*128+d0*32]=__float2bfloat16(val);} }
    asm volatile("s_waitcnt lgkmcnt(0)":::"memory"); }
  asm volatile("s_waitcnt lgkmcnt(0)\n\ts_barrier":::"memory");
  #undef DMA_K
  #undef DMA_V
  #undef CMASK
  #undef START
  #undef RESC
  #undef ROT
  #undef ALIBI_IN
  #undef NXS
}

typedef unsigned u32x2r __attribute__((ext_vector_type(2)));
typedef float f32x4r __attribute__((ext_vector_type(4)));
constexpr int R2_Q=LDS_OST, R2_SIMG=R2_Q+NSLOT*SLOTB, R2_SROW=144, R2_SBUF=128*R2_SROW, R2_STG=R2_SIMG+R2_SBUF, R2_STROW=264, R2_GATE=R2_STG+64*R2_STROW, R2_END=R2_GATE+16384;
static_assert(R2_END<=LDS_BYTES,"ret_chain LDS map");
__device__ __forceinline__ u32x4 gld16_async(const void*p){u32x4 r;asm volatile("global_load_dwordx4 %0, %1, off":"=v"(r):"v"(p):"memory");return r;}
__device__ __forceinline__ void ret_chain(const bf16*__restrict__ proj,long rowbase,int cq,int ck,int cv,int cg,float lgam,char*shm,int slot0,bool pre,const __attribute__((address_space(1))) float*gain,unsigned short*mixh,int DMX){
  #define NXS(s) (((s)==(NSLOT-1)*SLOTB)?0:(s)+SLOTB)
  int tid_=threadIdx.x; asm volatile("":"+v"(tid_));
  const int tid=tid_,lane=tid&63,r32=lane&31,hi=lane>>5; const int wid=__builtin_amdgcn_readfirstlane(tid>>6);
  const int rb=wid>>2,cb=wid&3;
  const unsigned lds0=(unsigned)(uintptr_t)shm; const lds_cptr shm3=(lds_cptr)shm;
  const bf16*ksrc=proj+ck+rowbase*DM+lane*8+wid*512; const bf16*qsrc=proj+cq+rowbase*DM+lane*8+wid*512;
  const bf16*vsrc=proj+cv+rowbase*DM+(wid>>2)*2048+(wid&3)*512+lane*8;
  const unsigned kdst=lds0+LDS_K+wid*1024, qdst=lds0+R2_Q+wid*1024, vdst=lds0+LDS_V+wid*1024;
  #define R2_DMA(t,slot) do{ glds16(ksrc+(long)(t)*KVBLK*DM,(unsigned)__builtin_amdgcn_readfirstlane(kdst+(slot))); glds16(qsrc+(long)(t)*KVBLK*DM,(unsigned)__builtin_amdgcn_readfirstlane(qdst+(slot))); \
    glds16(vsrc+(long)(t)*KVBLK*DM,(unsigned)__builtin_amdgcn_readfirstlane(vdst+2*(slot))); glds16(vsrc+(long)(t)*KVBLK*DM+GSTR,(unsigned)__builtin_amdgcn_readfirstlane(vdst+2*(slot)+8192)); }while(0)
  const lds_cptr kp0=shm3+LDS_K+hi*1024+r32*16;
  const lds_cptr qp0=shm3+R2_Q+hi*1024+(32*rb+r32)*16;
  const lds_cptr ktp0=shm3+LDS_K+(4*rb+2*((lane>>4)&1)+((lane&3)>>1))*1024+(4*hi+((lane&15)>>2))*16+(lane&1)*8;
  const lds_cptr vp0=shm3+LDS_V+((lane>>4)&1)*32+(lane&3)*8+(4*hi+((lane&15)>>2))*64+cb*4096;
  const lds_cptr sr0=shm3+R2_SIMG+(32*cb+r32)*R2_SROW+hi*16;
  char*const sw0=shm+R2_SIMG+(32*cb+r32)*R2_SROW+(32*rb+4*hi)*2;
  const int qrow=32*rb+r32;
  char*const stw=shm+R2_STG+qrow*R2_STROW+(32*cb+4*hi)*2;
  const int ch=lane&15, frow=8*wid+(lane>>4);
  const char*const str=shm+R2_STG+frow*R2_STROW+ch*16;
  const bf16*gsrc=proj+cg+(long)(ch>>3)*GSTR+(rowbase+frow)*DM+(ch&7)*8;
  unsigned short*msrc=mixh+(rowbase+frow)*(long)DMX+ch*8;
  float gd[8];
  #pragma unroll
  for(int r=0;r<8;++r)gd[r]=gain[ch*8+r];
  const float g64=__builtin_amdgcn_exp2f(64.f*lgam);
  f32x16 T,O;
  { _Pragma("unroll") for(int r=0;r<16;++r){float z_,y_;asm volatile("v_mov_b32 %0, 0\n\tv_mov_b32 %1, 0":"=v"(z_),"=v"(y_));T[r]=z_;O[r]=y_;} }
  #define MF32(a,b,c) __builtin_amdgcn_mfma_f32_32x32x16_bf16(a,b,c,0,0,0)
  asm volatile("s_waitcnt vmcnt(0) lgkmcnt(0)\n\ts_barrier":::"memory");
  { _Pragma("unroll") for(int r=0;r<8;++r)asm volatile("":"+v"(gd[r])); }
  const int sA=slot0,sB=NXS(sA),sC=NXS(sB);
  const unsigned gdst=lds0+R2_GATE+wid*2048; const char*const grd=shm+R2_GATE+wid*2048+lane*16;
  #define R2_GDMA(tt) do{ const bf16*gp_=gsrc+(long)(tt)*KVBLK*DM; asm volatile("s_waitcnt lgkmcnt(0)":::"memory"); glds16(gp_,(unsigned)__builtin_amdgcn_readfirstlane(gdst)); glds16(gp_+(long)4*DM,(unsigned)__builtin_amdgcn_readfirstlane(gdst+1024)); }while(0)
  if(!pre){ glds16(ksrc,(unsigned)__builtin_amdgcn_readfirstlane(kdst+sA)); glds16(vsrc,(unsigned)__builtin_amdgcn_readfirstlane(vdst+2*sA)); glds16(vsrc+GSTR,(unsigned)__builtin_amdgcn_readfirstlane(vdst+2*sA+8192)); }
  glds16(qsrc,(unsigned)__builtin_amdgcn_readfirstlane(qdst+sA));
  R2_DMA(1,sB);
  { u32x2r z_; z_.x=0u; z_.y=0u;
    #pragma unroll
    for(int g4=0;g4<4;++g4)*reinterpret_cast<u32x2r*>(sw0+g4*16)=z_; }
  int s_cur=sA,s_n1=sB,s_n2=sC;
  u32x4 ow[2];
  #define R2_FINAL() do{ u32x4 av_[2],gv_[2]; float qv_[2]; \
      _Pragma("unroll") for(int k=0;k<2;++k){ av_[k]=*reinterpret_cast<const u32x4*>(str+k*4*R2_STROW); gv_[k]=*reinterpret_cast<const u32x4*>(grd+k*1024); } \
      _Pragma("unroll") for(int k=0;k<2;++k){ const u32x4 a_=av_[k]; float s_=0.f; \
        _Pragma("unroll") for(int e=0;e<4;++e){ const float lo_=__uint_as_float(a_[e]<<16),hi_=__uint_as_float(a_[e]&0xffff0000u); s_=__builtin_fmaf(lo_,lo_,s_); s_=__builtin_fmaf(hi_,hi_,s_); } qv_[k]=s_; } \
      _Pragma("unroll") for(int o_=1;o_<16;o_<<=1){ _Pragma("unroll") for(int k=0;k<2;++k)qv_[k]+=__shfl_xor(qv_[k],o_); } \
      _Pragma("unroll") for(int k=0;k<2;++k){ const u32x4 a_=av_[k]; const float rs_=__builtin_amdgcn_rsqf(qv_[k]*(1.0f/128.0f)+1e-6f); \
        _Pragma("unroll") for(int e=0;e<4;++e){ const float lo_=__uint_as_float(a_[e]<<16),hi_=__uint_as_float(a_[e]&0xffff0000u); const unsigned gw_=gv_[k][e]; \
          ow[k][e]=cvtpk_s(lo_*rs_*gd[2*e]*__uint_as_float(gw_<<16),hi_*rs_*gd[2*e+1]*__uint_as_float(gw_&0xffff0000u)); } } }while(0)
  #define R2_STORE(tt) do{ unsigned short*mp_=msrc+(long)(tt)*KVBLK*DMX; _Pragma("unroll") for(int k=0;k<2;++k)*(__attribute__((address_space(1))) u32x4*)(mp_+(long)k*4*DMX)=ow[k]; }while(0)
  #define R2_BODY(t,GV) do{ \
    if(t<=1){ WAIT_BAR(4); } else if(t==31){ WAIT_BAR(2); } else { WAIT_BAR(6); } \
    const lds_cptr vt_=vp0+2*s_cur; const lds_cptr kt_=ktp0+s_cur; const lds_cptr kf_=kp0+s_cur; const lds_cptr qf_=qp0+s_cur; const lds_cptr sr_=sr0; \
    bf16x8 vf[4],ka[4],sf[4],qf[4],kb0[4],kb1[4]; \
    _Pragma("unroll") \
    for(int ks=0;ks<4;++ks){ const s16x4 b0_=vtr(vt_+ks*1024),b1_=vtr(vt_+ks*1024+512); vf[ks]=(bf16x8){b0_[0],b0_[1],b0_[2],b0_[3],b1_[0],b1_[1],b1_[2],b1_[3]}; \
      const s16x4 a0_=vtr(kt_+ks*256),a1_=vtr(kt_+ks*256+128); ka[ks]=(bf16x8){a0_[0],a0_[1],a0_[2],a0_[3],a1_[0],a1_[1],a1_[2],a1_[3]}; } \
    _Pragma("unroll") \
    for(int d0=0;d0<4;++d0){ sf[d0]=*(const __attribute__((address_space(3))) bf16x8*)(sr_+d0*32); qf[d0]=*(const __attribute__((address_space(3))) bf16x8*)(qf_+d0*2048); \
      kb0[d0]=*(const __attribute__((address_space(3))) bf16x8*)(kf_+d0*2048); kb1[d0]=*(const __attribute__((address_space(3))) bf16x8*)(kf_+d0*2048+512); } \
    SBAR(); \
    if(t>0){ R2_FINAL(); } \
    R2_GDMA(t); \
    if(t+2<32){ R2_DMA(t+2,s_n2); } \
    asm volatile("s_waitcnt lgkmcnt(0)":::"memory"); SBAR(); \
    f32x16 p0,p1; \
 \
    _Pragma("unroll") \
    for(int d0=0;d0<4;++d0){ O=MF32(sf[d0],qf[d0],d0==0?f32x16{}:O); T=MF32(ka[d0],vf[d0],T); p0=MF32(kb0[d0],qf[d0],d0==0?f32x16{}:p0); p1=MF32(kb1[d0],qf[d0],d0==0?f32x16{}:p1); SBAR(); } \
    { _Pragma("unroll") for(int r=0;r<16;++r){ const int kv=4*hi+(r&3)+8*(r>>2); p0[r]=(kv>qrow)?0.f:p0[r]; p1[r]=(kv+32>qrow)?0.f:p1[r]; } } \
    { u32x4 pw0,pw1,pw2,pw3; \
      pw0=(u32x4){cvtpk_s(p0[0],p0[1]),cvtpk_s(p0[2],p0[3]),cvtpk_s(p0[4],p0[5]),cvtpk_s(p0[6],p0[7])}; pw1=(u32x4){cvtpk_s(p0[8],p0[9]),cvtpk_s(p0[10],p0[11]),cvtpk_s(p0[12],p0[13]),cvtpk_s(p0[14],p0[15])}; \
      pw2=(u32x4){cvtpk_s(p1[0],p1[1]),cvtpk_s(p1[2],p1[3]),cvtpk_s(p1[4],p1[5]),cvtpk_s(p1[6],p1[7])}; pw3=(u32x4){cvtpk_s(p1[8],p1[9]),cvtpk_s(p1[10],p1[11]),cvtpk_s(p1[12],p1[13]),cvtpk_s(p1[14],p1[15])}; \
      O=MF32(vf[0],__builtin_bit_cast(bf16x8,pw0),O); O=MF32(vf[1],__builtin_bit_cast(bf16x8,pw1),O); O=MF32(vf[2],__builtin_bit_cast(bf16x8,pw2),O); O=MF32(vf[3],__builtin_bit_cast(bf16x8,pw3),O); } \
    asm volatile("s_waitcnt lgkmcnt(0)\n\ts_barrier":::"memory"); \
    { _Pragma("unroll") for(int r=0;r<16;++r)T[r]*=g64; } \
    if(t<31){ char*sw_=sw0; \
      _Pragma("unroll") for(int g4=0;g4<4;++g4){ u32x2r w_; w_.x=cvtpk_s(T[4*g4],T[4*g4+1]); w_.y=cvtpk_s(T[4*g4+2],T[4*g4+3]); *reinterpret_cast<u32x2r*>(sw_+g4*16)=w_; } } \
    { _Pragma("unroll") for(int g=0;g<4;++g){ u32x2r w_; w_.x=cvtpk_s(O[4*g],O[4*g+1]); w_.y=cvtpk_s(O[4*g+2],O[4*g+3]); *reinterpret_cast<u32x2r*>(stw+g*16)=w_; } } \
    if(t>0){ R2_STORE(t-1); } \
    { const int s_=s_cur; s_cur=s_n1; s_n1=s_n2; s_n2=s_; } \
  }while(0)
  asm volatile(".p2align 6");
  for(int t=0;t<32;++t){ R2_BODY(t,0); }
  WAIT_BAR(0);
  { R2_FINAL(); R2_STORE(31); }
  #undef R2_DMA
  #undef R2_FINAL
  #undef R2_STORE
  #undef R2_BODY
  #undef R2_GDMA
  #undef MF32
  #undef NXS
}
constexpr int ATTN_LDS_BYTES=LDS_BYTES;
#undef SBAR
#undef WAIT_BAR
}
#ifndef PG8_SP2
#define PG8_SP2 true
#endif
#ifndef PG8_ALIGN
#define PG8_ALIGN true
#endif
#ifndef RET_NAIVE
#define RET_NAIVE 0
#endif
#ifndef PROBE_DUP
#define PROBE_DUP 0
#endif
constexpr int ATT_THR = 40;
#ifndef NO_TSKIP
#define NO_TSKIP 0
#endif
#ifndef STAGGER_US
#define STAGGER_US 0
#endif
constexpr int NWAVES = 8;
using pg8::NORM_EPS;
#ifndef MK_PER_PHASE
#define MK_PER_PHASE 0
#endif
constexpr int BATCH = 32, SEQ = 2048, D = 1024, DEPTH = 2;
constexpr int M = BATCH * SEQ;
constexpr int NIN = 3072, FF = 2816, NGU = 2 * FF;
constexpr int C_RQ = 0, C_RK = 256, C_RV = 512, C_RG = 1024, C_DQ = 1536, C_DK = 2048, C_DV = 2560;
constexpr float LOG2E = 1.4426950408889634f;
constexpr float C2 = 0.125f * LOG2E;
constexpr int N_PHASES = 12;
constexpr size_t MiB = 1u << 20;
constexpr size_t WS_CTL = 0, CTL_ZERO_BYTES = 64 * 1024;
constexpr size_t WS_W = 2 * MiB, W_LAYER = 25 * MiB, W_IN = 0, W_OUT = 6 * MiB, W_GU = 8 * MiB, W_DN = 19 * MiB;
constexpr size_t WS_SSA = 52 * MiB, WS_SSB = 56 * MiB;
constexpr size_t WS_HB = 64 * MiB;
constexpr size_t WS_MIX = 192 * MiB;
constexpr size_t WS_PROJ = 320 * MiB;
constexpr size_t WS_END = 704 * MiB;
static_assert(W_DN + (size_t)D * FF * 2 <= W_LAYER && WS_W + 2 * W_LAYER <= WS_SSA && WS_SSB + (size_t)M * 64 <= WS_HB && WS_HB + (size_t)M * D * 2 <= WS_MIX && WS_MIX + (size_t)M * D * 2 <= WS_PROJ && WS_PROJ + (size_t)M * NIN * 2 <= WS_END, "d_ws map");
constexpr size_t WS_LAM = 60 * MiB;
constexpr size_t WS_QN = 61 * MiB, WS_KN = 61 * MiB + 65536;
constexpr int CW_BAR = 1024;
constexpr int RING_OFF = 0, RING_BYTES = 157696;
constexpr int LDSCTL_OFF = RING_BYTES, MISC_OFF = LDSCTL_OFF + 320;
constexpr int LDS_BYTES = 158720;
static_assert(MISC_OFF + 128 <= LDS_BYTES && attn_body::ATTN_LDS_BYTES <= RING_BYTES && pg8::STAGE_BYTES <= RING_BYTES, "LDS map");
#define GAS __attribute__((address_space(1)))
#define LAS __attribute__((address_space(3)))
typedef unsigned short bf16;
typedef unsigned v4u __attribute__((ext_vector_type(4)));
typedef float f32x4 __attribute__((ext_vector_type(4)));
typedef short bf16x8 __attribute__((ext_vector_type(8)));
typedef GAS unsigned gu32;
typedef GAS unsigned long long gu64;
#define RLX_AGENT __ATOMIC_RELAXED, __HIP_MEMORY_SCOPE_AGENT
#define LDS_WAIT() asm volatile("s_waitcnt lgkmcnt(0)" ::: "memory")
#define VM_WAIT() asm volatile("s_waitcnt vmcnt(0)" ::: "memory")
__device__ __forceinline__ unsigned long long rt() { return __builtin_amdgcn_s_memrealtime(); }
__device__ __forceinline__ unsigned f2bf(float f) { unsigned u = __builtin_bit_cast(unsigned, f); return (u + 0x7fffu + ((u >> 16) & 1u)) >> 16; }
__device__ __forceinline__ unsigned pk2(float lo, float hi) { return f2bf(lo) | (f2bf(hi) << 16); }

#define XB_TMO      128
#define XB_XCNT(j)  (256  + 64 * (j))
#define XB_XSUB(j)  (1280 + 64 * (j))
#define XB_XGEN(j)  (2304 + 64 * (j))
#define XB_TOP      3328
#define XB_TOPGEN   3392
#define XCD_BAR_WORDS 3456
#define XB_TAGMAX(j) (3520 + 64 * (j))
#define XB_TAGNEG(j) (4544 + 64 * (j))
#define XB_SPIN_CAP (1u << 22)

__device__ __forceinline__ unsigned xb_ld(unsigned* p)              { return __hip_atomic_load(p, __ATOMIC_RELAXED, __HIP_MEMORY_SCOPE_AGENT); }
__device__ __forceinline__ unsigned xb_add(unsigned* p, unsigned v) { return __hip_atomic_fetch_add(p, v, __ATOMIC_RELAXED, __HIP_MEMORY_SCOPE_AGENT); }
__device__ __forceinline__ unsigned xb_xcc_id() { return (unsigned)__builtin_amdgcn_s_getreg((3 << 11) | 20) & 0xFu; }
#define XB_SPIN(cond, bar) do { unsigned _sp = 0; while (cond) { __builtin_amdgcn_s_sleep(1); \
    if ((++_sp & 255u) == 0u) { if (xb_ld(&(bar)[XB_TMO])) break; if (_sp > XB_SPIN_CAP) { atomicAdd(&(bar)[XB_TMO], 1u); break; } } } } while (0)

struct XcdBarrier {
    unsigned* bar; unsigned x;
    volatile LAS unsigned* st;
};

__device__ __forceinline__ XcdBarrier xcd_barrier_post(unsigned* bar, volatile LAS unsigned* st) {
    XcdBarrier b; b.bar = bar; b.x = xb_xcc_id(); b.st = st;
    if (threadIdx.x == 0) { (void)xb_add(&bar[XB_XCNT(b.x)], 1u);
}
    return b;
}
__device__ __forceinline__ void xcd_barrier_complete(unsigned* bar, unsigned x, unsigned& nloc, unsigned& nx) {
    const unsigned G = gridDim.x * gridDim.y * gridDim.z;
    unsigned sum, cnt, mine, sp = 0u;
    for (;;) {
        sum = 0u; cnt = 0u; mine = 0u;
#pragma unroll
        for (unsigned j = 0; j < 16; ++j) { const unsigned c = xb_ld(&bar[XB_XCNT(j)]); sum += c; cnt += (c > 0u) ? 1u : 0u; mine = (j == x) ? c : mine; }
        if (sum == G) break;
        __builtin_amdgcn_s_sleep(1);
        if ((++sp & 255u) == 0u) { if (xb_ld(&bar[XB_TMO])) break; if (sp > XB_SPIN_CAP) { atomicAdd(&bar[XB_TMO], 1u); break; } }
    }
    nloc = mine > 0u ? mine : 1u; nx = cnt > 0u ? cnt : 1u;
}

__device__ __forceinline__ void xcd_barrier(const XcdBarrier& b, bool may_local = false) {
    asm volatile("s_waitcnt vmcnt(0)" ::: "memory");
    __syncthreads();
    if (threadIdx.x == 0) {
        unsigned* bar = b.bar; unsigned bx_ = b.x; asm volatile("" : "+s"(bx_));
        __builtin_amdgcn_s_waitcnt(0);
        unsigned nloc = b.st[0], nx = b.st[1];
        if (nloc == 0u) { xcd_barrier_complete(bar, bx_, nloc, nx); b.st[0] = nloc; b.st[1] = nx; }
        const unsigned old = xb_add(&bar[XB_XSUB(bx_)], 1u);
        const unsigned gen = old / nloc;
        if (old + 1u == (gen + 1u) * nloc && may_local && b.st[2] != 0u) {
            __builtin_amdgcn_fence(__ATOMIC_ACQUIRE, "agent");
            xb_add(&bar[XB_XGEN(bx_)], 1u);
            asm volatile("s_waitcnt vmcnt(0)" ::: "memory");
        } else
        if (old + 1u == (gen + 1u) * nloc) {
            __builtin_amdgcn_fence(__ATOMIC_RELEASE, "agent");
            asm volatile("s_waitcnt vmcnt(0)" ::: "memory");
            const unsigned og = xb_add(&bar[XB_TOP], 1u);
            const unsigned tg = og / nx;
            if (og + 1u == (tg + 1u) * nx) xb_add(&bar[XB_TOPGEN], 1u);
            else XB_SPIN(xb_ld(&bar[XB_TOPGEN]) == tg, bar);
            __builtin_amdgcn_fence(__ATOMIC_ACQUIRE, "agent");
            xb_add(&bar[XB_XGEN(bx_)], 1u);
            asm volatile("s_waitcnt vmcnt(0)" ::: "memory");
        } else {
            XB_SPIN(xb_ld(&bar[XB_XGEN(bx_)]) == gen, bar);
            __builtin_amdgcn_fence(__ATOMIC_ACQUIRE, "agent");
            asm volatile("s_waitcnt vmcnt(0)" ::: "memory");
        }
    }
    __syncthreads();
}

__device__ __forceinline__ void xcd_tag_post(const XcdBarrier& b) {
    if (threadIdx.x == 0) { unsigned x = b.x; asm volatile("" : "+s"(x)); const unsigned tag = blockIdx.x & 7u;
        (void)__hip_atomic_fetch_max(&b.bar[XB_TAGMAX(x)], tag + 1u, __ATOMIC_RELAXED, __HIP_MEMORY_SCOPE_AGENT);
        (void)__hip_atomic_fetch_max(&b.bar[XB_TAGNEG(x)], 8u - tag, __ATOMIC_RELAXED, __HIP_MEMORY_SCOPE_AGENT); }
}
__device__ __forceinline__ void xcd_local_check(const XcdBarrier& b) {
    if (threadIdx.x == 0) {
        unsigned ok = (gridDim.x * gridDim.y * gridDim.z == 256u) ? 1u : 0u, npop = 0u;
#pragma nounroll
        for (unsigned j_ = 0; j_ < 16; ++j_) { unsigned j = j_; asm volatile("" : "+s"(j));
            const unsigned c = xb_ld(&b.bar[XB_XCNT(j)]);
            if (c) { ++npop; const unsigned tmax = xb_ld(&b.bar[XB_TAGMAX(j)]), tneg = xb_ld(&b.bar[XB_TAGNEG(j)]); if (c != 32u || tmax - 1u != 8u - tneg) ok = 0u; } }
        if (npop != 8u) ok = 0u;
        b.st[2] = ok;
    }
    __syncthreads();
}
struct Frame {
    LAS unsigned char* lds;
    volatile LAS unsigned* MISC;
    gu32* ctl;
    int tid, lane, wave;
    int vcu, G;
};
__device__ __forceinline__ float wave_sum(float v) {
#pragma unroll
    for (int o = 1; o < 64; o <<= 1) v += __shfl_xor(v, o);
    return v;
}
__device__ __forceinline__ float bf2f(bf16 b) { return __builtin_bit_cast(float, (unsigned)b << 16); }
__device__ __forceinline__ float bflo(unsigned w) { return __builtin_bit_cast(float, w << 16); }
__device__ __forceinline__ float bfhi(unsigned w) { return __builtin_bit_cast(float, w & 0xffff0000u); }
__device__ __forceinline__ float lam_init_of(int l) { return l == 0 ? 0.2f : 0.35550907f; }

template <int MODE, bool HAS_GAIN>
__device__ __forceinline__ void p0_transpose_item(const float* W, int K, int N, bf16* WT, const float* gain, LAS float* scr, int item, int lane) {
    const int nblk = N / 32, kb = item / nblk, nb = item % nblk, k0 = 64 * kb, n0 = 32 * nb;
    float cs = 1.f;
    if (MODE == 1) { if (n0 >= C_RK && n0 < C_RV) cs = 0.125f; else if (n0 >= C_DQ && n0 < C_DK) cs = C2; }
#pragma unroll 8
    for (int i = 0; i < 32; ++i) { const int kk = 2 * i + (lane >> 5); const float g = HAS_GAIN ? gain[k0 + kk] * cs : cs; scr[kk * 33 + (lane & 31)] = W[(size_t)(k0 + kk) * N + n0 + (lane & 31)] * g; }
    LDS_WAIT(); asm volatile("" ::: "memory");
    const int c = lane & 7;
#pragma unroll
    for (int j = 0; j < 4; ++j) { const int n = (lane >> 3) + 8 * j; const LAS float* s = scr + (8 * c) * 33 + n;
        v4u o; o.x = pk2(s[0 * 33], s[1 * 33]); o.y = pk2(s[2 * 33], s[3 * 33]); o.z = pk2(s[4 * 33], s[5 * 33]); o.w = pk2(s[6 * 33], s[7 * 33]);
        const int nn = n0 + n; int drow = nn;
        if (MODE == 2) drow = 256 * (nn >> 7) + 64 * ((nn >> 5) & 3) + (nn & 31);
        if (MODE == 3) drow = 256 * (nn >> 7) + 64 * ((nn >> 5) & 3) + 32 + (nn & 31);
        *(GAS v4u*)(WT + (size_t)drow * K + k0 + 8 * c) = o; }
    LDS_WAIT(); asm volatile("" ::: "memory");
}
struct Ptrs {
    const float *x, *attn_norm, *w_in, *ret_norm, *lq1, *lk1, *lq2, *lk2, *diff_norm, *w_out, *ffn_norm, *w_gate, *w_up, *w_down, *final_norm;
    float* out; unsigned char* ws;
};

struct Args { const float* in[15]; float* out; unsigned char* ws; int ph_lo, ph_hi; };
typedef const __attribute__((address_space(4))) Args* KArgsPtr;
__device__ __forceinline__ KArgsPtr kargs() { KArgsPtr p = (KArgsPtr)__builtin_amdgcn_kernarg_segment_ptr(); asm volatile("" : "+s"(p)); return p; }
__device__ __forceinline__ void load_ptrs(Ptrs& P) {
    KArgsPtr a = kargs();
#define GP(T, e) ((T*)(GAS T*)(e))
    P.x = GP(const float, a->in[0]); P.attn_norm = GP(const float, a->in[1]); P.w_in = GP(const float, a->in[2]); P.ret_norm = GP(const float, a->in[3]);
    P.lq1 = GP(const float, a->in[4]); P.lk1 = GP(const float, a->in[5]); P.lq2 = GP(const float, a->in[6]); P.lk2 = GP(const float, a->in[7]);
    P.diff_norm = GP(const float, a->in[8]); P.w_out = GP(const float, a->in[9]); P.ffn_norm = GP(const float, a->in[10]); P.w_gate = GP(const float, a->in[11]);
    P.w_up = GP(const float, a->in[12]); P.w_down = GP(const float, a->in[13]); P.final_norm = GP(const float, a->in[14]);
    P.out = GP(float, a->out); P.ws = GP(unsigned char, a->ws);
#undef GP
}
__device__ __forceinline__ void make_frame(Frame& F, unsigned char* lds) {
    int t = threadIdx.x; asm volatile("" : "+v"(t));
    F.lds = (LAS unsigned char*)lds; F.MISC = (volatile LAS unsigned*)(F.lds + MISC_OFF);
    F.tid = t; F.lane = t & 63; F.wave = __builtin_amdgcn_readfirstlane(t >> 6);
    F.G = gridDim.x; { const int bx = blockIdx.x; F.vcu = (F.G % 8 == 0) ? (bx % 8) * (F.G / 8) + bx / 8 : bx; }
}
__device__ __forceinline__ void p0_prologue(unsigned char* lds_) {
    Frame F; make_frame(F, lds_); Ptrs P; load_ptrs(P);
    LAS float* scr = (LAS float*)(F.lds + RING_OFF + F.wave * 16384);
    const int gw = F.vcu * NWAVES + F.wave, NGW = F.G * NWAVES;
    constexpr int I_IN = (D / 64) * (NIN / 32), I_OUT = (D / 64) * (D / 32), I_G = (D / 64) * (FF / 32), I_DN = (FF / 64) * (D / 32);
    constexpr int I_LAYER = I_IN + I_OUT + 2 * I_G + I_DN;
    for (int it = gw; it < DEPTH * I_LAYER; it += NGW) {
        const int l = it / I_LAYER; int r = it % I_LAYER;
        bf16* wl = (bf16*)(P.ws + WS_W + (size_t)l * W_LAYER);
        if (r < I_IN) { p0_transpose_item<1, true>(P.w_in + (size_t)l * D * NIN, D, NIN, (bf16*)((unsigned char*)wl + W_IN), P.attn_norm + l * D, scr, r, F.lane); continue; } r -= I_IN;
        if (r < I_OUT) { p0_transpose_item<0, false>(P.w_out + (size_t)l * D * D, D, D, (bf16*)((unsigned char*)wl + W_OUT), nullptr, scr, r, F.lane); continue; } r -= I_OUT;
        if (r < I_G) { p0_transpose_item<2, true>(P.w_gate + (size_t)l * D * FF, D, FF, (bf16*)((unsigned char*)wl + W_GU), P.ffn_norm + l * D, scr, r, F.lane); continue; } r -= I_G;
        if (r < I_G) { p0_transpose_item<3, true>(P.w_up + (size_t)l * D * FF, D, FF, (bf16*)((unsigned char*)wl + W_GU), P.ffn_norm + l * D, scr, r, F.lane); continue; } r -= I_G;
        p0_transpose_item<0, false>(P.w_down + (size_t)l * FF * D, FF, D, (bf16*)((unsigned char*)wl + W_DN), nullptr, scr, r, F.lane);
    }
    if (gw == 0) {
        for (int l = 0; l < DEPTH; ++l) { const float s1 = wave_sum(P.lq1[l * 64 + F.lane] * P.lk1[l * 64 + F.lane]), s2 = wave_sum(P.lq2[l * 64 + F.lane] * P.lk2[l * 64 + F.lane]);
            if (F.lane == 0) ((GAS float*)(P.ws + WS_LAM))[l] = __expf(s1) - __expf(s2) + lam_init_of(l); } }
    bf16* hb = (bf16*)(P.ws + WS_HB); float* ssa = (float*)(P.ws + WS_SSA);
    for (int m0 = gw; m0 < M; m0 += 2 * NGW) {
        f32x4 v[2][4]; float s[2] = {0.f, 0.f};
#pragma unroll
        for (int r = 0; r < 2; ++r) { const int m = m0 + r * NGW; const GAS f32x4* xr = (const GAS f32x4*)(P.x + (size_t)(m < M ? m : m0) * D) + F.lane;
#pragma unroll
            for (int j = 0; j < 4; ++j) v[r][j] = __builtin_nontemporal_load(&xr[64 * j]); }
#pragma unroll
        for (int r = 0; r < 2; ++r) { const int m = m0 + r * NGW; if (m >= M) break;
#pragma unroll
            for (int j = 0; j < 4; ++j) s[r] += (v[r][j].x * v[r][j].x + v[r][j].y * v[r][j].y) + (v[r][j].z * v[r][j].z + v[r][j].w * v[r][j].w);
            s[r] = wave_sum(s[r]);
            GAS unsigned long long* o8 = (GAS unsigned long long*)(hb + (size_t)m * D) + F.lane;
#pragma unroll
            for (int j = 0; j < 4; ++j) o8[64 * j] = (unsigned long long)pk2(v[r][j].x, v[r][j].y) | ((unsigned long long)pk2(v[r][j].z, v[r][j].w) << 32);
            if (F.lane < 16) ssa[(size_t)m * 16 + F.lane] = F.lane == 0 ? s[r] : 0.f; }
    }
}
__device__ __forceinline__ void final_norm_phase(unsigned char* lds_) {
    Frame F; make_frame(F, lds_); Ptrs P; load_ptrs(P);
    const int gw = F.vcu * NWAVES + F.wave, NGW = F.G * NWAVES;
    const bf16* hb = (const bf16*)(P.ws + WS_HB);
    f32x4 g[4];
#pragma unroll
    for (int j = 0; j < 2; ++j) { g[2 * j] = ((const GAS f32x4*)P.final_norm)[128 * j + 2 * F.lane]; g[2 * j + 1] = ((const GAS f32x4*)P.final_norm)[128 * j + 2 * F.lane + 1]; }
    for (int m = gw; m < M; m += NGW) {
        const GAS v4u* hr = (const GAS v4u*)(hb + (size_t)m * D) + F.lane;
        f32x4 v[4]; float s = 0.f;
#pragma unroll
        for (int j = 0; j < 2; ++j) { const v4u w = __builtin_nontemporal_load(&hr[64 * j]);
            v[2 * j] = (f32x4){bflo(w.x), bfhi(w.x), bflo(w.y), bfhi(w.y)}; v[2 * j + 1] = (f32x4){bflo(w.z), bfhi(w.z), bflo(w.w), bfhi(w.w)}; }
#pragma unroll
        for (int j = 0; j < 4; ++j) s += (v[j].x * v[j].x + v[j].y * v[j].y) + (v[j].z * v[j].z + v[j].w * v[j].w);
        const float rs = 1.0f / sqrtf(wave_sum(s) * (1.0f / D) + NORM_EPS);
        GAS f32x4* o = (GAS f32x4*)(P.out + (size_t)m * D);
#pragma unroll
        for (int j = 0; j < 2; ++j) { __builtin_nontemporal_store(v[2 * j] * rs * g[2 * j], &o[128 * j + 2 * F.lane]); __builtin_nontemporal_store(v[2 * j + 1] * rs * g[2 * j + 1], &o[128 * j + 2 * F.lane + 1]); }
    }
}
template <int KINDS  >
__device__ __forceinline__ void naive_mixer_phase(unsigned char* lds_, int l) {
    Frame F; make_frame(F, lds_); Ptrs P; load_ptrs(P);
    const bf16* proj = (const bf16*)(P.ws + WS_PROJ); bf16* mix = (bf16*)(P.ws + WS_MIX);
    const int gw = F.vcu * NWAVES + F.wave, NGW = F.G * NWAVES, lane = F.lane;
    const float lam_init = lam_init_of(l);
    const float s1 = wave_sum(P.lq1[l * 64 + lane] * P.lk1[l * 64 + lane]), s2 = wave_sum(P.lq2[l * 64 + lane] * P.lk2[l * 64 + lane]);
    const float lam = __expf(s1) - __expf(s2) + lam_init;
    for (int it = gw; it < M * 8; it += NGW) {
        const int m = it >> 3, h = it & 3, kind = (it >> 2) & 1, t = m % SEQ;
        if (!((KINDS >> kind) & 1)) continue;
        const bf16* rowp = proj + (size_t)m * NIN; const bf16* seq0 = proj + (size_t)(m - t) * NIN;
        if (kind == 0) {
            const float q = bf2f(rowp[C_RQ + h * 64 + lane]);
            const float lg = log2f(1.0f - exp2f(-5.0f - (float)h));
            float a0 = 0.f, a1 = 0.f;
            for (int s = 0; s <= t; ++s) { const bf16* pr = seq0 + (size_t)s * NIN;
                const float dot = wave_sum(q * bf2f(pr[C_RK + h * 64 + lane]));
                const float w = dot * exp2f((float)(t - s) * lg);
                const unsigned vv = *(const unsigned*)(pr + C_RV + h * 128 + 2 * lane);
                a0 += w * bflo(vv); a1 += w * bfhi(vv); }
            const float rs = 1.0f / sqrtf(wave_sum(a0 * a0 + a1 * a1) * (1.0f / 128.0f) + NORM_EPS);
            const unsigned gg = *(const unsigned*)(rowp + C_RG + h * 128 + 2 * lane);
            const float g0 = bflo(gg), g1 = bfhi(gg);
            const float y0 = a0 * rs * P.ret_norm[l * 128 + 2 * lane], y1 = a1 * rs * P.ret_norm[l * 128 + 2 * lane + 1];
            const float o0 = g0 / (1.0f + __expf(-g0)) * y0, o1 = g1 / (1.0f + __expf(-g1)) * y1;
            *(unsigned*)(mix + (size_t)m * D + h * 128 + 2 * lane) = pk2(o0, o1);
        } else {
            const float cs = exp2f(-8.0f * (float)(h + 1) / 4.0f) * LOG2E;
            float oj[2][2];
#pragma unroll
            for (int j = 0; j < 2; ++j) {
                const float q = bf2f(rowp[C_DQ + h * 128 + j * 64 + lane]);
                float mx = -INFINITY, lsum = 0.f, a0 = 0.f, a1 = 0.f;
                for (int s = 0; s <= t; ++s) { const bf16* pr = seq0 + (size_t)s * NIN;
                    const float sc = wave_sum(q * bf2f(pr[C_DK + h * 128 + j * 64 + lane])) - cs * (float)(t - s);
                    const unsigned vv = *(const unsigned*)(pr + C_DV + h * 128 + 2 * lane);
                    const float mn = fmaxf(mx, sc), f = exp2f(mx - mn), p = exp2f(sc - mn);
                    lsum = lsum * f + p; a0 = a0 * f + p * bflo(vv); a1 = a1 * f + p * bfhi(vv); mx = mn; }
                oj[j][0] = a0 / lsum; oj[j][1] = a1 / lsum;
            }
            const float d0 = oj[0][0] - lam * oj[1][0], d1 = oj[0][1] - lam * oj[1][1];
            const float rs = 1.0f / sqrtf(wave_sum(d0 * d0 + d1 * d1) * (1.0f / 128.0f) + NORM_EPS) * (1.0f - lam_init);
            *(unsigned*)(mix + (size_t)m * D + 512 + h * 128 + 2 * lane) = pk2(d0 * rs * P.diff_norm[l * 128 + 2 * lane], d1 * rs * P.diff_norm[l * 128 + 2 * lane + 1]);
        }
    }
}


template <int KIND  >
__device__ __forceinline__ void mixer_finalize(const Ptrs& P, int l, char* lds, long row0  , int h, float lam_init) {
    int ln = threadIdx.x & 63; asm volatile("" : "+v"(ln));
    const int wv = __builtin_amdgcn_readfirstlane((int)threadIdx.x >> 6);
    const GAS float* dn = (const GAS float*)((KIND == 0 ? P.diff_norm : P.ret_norm) + l * 128); asm volatile("" : "+s"(dn));
    const attn_body::bf16* stg = (const attn_body::bf16*)(lds + attn_body::LDS_OST) + wv * 4096;
    const int ch = ln & 15;
    float gd[8];
#pragma unroll
    for (int e = 0; e < 8; ++e) gd[e] = dn[ch * 8 + e];
    const int colo = (KIND == 0 ? 512 : 0) + h * 128 + ch * 8;
    unsigned short* mixrow = (unsigned short*)(P.ws + WS_MIX) + (size_t)row0 * D + colo;
    const unsigned short* gaterow = (const unsigned short*)(P.ws + WS_PROJ) + (size_t)row0 * NIN + C_RG + h * 128 + ch * 8;
    v4u av[8]; float qv[8]; v4u gv[8];
#pragma unroll
    for (int k = 0; k < 8; ++k) { const int row = k * 4 + (ln >> 4);
        av[k] = *(const v4u*)(stg + row * 128 + ch * 8);
        if (KIND == 1) gv[k] = *(const GAS v4u*)(gaterow + (size_t)row * NIN); }
#pragma unroll
    for (int k = 0; k < 8; ++k) { const v4u a = av[k];
        const float v0 = bflo(a.x), v1 = bfhi(a.x), v2 = bflo(a.y), v3 = bfhi(a.y), v4 = bflo(a.z), v5 = bfhi(a.z), v6 = bflo(a.w), v7 = bfhi(a.w);
        qv[k] = ((v0 * v0 + v1 * v1) + (v2 * v2 + v3 * v3)) + ((v4 * v4 + v5 * v5) + (v6 * v6 + v7 * v7)); }
#pragma unroll
    for (int o = 1; o < 16; o <<= 1) {
#pragma unroll
        for (int k = 0; k < 8; ++k) qv[k] += __shfl_xor(qv[k], o); }
#pragma unroll
    for (int k = 0; k < 8; ++k) { const int row = k * 4 + (ln >> 4); const v4u a = av[k];
        float v[8];
        v[0] = bflo(a.x); v[1] = bfhi(a.x); v[2] = bflo(a.y); v[3] = bfhi(a.y); v[4] = bflo(a.z); v[5] = bfhi(a.z); v[6] = bflo(a.w); v[7] = bfhi(a.w);
        const float rs = (KIND == 0 ? (1.0f - lam_init) : 1.0f) / sqrtf(qv[k] * (1.0f / 128.0f) + NORM_EPS);
#pragma unroll
        for (int e = 0; e < 8; ++e) v[e] *= rs * gd[e];
        if (KIND == 1) {
            const v4u g0 = gv[k];
            float g[8];
            g[0] = bflo(g0.x); g[1] = bfhi(g0.x); g[2] = bflo(g0.y); g[3] = bfhi(g0.y); g[4] = bflo(g0.z); g[5] = bfhi(g0.z); g[6] = bflo(g0.w); g[7] = bfhi(g0.w);
#pragma unroll
            for (int e = 0; e < 8; ++e) v[e] *= g[e] * __builtin_amdgcn_rcpf(1.0f + __builtin_amdgcn_exp2f(g[e] * -LOG2E));
        }
        v4u o0;
        o0.x = pk2(v[0], v[1]); o0.y = pk2(v[2], v[3]); o0.z = pk2(v[4], v[5]); o0.w = pk2(v[6], v[7]);
        *(GAS v4u*)(mixrow + (size_t)row * D) = o0; }
    asm volatile("s_waitcnt lgkmcnt(0)" ::: "memory");
}
__device__ __forceinline__ int diff_tskip(const float* qn, const float* kn, int b, int hj, int qb, float cs) {
    const float* q4 = qn + (b * 8 + hj) * 32 + 4 * qb; const float* kt = kn + (b * 8 + hj) * 32;
    const float Qn = sqrtf(fmaxf(fmaxf(q4[0], q4[1]), fmaxf(q4[2], q4[3]))) * 1.01f;
    const float Ku = sqrtf(fmaxf(fmaxf(kt[4 * qb], kt[4 * qb + 1]), fmaxf(kt[4 * qb + 2], kt[4 * qb + 3]))) * 1.01f;
    int ts = 0;
    for (int t = 0; t + 1 < 4 * qb; t += 2) {
        const float km = sqrtf(fmaxf(kt[t], kt[t + 1])) * 1.01f;
        if (cs * (float)(256 * qb - 64 * (t + 1) - 63) - Qn * (km + Ku) >= 35.0f) ts = t + 2; else break;
    }
    return __builtin_amdgcn_readfirstlane(ts);
}
constexpr int MIX_NITEM = 36;
constexpr unsigned char MIX_ITEM[MIX_NITEM] = {23, 31, 22, 30, 21, 29, 12, 13, 14, 15, 20, 28, 32, 33, 34, 35, 11, 19, 27, 10, 18, 26, 2, 3, 4, 5, 6, 7, 1, 9, 17, 25, 0, 8, 16, 24};
__device__ __forceinline__ int mix_claim(gu32* ctr, volatile LAS unsigned* mb, int k) {
    if (threadIdx.x == 0) mb[16 + (k & 1)] = __hip_atomic_fetch_add((unsigned*)ctr, 1u, __ATOMIC_RELAXED, __HIP_MEMORY_SCOPE_AGENT);
    __syncthreads();
    return __builtin_amdgcn_readfirstlane((int)mb[16 + (k & 1)]);
}
__device__ __forceinline__ int mix_claim_finish(unsigned tok, volatile LAS unsigned* mb, int k) {
    if (threadIdx.x == 0) mb[16 + (k & 1)] = tok;
    asm volatile("s_waitcnt lgkmcnt(0)\n\ts_barrier" ::: "memory");
    return __builtin_amdgcn_readfirstlane((int)mb[16 + (k & 1)]);
}
__device__ __forceinline__ void mixer_phase(unsigned char* lds_, int l, int q_ = 0) {
    Frame F; make_frame(F, lds_); Ptrs P; load_ptrs(P); char* lds = (char*)lds_ + RING_OFF;
    using attn_body::attn_unit;
    const attn_body::bf16* proj = (const attn_body::bf16*)(P.ws + WS_PROJ);
    const float lam_init = lam_init_of(l);
    const float lam = __builtin_bit_cast(float, __builtin_amdgcn_readfirstlane(__builtin_bit_cast(int, ((const GAS float*)(P.ws + WS_LAM))[l])));
    const int xg = F.vcu >> 5;
    volatile LAS unsigned char* tst = (volatile LAS unsigned char*)(F.lds + LDSCTL_OFF + 512);
    { int tsv = 0;
#if !NO_TSKIP
      LAS float* ldn = (LAS float*)(F.lds + RING_OFF);
#pragma unroll
      for (int bb = 0; bb < 4; ++bb) ldn[bb * 512 + F.tid] = F.tid < 256 ? ((const GAS float*)(P.ws + WS_QN))[(4 * xg + bb) * 256 + F.tid] : ((const GAS float*)(P.ws + WS_KN))[(4 * xg + bb) * 256 + F.tid - 256];
      __syncthreads();
      ldn += (F.wave & 3) * 512;
      const int hj = F.lane >> 3, qb = F.lane & 7; const float cs = exp2f(-2.0f * (float)((hj >> 1) + 1)) * LOG2E;
      const LAS float* q4 = ldn + hj * 32 + 4 * qb; const LAS float* kt = ldn + 256 + hj * 32;
      const float Qn = sqrtf(fmaxf(fmaxf(q4[0], q4[1]), fmaxf(q4[2], q4[3]))) * 1.01f;
      const float Ku = sqrtf(fmaxf(fmaxf(kt[4 * qb], kt[4 * qb + 1]), fmaxf(kt[4 * qb + 2], kt[4 * qb + 3]))) * 1.01f;
      for (int t = 0; t + 1 < 4 * qb; t += 2) {
          const float km = sqrtf(fmaxf(kt[t], kt[t + 1])) * 1.01f;
          if (cs * (float)(256 * qb - 64 * (t + 1) - 63) - Qn * (km + Ku) >= 35.0f) tsv = t + 2; else break;
      }
#endif
      if (F.wave < 4) tst[F.wave * 64 + F.lane] = (unsigned char)tsv;
      __syncthreads(); }
#define TSK(bb, h, j, qb) __builtin_amdgcn_readfirstlane((int)tst[(bb) * 64 + (2 * (h) + (j)) * 8 + (qb)])
#define GO(c) (((c) >> 6) * (M * 64))
    gu32* ctr = (gu32*)(P.ws + WS_CTL) + (l * 32 + xg) * 16 + 8 * q_;
    int slot = 0; attn_body::bf16x8 qr[4]; bool pre = false;
    attn_body::f32x16 T;
#pragma unroll
    for (int r = 0; r < 16; ++r) T[r] = 0.f;
    int nclaim = 0;
    int cur = mix_claim(ctr, F.MISC, nclaim++);
    while (cur < 4 * MIX_NITEM) {
        unsigned tok = 0u; if (threadIdx.x == 0) tok = __hip_atomic_fetch_add((unsigned*)ctr, 1u, __ATOMIC_RELAXED, __HIP_MEMORY_SCOPE_AGENT);
        const int it = MIX_ITEM[cur >> 2];
        const int bb = cur & 3; const int rb_ = (4 * xg + bb) * SEQ; const long rowbase = rb_; int nxt;
        if (it < 32) {
            const int h = it >> 3, qb = it & 7;
            const float cs = __builtin_bit_cast(float, __builtin_amdgcn_readfirstlane(__builtin_bit_cast(int, exp2f(-2.0f * (float)(h + 1)) * LOG2E)));
            const attn_body::PassArgs a1{qb, GO(C_DQ + h * 128), GO(C_DK + h * 128), GO(C_DV + h * 128), TSK(bb, h, 0, qb), rb_};
            const attn_body::PassArgs a2{qb, GO(C_DQ + h * 128 + 64), GO(C_DK + h * 128 + 64), GO(C_DV + h * 128), TSK(bb, h, 1, qb), rb_};
            attn_unit<ATT_THR, 0>(proj, rowbase, a1, cs, lam, lds, slot, pre, qr, true, a2, T);
            nxt = mix_claim_finish(tok, F.MISC, nclaim++);
            const int nit = nxt < 4 * MIX_NITEM ? (int)MIX_ITEM[nxt >> 2] : -1; const int nbb = nxt & 3; const int nrb_ = (4 * xg + nbb) * SEQ;
            attn_body::PassArgs nx = a1; const bool more = nit >= 0;
            if (nit >= 32) nx = attn_body::PassArgs{0, GO(C_RQ + (nit - 32) * 64), GO(C_RK + (nit - 32) * 64), GO(C_RV + (nit - 32) * 128), 0, nrb_};
            else if (nit >= 0) { const int h2 = nit >> 3, qb2 = nit & 7; nx = attn_body::PassArgs{qb2, GO(C_DQ + h2 * 128), GO(C_DK + h2 * 128), GO(C_DV + h2 * 128), TSK(nbb, h2, 0, qb2), nrb_}; }
            attn_unit<ATT_THR, 1>(proj, rowbase, a2, cs, lam, lds, slot, true, qr, more, nx, T);
            mixer_finalize<0>(P, l, lds, rowbase + qb * 256 + F.wave * 32, h, lam_init);
            pre = more;
        } else {
            nxt = mix_claim_finish(tok, F.MISC, nclaim++);
            const int h = it - 32;
            const float lg = h == 0 ? -0.04580368961312479f : h == 1 ? -0.02272007650008353f : h == 2 ? -0.011315313227834146f : -0.005646563141142063f;
            const GAS float* gn = (const GAS float*)(P.ret_norm + l * 128); asm volatile("" : "+s"(gn));
            attn_body::ret_chain(proj, rowbase, GO(C_RQ + h * 64), GO(C_RK + h * 64), GO(C_RV + h * 128), GO(C_RG + h * 128), lg, lds, slot, pre, gn, (unsigned short*)(P.ws + WS_MIX) + h * 128, D);
            pre = false;
            asm volatile("s_waitcnt lgkmcnt(0)\n\ts_barrier" ::: "memory");
            asm volatile("" : "=v"(qr[0]), "=v"(qr[1]), "=v"(qr[2]), "=v"(qr[3]));
        }
        cur = nxt;
    }
#undef TSK
#undef GO
}

template <int l>
__device__ __forceinline__ void layer_phases(const XcdBarrier& bar, unsigned char* lds, int lo, int hi) {
#define GRID_BAR() do { if (!MK_PER_PHASE) xcd_barrier(bar, true); } while (0)
#define GRID_BAR_G() do { if (!MK_PER_PHASE) xcd_barrier(bar); } while (0)
#define IN(k) (lo <= (k) && (k) < hi)
#define BOTH(k) (IN(k) && IN((k) + 1))
#define LP_SETUP() Ptrs P; load_ptrs(P); const int G_ = gridDim.x; LAS unsigned char* ldsr = (LAS unsigned char*)lds + RING_OFF; \
    bf16* hb = (bf16*)(P.ws + WS_HB); bf16* mixb = (bf16*)(P.ws + WS_MIX); bf16* projb = (bf16*)(P.ws + WS_PROJ); bf16* hidb = (bf16*)(P.ws + WS_PROJ); \
    float* ssa = (float*)(P.ws + WS_SSA); float* ssb = (float*)(P.ws + WS_SSB); const unsigned char* wl = P.ws + WS_W + (size_t)l * W_LAYER; \
    (void)hb; (void)mixb; (void)projb; (void)hidb; (void)ssa; (void)ssb; (void)wl
        const int pb = 1 + 5 * l;
        if (IN(pb)) {
            LP_SETUP();
            pg8::Gemm g{hb, (const bf16*)(wl + W_IN), M, NIN, D}; pg8::StaticOrder S; S.init(M, NIN, G_, (int)blockIdx.x);
            pg8::EpiProj E{projb, 64, ssa, (float*)(P.ws + WS_QN), (float*)(P.ws + WS_KN), (long)M * 64, (const LAS float*)(ldsr + pg8::SS_LDS_OFF), (unsigned*)(P.ws + WS_END)};
            for (int rep_ = 0; rep_ < (PROBE_DUP == 1 ? 2 : 1); ++rep_) {
            pg8::gemm_phase<pg8::EpiProj, pg8::StaticOrder, PG8_ALIGN, PG8_SP2>(ldsr, g, S, E);
            if (BOTH(pb)) GRID_BAR(); }
        }
        if (IN(pb + 1)) {
#if PROBE_DUP == 2
            mixer_phase(lds, l, 1); if (BOTH(pb + 1)) GRID_BAR();
#endif
            mixer_phase(lds, l);
#if RET_NAIVE
            naive_mixer_phase<1>(lds, l);
#endif
            if (BOTH(pb + 1)) GRID_BAR();
        }
        if (IN(pb + 2)) {
            LP_SETUP();
            pg8::Gemm g{mixb, (const bf16*)(wl + W_OUT), M, D, D}; pg8::StaticOrder S; S.init(M, D, G_, (int)blockIdx.x);
            for (int rep_ = 0; rep_ < (PROBE_DUP == 3 ? 2 : 1); ++rep_) {
            const bool dummy_ = (PROBE_DUP == 3) && rep_ == 0;
            pg8::EpiResid E{hb, dummy_ ? projb : hb, dummy_ ? (float*)(P.ws + WS_END) : ssb, (unsigned*)(P.ws + WS_END)};
            pg8::gemm_phase<pg8::EpiResid, pg8::StaticOrder, PG8_ALIGN, PG8_SP2>(ldsr, g, S, E);
            if (BOTH(pb + 2)) GRID_BAR(); }
        }
        if (IN(pb + 3)) {
            LP_SETUP();
            pg8::Gemm g{hb, (const bf16*)(wl + W_GU), M, NGU, D};
#if PROBE_DUP == 7
            typedef pg8::DupOrder P4Order;
#else
            typedef pg8::StaticOrder P4Order;
#endif
            P4Order S; S.init(M, NGU, G_, (int)blockIdx.x);
            pg8::EpiSwiglu E{hidb, (long)M * 64, ssb, (const LAS float*)(ldsr + pg8::SS_LDS_OFF), (unsigned*)(P.ws + WS_END)};
            for (int rep_ = 0; rep_ < (PROBE_DUP == 4 ? 2 : 1); ++rep_) {
            pg8::gemm_phase<pg8::EpiSwiglu, P4Order, PG8_ALIGN, PG8_SP2>(ldsr, g, S, E);
            if (BOTH(pb + 3)) GRID_BAR(); }
        }
        if (IN(pb + 4)) {
            LP_SETUP();
            pg8::Gemm g{hidb, (const bf16*)(wl + W_DN), M, D, FF, 32, (long)(M / 8) * 32, (long)M * 64, (long)(M / 8) * 32};    pg8::StaticOrder S; S.init(M, D, G_, (int)blockIdx.x);
            for (int rep_ = 0; rep_ < (PROBE_DUP == 5 ? 2 : 1); ++rep_) {
            const bool dummy_ = (PROBE_DUP == 5) && rep_ == 0;
            pg8::EpiResid E{hb, dummy_ ? mixb : hb, dummy_ ? (float*)(P.ws + WS_END) : ssa, (unsigned*)(P.ws + WS_END)};
            pg8::gemm_phase<pg8::EpiResid, pg8::StaticOrder, PG8_ALIGN, PG8_SP2>(ldsr, g, S, E);
            if (BOTH(pb + 4)) { if (l == DEPTH - 1) GRID_BAR_G(); else GRID_BAR(); } }
        }
    #undef IN
#undef BOTH
#undef GRID_BAR
#undef GRID_BAR_G
#undef LP_SETUP
}

__global__ void __launch_bounds__(NWAVES * 64, 2) hybrid_fwd(Args args) {
    extern __shared__ __attribute__((aligned(16))) unsigned char lds[];
    for (int u = threadIdx.x; u < (LDS_BYTES - LDSCTL_OFF) / 4; u += NWAVES * 64) ((LAS unsigned*)((LAS unsigned char*)lds + LDSCTL_OFF))[u] = 0u;
    __syncthreads();
    unsigned* barw = (unsigned*)(args.ws + WS_CTL) + CW_BAR;
    XcdBarrier bar; bar.bar = barw; bar.x = 0; bar.st = nullptr;
    if (!MK_PER_PHASE) bar = xcd_barrier_post(barw, (volatile LAS unsigned*)((LAS unsigned char*)lds + MISC_OFF) + 8);
#define GRID_BAR() do { if (!MK_PER_PHASE) xcd_barrier(bar); } while (0)
    const int lo = args.ph_lo, hi = args.ph_hi;
#define IN(k) (lo <= (k) && (k) < hi)
#define BOTH(k) (IN(k) && IN((k) + 1))
    for (int rep_ = 0; rep_ < (PROBE_DUP == 6 ? 2 : 1); ++rep_) if (IN(0)) { p0_prologue(lds); if (BOTH(0)) { if (!MK_PER_PHASE) xcd_tag_post(bar); GRID_BAR(); if (!MK_PER_PHASE) xcd_local_check(bar); } }
    layer_phases<0>(bar, lds, lo, hi);
    layer_phases<1>(bar, lds, lo, hi);
    if (IN(11)) final_norm_phase(lds);
#undef IN
#undef BOTH
#undef GRID_BAR
}

extern "C" void kernel_launch(void* const* d_in, const int* in_sizes, int n_in, void* d_out, int out_size, void* d_ws, size_t ws_size, hipStream_t stream) {
    static int grid = 0;
    if (grid == 0) {
        if (n_in != 15 || in_sizes[0] != M * D || out_size != M * D || ws_size < WS_END) { fprintf(stderr, "kernel_launch: unexpected shapes (n_in %d, in0 %d, out %d, ws %zu; need ws >= %zu); nothing launched\n", n_in, n_in > 0 ? in_sizes[0] : -1, out_size, ws_size, (size_t)WS_END); grid = -1; return; }
        int dev = 0, cus = 0, per_cu = 0;
        if (hipGetDevice(&dev) != hipSuccess || hipDeviceGetAttribute(&cus, hipDeviceAttributeMultiprocessorCount, dev) != hipSuccess) { grid = -1; return; }
        if (hipFuncSetAttribute((const void*)hybrid_fwd, hipFuncAttributeMaxDynamicSharedMemorySize, LDS_BYTES) != hipSuccess) { fprintf(stderr, "kernel_launch: hipFuncSetAttribute failed\n"); grid = -1; return; }
        if (hipOccupancyMaxActiveBlocksPerMultiprocessor(&per_cu, (const void*)hybrid_fwd, NWAVES * 64, LDS_BYTES) != hipSuccess || per_cu < 1) { fprintf(stderr, "kernel_launch: occupancy query reports %d workgroups per CU\n", per_cu); (void)hipGetLastError(); grid = -1; return; }
        if (cus != 256) { fprintf(stderr, "kernel_launch: built for 256 CUs (the mixer's unit deal), found %d; nothing launched\n", cus); grid = -1; return; }
        grid = cus;
    }
    if (grid < 0) return;
    if (hipMemsetAsync((char*)d_ws + WS_CTL, 0, CTL_ZERO_BYTES, stream) != hipSuccess) return;
    Args a{};
    for (int i = 0; i < 15; ++i) a.in[i] = (const float*)d_in[i];
    a.out = (float*)d_out; a.ws = (unsigned char*)d_ws;
#if MK_PER_PHASE
    for (int p = 0; p < N_PHASES; ++p) { a.ph_lo = p; a.ph_hi = p + 1; hipLaunchKernelGGL(hybrid_fwd, dim3(grid), dim3(NWAVES * 64), LDS_BYTES, stream, a); }
#else
    a.ph_lo = 0; a.ph_hi = N_PHASES;
    hipLaunchKernelGGL(hybrid_fwd, dim3(grid), dim3(NWAVES * 64), LDS_BYTES, stream, a);
#endif
}
```
